# Optimizing an MI355X kernel written in HIP

```python
import math
import jax
import jax.numpy as jnp
from jax import lax
import numpy as np

D_MODEL = 1024
BATCH = 8
SEQ = 4096
DEPTH = 4

CHUNK = 64
Q_BLOCK = 128
N_MEM = 256
MAX_STREAM_OFFSET = 4096
LN_EPS = 1e-5
RMS_EPS = 1e-6

DA_HEAD_DIM = 64
DA_V_DIM = 2 * DA_HEAD_DIM
DA_WIDTH = D_MODEL // 2
DA_HEADS = DA_WIDTH // DA_V_DIM
DA_QK = 2 * DA_HEADS * DA_HEAD_DIM
ROPE_THETA = 10000.0

RW_HEAD_DIM = 64
RW_WIDTH = D_MODEL // 4
RW_HEADS = RW_WIDTH // RW_HEAD_DIM
RW_DECAY_RANK = 32
RW_AAA_RANK = 32
RW_GATE_RANK = 64
RW_IN = 3 * RW_WIDTH + RW_DECAY_RANK + RW_AAA_RANK + RW_GATE_RANK
RW_SPLITS = tuple(int(v) for v in np.cumsum([RW_WIDTH, RW_WIDTH, RW_WIDTH, RW_DECAY_RANK, RW_AAA_RANK]))
RW_DECAY_SCALE = math.exp(-0.5)
RW_LNX_EPS = 64e-5

S5_WIDTH = D_MODEL - DA_WIDTH - RW_WIDTH
S5_GROUP_CH = 16
S5_GROUPS = S5_WIDTH // S5_GROUP_CH
S5_STATE = 64

MIX_WIDTH = DA_WIDTH + RW_WIDTH + S5_WIDTH
IN_SIZES = (DA_QK, DA_QK, DA_WIDTH, RW_IN, S5_WIDTH)
IN_WIDTH = sum(IN_SIZES)
IN_SPLITS = tuple(int(v) for v in np.cumsum(IN_SIZES)[:-1])

MEM_HEADS = 4
MEM_HEAD_DIM = D_MODEL // MEM_HEADS

D_FF = ((8 * D_MODEL // 3 + 127) // 128) * 128
FFN_CONV = 3

ALPHA = (2.0 * DEPTH) ** 0.25
BETA = (8.0 * DEPTH) ** -0.25

kernel_name = 'hybrid_streaming_encoder_trunk'


def layer_norm(x, g, b):
    x32 = x.astype(jnp.float32)
    mu = jnp.mean(x32, axis=-1, keepdims=True)
    var = jnp.mean(jnp.square(x32 - mu), axis=-1, keepdims=True)
    return ((x32 - mu) * lax.rsqrt(var + LN_EPS) * g + b).astype(x.dtype)


def rms_norm(x, g):
    x32 = x.astype(jnp.float32)
    y = x32 * lax.rsqrt(jnp.mean(jnp.square(x32), axis=-1, keepdims=True) + RMS_EPS)
    return (y * g).astype(x.dtype)


def rope_tables(positions):
    inv_freq = ROPE_THETA ** (-jnp.arange(0, DA_HEAD_DIM, 2, dtype=jnp.float32) / DA_HEAD_DIM)
    ang = positions.astype(jnp.float32)[..., None] * inv_freq
    ang = jnp.concatenate([ang, ang], axis=-1)
    return jnp.cos(ang), jnp.sin(ang)


def apply_rope(t, cos, sin):
    c = cos[:, :, None, None, :].astype(t.dtype)
    s = sin[:, :, None, None, :].astype(t.dtype)
    half = t.shape[-1] // 2
    rot = jnp.concatenate([-t[..., half:], t[..., :half]], axis=-1)
    return t * c + rot * s


def diff_attention(pq, pk, pv, cos, sin, lam_q1, lam_k1, lam_q2, lam_k2, subln_g, lambda_init):
    bsz, seq, _ = pq.shape
    nb = seq // Q_BLOCK
    q = apply_rope(pq.reshape(bsz, seq, DA_HEADS, 2, DA_HEAD_DIM), cos, sin) * (DA_HEAD_DIM ** -0.5)
    k = apply_rope(pk.reshape(bsz, seq, DA_HEADS, 2, DA_HEAD_DIM), cos, sin)
    q = q.transpose(3, 0, 2, 1, 4)
    k = k.transpose(3, 0, 2, 1, 4)
    v = pv.reshape(bsz, seq, DA_HEADS, DA_V_DIM).transpose(0, 2, 1, 3)
    lam = (jnp.exp(jnp.sum((lam_q1 * lam_k1).astype(jnp.float32)))
           - jnp.exp(jnp.sum((lam_q2 * lam_k2).astype(jnp.float32))) + lambda_init)
    q_blocks = q.reshape(2, bsz, DA_HEADS, nb, Q_BLOCK, DA_HEAD_DIM).transpose(3, 0, 1, 2, 4, 5)
    key_chunk = jnp.arange(seq) // CHUNK

    def block(args):
        i, qb = args
        q_chunk = (i * Q_BLOCK + jnp.arange(Q_BLOCK)) // CHUNK
        mask = key_chunk[None, :] <= q_chunk[:, None]
        s = jnp.einsum('nbhqd,nbhkd->nbhqk', qb, k).astype(jnp.float32)
        p = jax.nn.softmax(jnp.where(mask, s, -jnp.inf), axis=-1)
        attn = p[0] - lam * p[1]
        return jnp.einsum('bhqk,bhkv->bhqv', attn.astype(v.dtype), v)

    o = lax.map(block, (jnp.arange(nb), q_blocks))
    o = o.transpose(1, 2, 0, 3, 4).reshape(bsz, DA_HEADS, seq, DA_V_DIM)
    o = rms_norm(o, subln_g) * (1.0 - lambda_init)
    return o.transpose(0, 2, 1, 3).reshape(bsz, seq, DA_WIDTH)


def rwkv7_time_mix(p, mu, w0, w2, a0, a2, g2, k_k, k_a, r_k, lnx_g, lnx_b):
    bsz, seq, _ = p.shape
    prev = jnp.pad(p, ((0, 0), (1, 0), (0, 0)))[:, :-1]
    p = p + (prev - p) * mu
    r, k, v, wd, ad, gd = jnp.split(p, RW_SPLITS, axis=-1)

    def heads(t):
        return t.astype(jnp.float32).reshape(bsz, seq, RW_HEADS, RW_HEAD_DIM)

    decay = jnp.exp(-RW_DECAY_SCALE * jax.nn.sigmoid((w0 + jnp.tanh(wd) @ w2).astype(jnp.float32)))
    a = jax.nn.sigmoid((a0 + ad @ a2).astype(jnp.float32))
    g = jax.nn.sigmoid(gd) @ g2
    kk = heads(k * k_k)
    kk = kk * lax.rsqrt(jnp.maximum(jnp.sum(kk * kk, axis=-1, keepdims=True), 1e-24))
    k = k.astype(jnp.float32) * (1.0 + (a - 1.0) * k_a)
    r_h, k_h, v_h, w_h, a_h = heads(r), heads(k), heads(v), heads(decay), heads(a)

    def step(state, inp):
        r_t, w_t, k_t, v_t, kk_t, a_t = inp
        sa = jnp.einsum('bhvk,bhk->bhv', state, -kk_t)
        state = (state * w_t[:, :, None, :] + sa[..., None] * (kk_t * a_t)[:, :, None, :]
                 + v_t[..., None] * k_t[:, :, None, :])
        return state, jnp.einsum('bhvk,bhk->bhv', state, r_t)

    xs = tuple(jnp.moveaxis(t, 1, 0) for t in (r_h, w_h, k_h, v_h, kk, a_h))
    s0 = jnp.zeros((bsz, RW_HEADS, RW_HEAD_DIM, RW_HEAD_DIM), jnp.float32)
    _, y = lax.scan(step, s0, xs)
    y = jnp.moveaxis(y, 0, 1)
    mean = jnp.mean(y, axis=-1, keepdims=True)
    var = jnp.mean(jnp.square(y - mean), axis=-1, keepdims=True)
    y = ((y - mean) * lax.rsqrt(var + RW_LNX_EPS)).reshape(bsz, seq, RW_WIDTH) * lnx_g + lnx_b
    bonus = jnp.sum(r_h * k_h * r_k, axis=-1, keepdims=True) * v_h
    y = y + bonus.reshape(bsz, seq, RW_WIDTH)
    return (y * g).astype(p.dtype)


def s5_ssm(u, a_re, a_im, b_re, b_im, c_re, c_im, d_skip, log_step, glu_w, glu_b, out_g):
    bsz, seq, _ = u.shape
    u32 = u.astype(jnp.float32).reshape(bsz, seq, S5_GROUPS, S5_GROUP_CH)
    A = lax.complex(a_re.astype(jnp.float32), a_im.astype(jnp.float32))
    delta = jnp.exp(log_step.astype(jnp.float32))[:, None]
    a_bar = jnp.exp(delta * A)
    Bc = lax.complex(b_re.astype(jnp.float32), b_im.astype(jnp.float32))
    b_bar = ((a_bar - 1.0) / A)[..., None] * Bc
    bu = lax.complex(jnp.einsum('gph,blgh->blgp', jnp.real(b_bar), u32),
                     jnp.einsum('gph,blgh->blgp', jnp.imag(b_bar), u32))
    a_seq = jnp.broadcast_to(a_bar, bu.shape)

    def combine(e1, e2):
        a1, b1 = e1
        a2, b2 = e2
        return a1 * a2, a2 * b1 + b2

    _, states = lax.associative_scan(combine, (a_seq, bu), axis=1)
    Cc = lax.complex(c_re.astype(jnp.float32), c_im.astype(jnp.float32))
    y = jnp.real(jnp.einsum('ghp,blgp->blgh', Cc, states))
    y = (y + d_skip.astype(jnp.float32).reshape(S5_GROUPS, S5_GROUP_CH) * u32).reshape(bsz, seq, S5_WIDTH)
    z = jax.nn.gelu(y)
    z = z * jax.nn.sigmoid(z @ glu_w.astype(jnp.float32) + glu_b)
    return rms_norm(z, out_g).astype(u.dtype)


def memory_cross_attention(x, mem, wq, wkv, wo):
    bsz, seq, _ = x.shape
    q = (x @ wq).reshape(bsz, seq, MEM_HEADS, MEM_HEAD_DIM)
    k, v = jnp.split(mem @ wkv, 2, axis=-1)
    k = k.reshape(bsz, N_MEM, MEM_HEADS, MEM_HEAD_DIM)
    v = v.reshape(bsz, N_MEM, MEM_HEADS, MEM_HEAD_DIM)
    s = jnp.einsum('blhd,bmhd->bhlm', q, k).astype(jnp.float32) * (MEM_HEAD_DIM ** -0.5)
    p = jax.nn.softmax(s, axis=-1).astype(v.dtype)
    o = jnp.einsum('bhlm,bmhd->blhd', p, v).reshape(bsz, seq, D_MODEL)
    return o @ wo


def conv_ffn(x, w_up, conv_w, conv_b, w_down):
    seq = x.shape[1]
    a, g = jnp.split(x @ w_up, 2, axis=-1)
    ap = jnp.pad(a, ((0, 0), (FFN_CONV - 1, 0), (0, 0)))
    a = conv_b + sum(conv_w[j] * ap[:, j:j + seq] for j in range(FFN_CONV))
    return (jax.nn.silu(a) * g) @ w_down


def setup_inputs(seed: int = 0) -> dict:
    key = jax.random.key(seed)
    keys = iter(jax.random.split(key, 64))

    def normal(shape, scale):
        return scale * jax.random.normal(next(keys), shape, jnp.float32)

    def uniform(shape, lo, hi):
        return jax.random.uniform(next(keys), shape, jnp.float32, lo, hi)

    L = DEPTH
    n_idx = jnp.arange(S5_STATE, dtype=jnp.float32)
    positions = (jax.random.randint(next(keys), (BATCH, 1), 0, MAX_STREAM_OFFSET, dtype=jnp.int32)
                 + jnp.arange(SEQ, dtype=jnp.int32)[None, :])
    return {
        'x': normal((BATCH, SEQ, D_MODEL), 1.0),
        'mem': normal((BATCH, N_MEM, D_MODEL), 1.0),
        'positions': positions,
        'w_in': normal((L, D_MODEL, IN_WIDTH), D_MODEL ** -0.5),
        'da_lam_q1': normal((L, DA_HEAD_DIM), 0.1),
        'da_lam_k1': normal((L, DA_HEAD_DIM), 0.1),
        'da_lam_q2': normal((L, DA_HEAD_DIM), 0.1),
        'da_lam_k2': normal((L, DA_HEAD_DIM), 0.1),
        'da_subln_g': 1.0 + normal((L, DA_V_DIM), 0.02),
        'rw_mu': uniform((L, RW_IN), 0.0, 1.0),
        'rw_w0': normal((L, RW_WIDTH), 1.0),
        'rw_w2': normal((L, RW_DECAY_RANK, RW_WIDTH), 0.1 * RW_DECAY_RANK ** -0.5),
        'rw_a0': normal((L, RW_WIDTH), 0.1),
        'rw_a2': normal((L, RW_AAA_RANK, RW_WIDTH), 0.1 * RW_AAA_RANK ** -0.5),
        'rw_g2': normal((L, RW_GATE_RANK, RW_WIDTH), RW_GATE_RANK ** -0.5),
        'rw_k_k': 0.85 + normal((L, RW_WIDTH), 0.02),
        'rw_k_a': 1.0 + normal((L, RW_WIDTH), 0.02),
        'rw_r_k': normal((L, RW_HEADS, RW_HEAD_DIM), 0.1),
        'rw_lnx_g': 1.0 + normal((L, RW_WIDTH), 0.02),
        'rw_lnx_b': normal((L, RW_WIDTH), 0.02),
        's5_a_re': -0.5 + normal((L, S5_GROUPS, S5_STATE), 0.01),
        's5_a_im': math.pi * n_idx + normal((L, S5_GROUPS, S5_STATE), 0.01),
        's5_b_re': normal((L, S5_GROUPS, S5_STATE, S5_GROUP_CH), (2.0 * S5_GROUP_CH) ** -0.5),
        's5_b_im': normal((L, S5_GROUPS, S5_STATE, S5_GROUP_CH), (2.0 * S5_GROUP_CH) ** -0.5),
        's5_c_re': normal((L, S5_GROUPS, S5_GROUP_CH, S5_STATE), S5_STATE ** -0.5),
        's5_c_im': normal((L, S5_GROUPS, S5_GROUP_CH, S5_STATE), S5_STATE ** -0.5),
        's5_d': normal((L, S5_WIDTH), 1.0),
        's5_log_step': uniform((L, S5_GROUPS), math.log(1e-3), math.log(1e-1)),
        's5_glu_w': normal((L, S5_WIDTH, S5_WIDTH), S5_WIDTH ** -0.5),
        's5_glu_b': normal((L, S5_WIDTH), 0.02),
        's5_out_g': 1.0 + normal((L, S5_WIDTH), 0.02),
        'w_out': normal((L, MIX_WIDTH, D_MODEL), BETA * MIX_WIDTH ** -0.5),
        'ln1_g': 1.0 + normal((L, D_MODEL), 0.02),
        'ln1_b': normal((L, D_MODEL), 0.02),
        'ca_wq': normal((L, D_MODEL, D_MODEL), D_MODEL ** -0.5),
        'ca_wkv': normal((L, D_MODEL, 2 * D_MODEL), D_MODEL ** -0.5),
        'ca_wo': normal((L, D_MODEL, D_MODEL), BETA * D_MODEL ** -0.5),
        'ln2_g': 1.0 + normal((L, D_MODEL), 0.02),
        'ln2_b': normal((L, D_MODEL), 0.02),
        'ffn_w_up': normal((L, D_MODEL, 2 * D_FF), D_MODEL ** -0.5),
        'ffn_conv_w': normal((L, FFN_CONV, D_FF), 0.5),
        'ffn_conv_b': normal((L, D_FF), 0.02),
        'ffn_w_down': normal((L, D_FF, D_MODEL), BETA * D_FF ** -0.5),
        'ln3_g': 1.0 + normal((L, D_MODEL), 0.02),
        'ln3_b': normal((L, D_MODEL), 0.02),
    }


def reference(x, mem, positions, w_in, da_lam_q1, da_lam_k1, da_lam_q2, da_lam_k2, da_subln_g,
              rw_mu, rw_w0, rw_w2, rw_a0, rw_a2, rw_g2, rw_k_k, rw_k_a, rw_r_k, rw_lnx_g, rw_lnx_b,
              s5_a_re, s5_a_im, s5_b_re, s5_b_im, s5_c_re, s5_c_im, s5_d, s5_log_step,
              s5_glu_w, s5_glu_b, s5_out_g, w_out, ln1_g, ln1_b, ca_wq, ca_wkv, ca_wo, ln2_g, ln2_b,
              ffn_w_up, ffn_conv_w, ffn_conv_b, ffn_w_down, ln3_g, ln3_b):
    cos, sin = rope_tables(positions)
    for l in range(DEPTH):
        lambda_init = 0.8 - 0.6 * math.exp(-0.3 * l)
        p_q, p_k, p_v, p_rw, p_s5 = jnp.split(x @ w_in[l], IN_SPLITS, axis=-1)
        h_da = diff_attention(p_q, p_k, p_v, cos, sin, da_lam_q1[l], da_lam_k1[l], da_lam_q2[l],
                              da_lam_k2[l], da_subln_g[l], lambda_init)
        h_rw = rwkv7_time_mix(p_rw, rw_mu[l], rw_w0[l], rw_w2[l], rw_a0[l], rw_a2[l], rw_g2[l],
                              rw_k_k[l], rw_k_a[l], rw_r_k[l], rw_lnx_g[l], rw_lnx_b[l])
        h_s5 = s5_ssm(p_s5, s5_a_re[l], s5_a_im[l], s5_b_re[l], s5_b_im[l], s5_c_re[l], s5_c_im[l],
                      s5_d[l], s5_log_step[l], s5_glu_w[l], s5_glu_b[l], s5_out_g[l])
        h = jnp.concatenate([h_da.astype(x.dtype), h_rw.astype(x.dtype), h_s5.astype(x.dtype)], axis=-1)
        x = layer_norm(ALPHA * x + h @ w_out[l], ln1_g[l], ln1_b[l])
        h = memory_cross_attention(x, mem, ca_wq[l], ca_wkv[l], ca_wo[l])
        x = layer_norm(ALPHA * x + h, ln2_g[l], ln2_b[l])
        h = conv_ffn(x, ffn_w_up[l], ffn_conv_w[l], ffn_conv_b[l], ffn_w_down[l])
        x = layer_norm(ALPHA * x + h, ln3_g[l], ln3_b[l])
    return x
```

```cpp
#include <hip/hip_runtime.h>
#include <hip/hip_bf16.h>
#include <hip/hip_cooperative_groups.h>
#include <cstdio>
#include <cstring>
#include <cmath>
#include <cstddef>
namespace cg = cooperative_groups;

#ifndef PROBE_DUP
#define PROBE_DUP 0
#endif
#ifndef MULTI_LAUNCH
#define MULTI_LAUNCH 0
#endif

typedef unsigned short u16;
using bf16x8 = __attribute__((ext_vector_type(8))) short;
using f32x4 = __attribute__((ext_vector_type(4))) float;
using u32x4 = __attribute__((ext_vector_type(4))) unsigned;
#define DI __device__ __forceinline__

constexpr int NTOK = 32768, DM = 1024, SEQ = 4096, NBATCH = 8, DEPTH = 4;
constexpr int INW = 2688, DFF = 2816;
constexpr float ALPHA = 1.681792830507429f;
constexpr float LOG2E = 1.4426950408889634f;

enum { I_X = 0, I_MEM, I_POS, I_WIN, I_LQ1, I_LK1, I_LQ2, I_LK2, I_SUBLN, I_MU, I_W0, I_W2, I_A0, I_A2, I_G2, I_KK, I_KA, I_RK,
       I_LNXG, I_LNXB, I_SARE, I_SAIM, I_SBRE, I_SBIM, I_SCRE, I_SCIM, I_SD, I_SLOG, I_GLUW, I_GLUB, I_SOUTG, I_WOUT, I_LN1G, I_LN1B,
       I_WQ, I_WKV, I_WO, I_LN2G, I_LN2B, I_WUP, I_CONVW, I_CONVB, I_WDOWN, I_LN3G, I_LN3B, N_IN };

constexpr size_t MiB = 1024 * 1024;
constexpr size_t OFF_XB = 0;
constexpr size_t OFF_Y = 0, OFF_G = 32 * MiB, OFF_Z = 48 * MiB;
constexpr size_t OFF_WT = 64 * MiB;
constexpr size_t WT_IN = 0, WT_OUT = WT_IN + 2816ul * 1024 * 2, WT_Q = WT_OUT + 2 * MiB, WT_KV = WT_Q + 2 * MiB, WT_O = WT_KV + 4 * MiB,
                 WT_UP = WT_O + 2 * MiB, WT_DOWN = WT_UP + 11 * MiB, WT_GLU = WT_DOWN + 2816ul * 1024 * 2,
                 WT_W2T = WT_GLU + 131072, WT_A2T = WT_W2T + 16384, WT_G2T = WT_A2T + 16384;
constexpr size_t OFF_KMEM = 97 * MiB;
constexpr size_t OFF_VMEMT = 101 * MiB;
constexpr size_t OFF_MEMB = 105 * MiB;
constexpr size_t OFF_ROPE = 109 * MiB;
constexpr size_t OFF_CNT = 117 * MiB;
constexpr size_t OFF_BONUS = 118 * MiB;
constexpr size_t OFF_DR = 120 * MiB;
constexpr size_t OFF_QK = OFF_DR;
constexpr size_t OFF_RW = OFF_DR + 64 * MiB;
constexpr size_t OFF_S5 = OFF_DR + 120 * MiB;
constexpr size_t OFF_VT = OFF_DR + 136 * MiB;
constexpr size_t OFF_HCAT = OFF_DR + 168 * MiB;
constexpr size_t OFF_REC = OFF_DR + 232 * MiB;
constexpr size_t OFF_QC = OFF_DR;
constexpr size_t OFF_OC = OFF_DR + 64 * MiB;
constexpr size_t OFF_AG = OFF_DR;
constexpr size_t OFF_AF = OFF_DR + 200 * MiB;
constexpr size_t OFF_GF = OFF_AF + 3 * MiB;
constexpr size_t OFF_AL = OFF_GF + 3 * MiB;

struct Params {
  const void* in[48];
  float* xs;
  char* ws;
  float lam_init[4];
  int pad[4];
};

typedef const char __attribute__((address_space(4)))* kaptr_t;
struct PRef {
  struct In { kaptr_t ka; DI const void* operator[](int i) const { return *(const void* const __attribute__((address_space(4)))*)(ka + i * 8); } } in;
  struct Xs { kaptr_t ka; DI operator float*() const { return *(float* const __attribute__((address_space(4)))*)(ka + 384); } } xs;
  struct Ws { kaptr_t ka; DI operator char*() const { return *(char* const __attribute__((address_space(4)))*)(ka + 392); } } ws;
  struct Lam { kaptr_t ka; DI float operator[](int i) const { return *(const float __attribute__((address_space(4)))*)(ka + 400 + i * 4); } } lam_init;
  DI explicit PRef(kaptr_t k) : in{k}, xs{k}, ws{k}, lam_init{k} {}
};
static_assert(offsetof(Params, xs) == 384 && offsetof(Params, ws) == 392 && offsetof(Params, lam_init) == 400, "layout");

DI int ltid() { int t = threadIdx.x; asm volatile("" : "+v"(t)); return t; }
typedef __bf16 bf16v2 __attribute__((ext_vector_type(2)));
typedef float f32v2 __attribute__((ext_vector_type(2)));
DI unsigned pack2(float a, float b) { f32v2 v = {a, b}; return __builtin_bit_cast(unsigned, __builtin_convertvector(v, bf16v2)); }
DI u16 f2bf(float x) { return (u16)(pack2(x, 0.f) & 0xffffu); }
DI float bf2f(u16 h) { return __uint_as_float(((unsigned)h) << 16); }
DI float sigmoidf_(float x) { return 1.f / (1.f + __expf(-x)); }
DI float wave_sum(float v) {
  for (int o = 32; o > 0; o >>= 1) v += __shfl_xor(v, o);
  return v;
}
template <int CTRL> DI float dpp_f(float x) {
  return __int_as_float(__builtin_amdgcn_mov_dpp(__float_as_int(x), CTRL, 0xF, 0xF, true));
}
DI float row16_sum(float x) {
  x += dpp_f<0xB1>(x);
  x += dpp_f<0x4E>(x);
  x += dpp_f<0x141>(x);
  x += dpp_f<0x140>(x);
  return x;
}

constexpr int BM = 256, BK = 64, HALF = 128, HT = HALF * BK;

DI int lds_byte(int r, int c) {
  int st = (r >> 4) * 2 + (c >> 5), rr = r & 15, cc = c & 31, ob = rr * 64 + cc * 2;
  return st * 1024 + (ob ^ (((ob >> 9) & 1) << 5));
}
DI void stage_rc(int b, int& R, int& C) {
  int st = b / 1024, sb = b % 1024, swz = sb ^ (((sb >> 9) & 1) << 5);
  R = (st >> 1) * 16 + swz / 64; C = (st & 1) * 32 + (swz % 64) / 2;
}

struct TileDesc { const u16* A; const u16* B; int brow, bcol, sub; };
template <class TileFn, class Epi>
DI void gemm_stream(int ntiles, int lda, int ldb, int K, TileFn tile_fn, Epi epi) {
  extern __shared__ __attribute__((aligned(16))) u16 shm[];
  if (ntiles <= 0) return;
#define SA(b, h) (shm + ((b) * 2 + (h)) * HT)
#define SB(b, h) (shm + (4 + (b) * 2 + (h)) * HT)
#define STAGE(P, PTR, V, S64, HH, KREL) do { \
    const char* _p = (PTR) + ((KREL) * 128 + (size_t)(2 * (HH)) * (S64)); asm volatile("" : "+s"(_p)); \
    __builtin_amdgcn_global_load_lds((const unsigned*)(_p + (size_t)(V)), (unsigned*)((char*)(P) + tid * 16), 16, 0, 0); \
    const char* _q = (PTR) + ((KREL) * 128 + (size_t)(2 * (HH) + 1) * (S64)); asm volatile("" : "+s"(_q)); \
    __builtin_amdgcn_global_load_lds((const unsigned*)(_q + (size_t)(V)), (unsigned*)((char*)(P) + tid * 16 + 8192), 16, 0, 0); } while (0)
#define LDA(dst, b, h) for (int m = 0; m < 4; ++m) for (int k = 0; k < 2; ++k) \
    dst[m][k] = *reinterpret_cast<const bf16x8*>((char*)SA(b, h) + lds_byte(wr * 64 + m * 16 + fr, k * 32 + fq * 8))
#define LDB(dst, b, h) for (int n = 0; n < 2; ++n) for (int k = 0; k < 2; ++k) \
    dst[n][k] = *reinterpret_cast<const bf16x8*>((char*)SB(b, h) + lds_byte(wc * 32 + n * 16 + fr, k * 32 + fq * 8))
#define MMA(ai, bj, At_, Bt_) do { __builtin_amdgcn_s_setprio(1); \
    for (int m = 0; m < 4; ++m) for (int n = 0; n < 2; ++n) for (int k = 0; k < 2; ++k) \
      acc[ai][bj][m][n] = __builtin_amdgcn_mfma_f32_16x16x32_bf16(Bt_[n][k], At_[m][k], acc[ai][bj][m][n], 0, 0, 0); \
    __builtin_amdgcn_s_setprio(0); } while (0)
#define WAIT_V(n) asm volatile("s_waitcnt vmcnt(" #n ")" ::: "memory")
#define WAIT_L(n) asm volatile("s_waitcnt lgkmcnt(" #n ")" ::: "memory")
#define BAR __builtin_amdgcn_s_barrier()
#define SCHED __builtin_amdgcn_sched_barrier(0)
#define SA0(P_, K) STAGE(SA(0, 0), P_, vA, sA64, 0, K)
#define SA0H(P_, K) STAGE(SA(0, 1), P_, vA, sA64, 1, K)
#define SA1(P_, K) STAGE(SA(1, 0), P_, vA, sA64, 0, K)
#define SA1H(P_, K) STAGE(SA(1, 1), P_, vA, sA64, 1, K)
#define SB0(P_, K) STAGE(SB(0, 0), P_, vB, sB64, 0, K)
#define SB0H(P_, K) STAGE(SB(0, 1), P_, vB, sB64, 1, K)
#define SB1(P_, K) STAGE(SB(1, 0), P_, vB, sB64, 0, K)
#define SB1H(P_, K) STAGE(SB(1, 1), P_, vB, sB64, 1, K)

  const int tid = ltid();
  const int wid = tid >> 6, lane = tid & 63, wr = wid >> 2, wc = wid & 3, fr = lane & 15, fq = lane >> 4;
  unsigned vA, vB;
  { int r0, c0; stage_rc(tid * 16, r0, c0); vA = (unsigned)(r0 * lda + c0) * 2u; vB = (unsigned)(r0 * ldb + c0) * 2u; }
  const unsigned sA64 = (unsigned)lda * 128u, sB64 = (unsigned)ldb * 128u;
  const int nt = K / BK;
  TileDesc cur = tile_fn(0);
  const char* pA = (const char*)(cur.A + (long)cur.brow * lda);
  const char* pB = (const char*)(cur.B + (long)cur.bcol * ldb);
  SB0(pB, 0); SA0(pA, 0); SB0H(pB, 0); SA0H(pA, 0);
  if (wr == 1) BAR;
  WAIT_V(4); BAR;
  SB1(pB, 1); SA1(pA, 1); SB1H(pB, 1);
  WAIT_V(6); BAR;
  for (int ti = 0; ti < ntiles; ++ti) {
    const TileDesc nxt = tile_fn(ti + 1 < ntiles ? ti + 1 : ti);
    const char* pAn = (const char*)(nxt.A + (long)nxt.brow * lda);
    const char* pBn = (const char*)(nxt.B + (long)nxt.bcol * ldb);
    f32x4 acc[2][2][4][2];
    for (int a = 0; a < 2; ++a) for (int b = 0; b < 2; ++b) for (int m = 0; m < 4; ++m) for (int n = 0; n < 2; ++n) acc[a][b][m][n] = f32x4{0.f, 0.f, 0.f, 0.f};
    bf16x8 At[4][2], B0[2][2], B1[2][2];
    for (int t = 0; t < nt; t += 2) {
      const bool last = (t == nt - 2);
      const char* pA2 = last ? pAn - 256 : pA;
      const char* pB2 = last ? pBn - 256 : pB;
      LDB(B0, 0, 0); SCHED; LDA(At, 0, 0); SA1H(pA, 1);
      WAIT_L(8); BAR; WAIT_L(0); MMA(0, 0, At, B0); BAR; SCHED;
      LDB(B1, 0, 1); SB0(pB2, 2);
      BAR; WAIT_L(0); MMA(0, 1, At, B1); BAR;
      LDA(At, 0, 1); SA0(pA2, 2);
      BAR; WAIT_L(0); MMA(1, 0, At, B0); BAR; SCHED;
      SB0H(pB2, 2);
      WAIT_V(6); BAR; MMA(1, 1, At, B1); BAR;
      LDB(B0, 1, 0); SCHED; LDA(At, 1, 0); SA0H(pA2, 2);
      WAIT_L(8); BAR; WAIT_L(0); MMA(0, 0, At, B0); BAR; SCHED;
      LDB(B1, 1, 1); SB1(pB2, 3);
      BAR; WAIT_L(0); MMA(0, 1, At, B1); BAR;
      LDA(At, 1, 1); SA1(pA2, 3);
      BAR; WAIT_L(0); MMA(1, 0, At, B0); BAR; SCHED;
      SB1H(pB2, 3);
      WAIT_V(6); BAR; MMA(1, 1, At, B1); BAR;
      pA += 256; pB += 256;
    }
    if (wr == 0) BAR;
    if (epi.kind == 10) {
      const PRef pe(epi.ka);
      up_epilogue(pe, epi.lay, acc, cur.brow, cur.bcol, wr, wc, fr, fq, reinterpret_cast<float*>(reinterpret_cast<char*>(shm) + 131072));
    } else {
#pragma unroll
      for (int ai = 0; ai < 2; ++ai)
#pragma unroll
        for (int bj = 0; bj < 2; ++bj)
#pragma unroll
          for (int m = 0; m < 4; ++m)
#pragma unroll
            for (int n = 0; n < 2; ++n)
              epi(cur.sub, cur.brow + ai * HALF + wr * 64 + m * 16 + fr, cur.bcol + bj * HALF + wc * 32 + n * 16 + fq * 4, acc[ai][bj][m][n]);
    }
    WAIT_V(0);
    cur = nxt; pA = pAn; pB = pBn;
    if (wr == 1 && ti + 1 < ntiles) BAR;
  }
  __syncthreads();
#undef SA
#undef SB
}

template <int CTRL> DI float dppz(float x) {
  return __int_as_float(__builtin_amdgcn_update_dpp(0, __float_as_int(x), CTRL, 0xF, 0xF, true));
}
DI void up_epilogue(const PRef& p, int l, const f32x4 (&acc)[2][2][4][2], int brow, int bcol, int wr, int wc, int fr, int fq, float* exch) {
  char* ws = p.ws;
  u16* hmid = (u16*)(ws + OFF_AG);
  const int pm = brow >> 8, pn = bcol >> 8;
  const int cw0 = pn * 128 + wc * 32 + fq * 4;
  const float* cwp = (const float*)p.in[I_CONVW] + (size_t)l * 3 * DFF;
  const float* cbp = (const float*)p.in[I_CONVB] + (size_t)l * DFF;
#pragma unroll
  for (int ai = 0; ai < 2; ++ai)
#pragma unroll
    for (int n = 0; n < 2; ++n) {
      if (fr >= 14) {
        const f32x4 v = acc[ai][0][3][n];
        *reinterpret_cast<float4*>(exch + (((ai * 2 + wr) * 2 + (fr - 14)) * 128 + wc * 32 + n * 16 + fq * 4)) = make_float4(v[0], v[1], v[2], v[3]);
        if (ai == 1 && wr == 1)
          *reinterpret_cast<float4*>((float*)(ws + OFF_AL) + ((size_t)(pm * 2 + (fr - 14)) * DFF + cw0 + n * 16)) = make_float4(v[0], v[1], v[2], v[3]);
      }
      if (ai == 0 && wr == 0 && fr < 2) {
        const f32x4 va = acc[0][0][0][n], vg = acc[0][1][0][n];
        *reinterpret_cast<float4*>((float*)(ws + OFF_AF) + ((size_t)(pm * 2 + fr) * DFF + cw0 + n * 16)) = make_float4(va[0], va[1], va[2], va[3]);
        *reinterpret_cast<float4*>((float*)(ws + OFF_GF) + ((size_t)(pm * 2 + fr) * DFF + cw0 + n * 16)) = make_float4(vg[0], vg[1], vg[2], vg[3]);
      }
    }
  __syncthreads();
#pragma unroll
  for (int ai = 0; ai < 2; ++ai) {
    const int sp = ai * 2 + wr;
#pragma unroll
    for (int n = 0; n < 2; ++n) {
      const int c = cw0 + n * 16;
      const float4 w0 = *reinterpret_cast<const float4*>(cwp + c), w1 = *reinterpret_cast<const float4*>(cwp + DFF + c);
      const float4 w2 = *reinterpret_cast<const float4*>(cwp + 2 * DFF + c), bs = *reinterpret_cast<const float4*>(cbp + c);
      float4 p62 = make_float4(0.f, 0.f, 0.f, 0.f), p63 = p62;
      if (sp > 0) {
        p62 = *reinterpret_cast<const float4*>(exch + (((sp - 1) * 2 + 0) * 128 + wc * 32 + n * 16 + fq * 4));
        p63 = *reinterpret_cast<const float4*>(exch + (((sp - 1) * 2 + 1) * 128 + wc * 32 + n * 16 + fq * 4));
      }
      const float w0a[4] = {w0.x, w0.y, w0.z, w0.w}, w1a[4] = {w1.x, w1.y, w1.z, w1.w}, w2a[4] = {w2.x, w2.y, w2.z, w2.w}, bsa[4] = {bs.x, bs.y, bs.z, bs.w};
      const float p62a[4] = {p62.x, p62.y, p62.z, p62.w}, p63a[4] = {p63.x, p63.y, p63.z, p63.w};
#pragma unroll
      for (int m = 0; m < 4; ++m) {
        float o[4];
#pragma unroll
        for (int j = 0; j < 4; ++j) {
          const float a = acc[ai][0][m][n][j], g = acc[ai][1][m][n][j];
          float pr1 = dppz<0x111>(a), pr2 = dppz<0x112>(a);
          if (m == 0) {
            if (fr == 0) { pr1 = p63a[j]; pr2 = p62a[j]; }
            if (fr == 1) { pr2 = p63a[j]; }
          } else {
            const float am = acc[ai][0][m - 1][n][j];
            const float mir = dppz<0x140>(am);
            const float swp = dppz<0xB1>(mir);
            if (fr == 0) { pr1 = mir; }
            if (fr < 2) { pr2 = swp; }
          }
          const float cv = bsa[j] + w0a[j] * pr2 + w1a[j] * pr1 + w2a[j] * a;
          o[j] = cv * sigmoidf_(cv) * g;
        }
        uint2 ov; ov.x = pack2(o[0], o[1]); ov.y = pack2(o[2], o[3]);
        *reinterpret_cast<uint2*>(hmid + (size_t)(brow + ai * HALF + wr * 64 + m * 16 + fr) * DFF + c) = ov;
      }
    }
  }
  __syncthreads();
}

struct EpiGen {
  int kind, lay; kaptr_t ka;
  DI void operator()(int sub, int row, int col, f32x4 v) const {
    const PRef p(ka);
    if (kind == 4 || kind == 8 || kind == 12) {
      float* X = p.xs;
      float4* q = reinterpret_cast<float4*>(X + (size_t)row * DM + col);
      const float4* qi = (kind == 4 && lay == 0) ? reinterpret_cast<const float4*>((const float*)p.in[I_X] + (size_t)row * DM + col) : q;
      float4 x = *qi;
      x.x = ALPHA * x.x + v[0]; x.y = ALPHA * x.y + v[1]; x.z = ALPHA * x.z + v[2]; x.w = ALPHA * x.w + v[3];
      *q = x;
      return;
    }
    char* ws = p.ws;
    const float scale = (kind == 6) ? 0.0625f * LOG2E : 1.f;
    uint2 o; o.x = pack2(v[0] * scale, v[1] * scale); o.y = pack2(v[2] * scale, v[3] * scale);
    u16* dst;
    if (kind == 6) dst = (u16*)(ws + OFF_QC) + (size_t)row * 1024 + col;
    else if (sub == 1) dst = (u16*)(ws + OFF_VT) + (size_t)row * NTOK + col;
    else if (sub == 2) dst = (u16*)(ws + OFF_KMEM) + (size_t)row * 1024 + col;
    else if (sub == 3) dst = (u16*)(ws + OFF_VMEMT) + (size_t)row * 2048 + col;
    else if (col < 1024) dst = (u16*)(ws + OFF_QK) + (size_t)row * 1024 + col;
    else if (col < 2432) dst = (u16*)(ws + OFF_RW) + (size_t)row * 896 + (col - 1536);
    else if (col < 2688) dst = (u16*)(ws + OFF_S5) + (size_t)row * 256 + (col - 2432);
    else return;
    *reinterpret_cast<uint2*>(dst) = o;
  }
};

DI void transpose_tiles(const float* __restrict__ src, int K, int N, int Npad, u16* __restrict__ dst, int& tbase, int tile_begin, int tile_stride, bool upmap = false) {
  extern __shared__ __attribute__((aligned(16))) u16 shm[];
  float* tile = reinterpret_cast<float*>(shm);
  const int nkt = K / 64, nnt = Npad / 64, total = nkt * nnt;
  int first = tile_begin;
  if (first < tbase) { int d = tbase - first; first += ((d + tile_stride - 1) / tile_stride) * tile_stride; }
  for (int g = first; g < tbase + total; g += tile_stride) {
    int t = g - tbase; int kt = t % nkt, ntile = t / nkt; int k0 = kt * 64, n0 = ntile * 64;
    __syncthreads();
    const int tid = ltid();
#pragma unroll
    for (int r = 0; r < 2; ++r) {
      const int e = tid + r * 512, i = e >> 4, j4 = (e & 15) * 4;
      float4 v = make_float4(0.f, 0.f, 0.f, 0.f);
      const int sn0 = upmap ? ((n0 & 255) >> 7) * DFF + (n0 >> 8) * 128 + (n0 & 127) : n0;
      if (n0 + j4 < N) v = *reinterpret_cast<const float4*>(src + (size_t)(k0 + i) * N + sn0 + j4);
      tile[i * 65 + j4] = v.x; tile[i * 65 + j4 + 1] = v.y; tile[i * 65 + j4 + 2] = v.z; tile[i * 65 + j4 + 3] = v.w;
    }
    __syncthreads();
    {
      const int jn = tid >> 3, seg = tid & 7;
      const float* tp = tile + (seg * 8) * 65 + jn;
      uint4 o;
      o.x = pack2(tp[0], tp[65]); o.y = pack2(tp[2 * 65], tp[3 * 65]); o.z = pack2(tp[4 * 65], tp[5 * 65]); o.w = pack2(tp[6 * 65], tp[7 * 65]);
      *reinterpret_cast<uint4*>(dst + (size_t)(n0 + jn) * K + k0 + seg * 8) = o;
    }
  }
  tbase += total;
}

DI void phase_transposes(const PRef& p, int l) {
  char* wt = p.ws + OFF_WT;
  int tbase = 0; const int tb = blockIdx.x, ts = gridDim.x;
  transpose_tiles((const float*)p.in[I_WIN] + (size_t)l * 1024 * INW, 1024, INW, 2816, (u16*)(wt + WT_IN), tbase, tb, ts);
  transpose_tiles((const float*)p.in[I_WOUT] + (size_t)l * 1024 * 1024, 1024, 1024, 1024, (u16*)(wt + WT_OUT), tbase, tb, ts);
  transpose_tiles((const float*)p.in[I_WQ] + (size_t)l * 1024 * 1024, 1024, 1024, 1024, (u16*)(wt + WT_Q), tbase, tb, ts);
  transpose_tiles((const float*)p.in[I_WKV] + (size_t)l * 1024 * 2048, 1024, 2048, 2048, (u16*)(wt + WT_KV), tbase, tb, ts);
  transpose_tiles((const float*)p.in[I_WO] + (size_t)l * 1024 * 1024, 1024, 1024, 1024, (u16*)(wt + WT_O), tbase, tb, ts);
  transpose_tiles((const float*)p.in[I_WUP] + (size_t)l * 1024 * 5632, 1024, 5632, 5632, (u16*)(wt + WT_UP), tbase, tb, ts, true);
  transpose_tiles((const float*)p.in[I_WDOWN] + (size_t)l * 2816 * 1024, 2816, 1024, 1024, (u16*)(wt + WT_DOWN), tbase, tb, ts);
  transpose_tiles((const float*)p.in[I_GLUW] + (size_t)l * 256 * 256, 256, 256, 256, (u16*)(wt + WT_GLU), tbase, tb, ts);
  __syncthreads();
  {
    const float* w2 = (const float*)p.in[I_W2] + l * 32 * 256;
    const float* a2 = (const float*)p.in[I_A2] + l * 32 * 256;
    const float* g2 = (const float*)p.in[I_G2] + l * 64 * 256;
    u16* w2t = (u16*)(wt + WT_W2T); u16* a2t = (u16*)(wt + WT_A2T); u16* g2t = (u16*)(wt + WT_G2T);
    for (int e = blockIdx.x * 512 + ltid(); e < 256 * 128; e += gridDim.x * 512) {
      const int n = e & 255, kk = e >> 8;
      if (kk < 32) w2t[n * 32 + kk] = f2bf(w2[kk * 256 + n]);
      else if (kk < 64) a2t[n * 32 + (kk - 32)] = f2bf(a2[(kk - 32) * 256 + n]);
      else g2t[n * 64 + (kk - 64)] = f2bf(g2[(kk - 64) * 256 + n]);
    }
  }
}

DI void phase_init(const PRef& p) {
  const size_t gtid = (size_t)blockIdx.x * 512 + ltid(), gsz = (size_t)gridDim.x * 512;
  const float4* x4 = (const float4*)p.in[I_X];
  uint2* xb2 = (uint2*)(p.ws + OFF_XB);
  for (size_t i = gtid; i < (size_t)NTOK * DM / 4; i += gsz) {
    float4 v = x4[i];
    uint2 o; o.x = pack2(v.x, v.y); o.y = pack2(v.z, v.w); xb2[i] = o;
  }
  const float4* m4 = (const float4*)p.in[I_MEM];
  uint2* mb2 = (uint2*)(p.ws + OFF_MEMB);
  for (size_t i = gtid; i < (size_t)2048 * 1024 / 4; i += gsz) {
    float4 v = m4[i]; uint2 o; o.x = pack2(v.x, v.y); o.y = pack2(v.z, v.w); mb2[i] = o;
  }
  const int* pos = (const int*)p.in[I_POS];
  float* rc = (float*)(p.ws + OFF_ROPE); float* rs = rc + (size_t)NTOK * 32;
  for (size_t i = gtid; i < (size_t)NTOK * 32; i += gsz) {
    int tok = (int)(i >> 5), d = (int)(i & 31);
    float invf = exp2f(-(float)d * (13.287712379549449f / 32.f));
    float angf = (float)pos[tok] * invf;
    double rev = (double)angf * 0.15915494309189535;
    float xr = (float)((rev - rint(rev)) * 6.283185307179586);
    float sv = __sinf(xr), cv = __cosf(xr);
    rc[i] = cv; rs[i] = sv;
  }
  if (blockIdx.x == 0 && ltid() < 64) ((unsigned*)(p.ws + OFF_CNT))[ltid()] = 0u;
}

DI void phase_prep(const PRef& p, int l) {
  extern __shared__ __attribute__((aligned(16))) u16 shm[];
  float* act = reinterpret_cast<float*>(shm);
  u16* qk = (u16*)(p.ws + OFF_QK);
  const u16* rw = (const u16*)(p.ws + OFF_RW);
  const float* rc = (const float*)(p.ws + OFF_ROPE); const float* rs = rc + (size_t)NTOK * 32;
  const float* mu = (const float*)p.in[I_MU] + l * 896;
  const float* w0 = (const float*)p.in[I_W0] + l * 256;
  const float* w2 = (const float*)p.in[I_W2] + l * 32 * 256;
  const float* a0 = (const float*)p.in[I_A0] + l * 256;
  const float* a2 = (const float*)p.in[I_A2] + l * 32 * 256;
  const float* g2 = (const float*)p.in[I_G2] + l * 64 * 256;
  const float* k_k = (const float*)p.in[I_KK] + l * 256;
  const float* k_a = (const float*)p.in[I_KA] + l * 256;
  const float* r_k = (const float*)p.in[I_RK] + l * 256;
  char* rec = p.ws + OFF_REC;
  u16* gbuf = (u16*)(p.ws + OFF_G);
  float* bonus = (float*)(p.ws + OFF_BONUS);
  const int tid = ltid();
  for (int item = blockIdx.x; item < NTOK / 32; item += gridDim.x) {
    const int tk0 = item * 32;
    {
      const int hh = tid >> 5, d = tid & 31;
      const float sc = (hh < 8) ? 0.125f * LOG2E : 1.f;
      for (int i = 0; i < 32; ++i) {
        const int tok = tk0 + i;
        u16* q = qk + (size_t)tok * 1024 + hh * 64 + d;
        float t0 = bf2f(q[0]), t1 = bf2f(q[32]);
        float c = rc[(size_t)tok * 32 + d], s = rs[(size_t)tok * 32 + d];
        q[0] = f2bf((t0 * c - t1 * s) * sc);
        q[32] = f2bf((t1 * c + t0 * s) * sc);
      }
    }
    __syncthreads();
    for (int idx = tid; idx < 32 * 128; idx += 512) {
      const int i = idx >> 7, j = idx & 127, tok = tk0 + i, col = 768 + j;
      float pv = bf2f(rw[(size_t)tok * 896 + col]);
      float pp = ((tok & (SEQ - 1)) != 0) ? bf2f(rw[(size_t)(tok - 1) * 896 + col]) : 0.f;
      float ps = pv + (pp - pv) * mu[col];
      float a = (j < 32) ? tanhf(ps) : (j < 64) ? ps : sigmoidf_(ps);
      act[i * 128 + j] = a;
    }
    __syncthreads();
    const int c = tid & 255, half = tid >> 8, h = c >> 6;
    {
      float* lora = act + 32 * 128;
      const int w8 = tid >> 6, ln = tid & 63, fr = ln & 15, fq = ln >> 4;
      const u16* w2t = (const u16*)(p.ws + OFF_WT + WT_W2T);
      const u16* a2t = (const u16*)(p.ws + OFF_WT + WT_A2T);
      const u16* g2t = (const u16*)(p.ws + OFF_WT + WT_G2T);
#pragma unroll
      for (int nbi = 0; nbi < 2; ++nbi) {
        const int col0 = (w8 * 2 + nbi) * 16;
        const bf16x8 bw = *reinterpret_cast<const bf16x8*>(w2t + (size_t)(col0 + fr) * 32 + fq * 8);
        const bf16x8 ba = *reinterpret_cast<const bf16x8*>(a2t + (size_t)(col0 + fr) * 32 + fq * 8);
        const bf16x8 bg0 = *reinterpret_cast<const bf16x8*>(g2t + (size_t)(col0 + fr) * 64 + fq * 8);
        const bf16x8 bg1 = *reinterpret_cast<const bf16x8*>(g2t + (size_t)(col0 + fr) * 64 + 32 + fq * 8);
#pragma unroll
        for (int mb = 0; mb < 2; ++mb) {
          const float* ap = act + (mb * 16 + fr) * 128 + fq * 8;
          bf16x8 af[4];
#pragma unroll
          for (int ks = 0; ks < 4; ++ks) {
            const float4 f0 = *reinterpret_cast<const float4*>(ap + ks * 32), f1 = *reinterpret_cast<const float4*>(ap + ks * 32 + 4);
            af[ks] = __builtin_bit_cast(bf16x8, (u32x4{pack2(f0.x, f0.y), pack2(f0.z, f0.w), pack2(f1.x, f1.y), pack2(f1.z, f1.w)}));
          }
          const f32x4 z4 = f32x4{0.f, 0.f, 0.f, 0.f};
          f32x4 dw = __builtin_amdgcn_mfma_f32_16x16x32_bf16(bw, af[0], z4, 0, 0, 0);
          f32x4 da = __builtin_amdgcn_mfma_f32_16x16x32_bf16(ba, af[1], z4, 0, 0, 0);
          f32x4 dg = __builtin_amdgcn_mfma_f32_16x16x32_bf16(bg0, af[2], z4, 0, 0, 0);
          dg = __builtin_amdgcn_mfma_f32_16x16x32_bf16(bg1, af[3], dg, 0, 0, 0);
          float* lp = lora + (mb * 16 + fr) * 256 + col0 + fq * 4;
          *reinterpret_cast<float4*>(lp) = make_float4(dw[0], dw[1], dw[2], dw[3]);
          *reinterpret_cast<float4*>(lp + 32 * 256) = make_float4(da[0], da[1], da[2], da[3]);
          *reinterpret_cast<float4*>(lp + 2 * 32 * 256) = make_float4(dg[0], dg[1], dg[2], dg[3]);
        }
      }
    }
    __syncthreads();
    float accw[16], acca[16], accg[16];
#pragma unroll
    for (int i = 0; i < 16; ++i) {
      const float* lp = act + 32 * 128 + (half * 16 + i) * 256 + c;
      accw[i] = lp[0]; acca[i] = lp[32 * 256]; accg[i] = lp[2 * 32 * 256];
    }
    const float mur = mu[c], muk = mu[256 + c], muv = mu[512 + c];
    const float w0c = w0[c], a0c = a0[c], kkc = k_k[c], kac = k_a[c], rkc = r_k[c];
#pragma unroll
    for (int i = 0; i < 16; ++i) {
      const int tok = tk0 + half * 16 + i;
      const bool has_prev = (tok & (SEQ - 1)) != 0;
      const u16* pr_ = rw + (size_t)tok * 896;
      float r0 = bf2f(pr_[c]), k0 = bf2f(pr_[256 + c]), v0 = bf2f(pr_[512 + c]);
      float r1 = 0.f, k1 = 0.f, v1 = 0.f;
      if (has_prev) { r1 = bf2f(pr_[c - 896]); k1 = bf2f(pr_[256 + c - 896]); v1 = bf2f(pr_[512 + c - 896]); }
      float r = r0 + (r1 - r0) * mur, k = k0 + (k1 - k0) * muk, v = v0 + (v1 - v0) * muv;
      float w = __expf(-0.6065306597126334f * sigmoidf_(w0c + accw[i]));
      float a = sigmoidf_(a0c + acca[i]);
      float kk = k * kkc;
      float ss = wave_sum(kk * kk);
      kk *= rsqrtf(fmaxf(ss, 1e-24f));
      float kp = k * (1.f + (a - 1.f) * kac);
      float bb = kk * a;
      float bo = wave_sum(r * kp * rkc);
      const int b = tok >> 12, t = tok & (SEQ - 1);
      char* rp = rec + ((size_t)((b * 4 + h) * SEQ + t)) * 1152;
      const int cc = c & 63;
      reinterpret_cast<float*>(rp)[cc] = w;
      reinterpret_cast<float*>(rp + 256)[cc] = kk;
      reinterpret_cast<float*>(rp + 512)[cc] = bb;
      reinterpret_cast<u16*>(rp + 768)[cc] = f2bf(kp);
      reinterpret_cast<u16*>(rp + 896)[cc] = f2bf(r);
      reinterpret_cast<u16*>(rp + 1024)[cc] = f2bf(v);
      gbuf[(size_t)tok * 256 + c] = f2bf(accg[i]);
      if (cc == 0) bonus[(size_t)tok * 4 + h] = bo;
    }
    __syncthreads();
  }
}

template <int DK, int DV, int NQB>
struct FlashWave {
  bf16x8 qf[NQB][DK / 32];
  f32x4 o[NQB][DV / 16];
  float m[NQB], l[NQB];
  DI void init() {
#pragma unroll
    for (int qb = 0; qb < NQB; ++qb) { m[qb] = -INFINITY; l[qb] = 0.f;
#pragma unroll
      for (int d = 0; d < DV / 16; ++d) o[qb][d] = f32x4{0.f, 0.f, 0.f, 0.f}; }
  }
  DI void tile(const u16* Ks, const u16* Vts) {
    constexpr int KSTR = DK + 8, VSTR = 72;
    const int lane = ltid() & 63, fr = lane & 15, fq = lane >> 4;
    float base[NQB];
#pragma unroll
    for (int qb = 0; qb < NQB; ++qb) base[qb] = (m[qb] == -INFINITY) ? 0.f : m[qb];
    f32x4 s[4][NQB];
    __builtin_amdgcn_s_setprio(1);
#pragma unroll
    for (int kb = 0; kb < 4; ++kb) {
#pragma unroll
      for (int qb = 0; qb < NQB; ++qb) s[kb][qb] = f32x4{-base[qb], -base[qb], -base[qb], -base[qb]};
#pragma unroll
      for (int ks = 0; ks < DK / 32; ++ks) {
        bf16x8 kf = *reinterpret_cast<const bf16x8*>(Ks + (kb * 16 + fr) * KSTR + ks * 32 + fq * 8);
#pragma unroll
        for (int qb = 0; qb < NQB; ++qb) s[kb][qb] = __builtin_amdgcn_mfma_f32_16x16x32_bf16(kf, qf[qb][ks], s[kb][qb], 0, 0, 0);
      }
    }
    __builtin_amdgcn_s_setprio(0);
    bf16x8 pf[NQB][2];
#pragma unroll
    for (int qb = 0; qb < NQB; ++qb) {
      float mx = -INFINITY;
#pragma unroll
      for (int kb = 0; kb < 4; ++kb) {
#pragma unroll
        for (int j = 0; j < 4; ++j) mx = fmaxf(mx, s[kb][qb][j]); }
      mx = fmaxf(mx, __shfl_xor(mx, 16));
      mx = fmaxf(mx, __shfl_xor(mx, 32));
      const float mn = fmaxf(m[qb], base[qb] + mx);
      const bool changed = __any(mn > m[qb]);
      float sum = 0.f;
      if (changed) {
        const float delta = mn - base[qb];
        const float alpha = __builtin_amdgcn_exp2f(m[qb] - mn);
#pragma unroll
        for (int kb = 0; kb < 4; ++kb) {
#pragma unroll
          for (int j = 0; j < 4; ++j) { float e = __builtin_amdgcn_exp2f(s[kb][qb][j] - delta); s[kb][qb][j] = e; sum += e; } }
        l[qb] = l[qb] * alpha + sum;
#pragma unroll
        for (int d = 0; d < DV / 16; ++d) { o[qb][d][0] *= alpha; o[qb][d][1] *= alpha; o[qb][d][2] *= alpha; o[qb][d][3] *= alpha; }
      } else {
#pragma unroll
        for (int kb = 0; kb < 4; ++kb) {
#pragma unroll
          for (int j = 0; j < 4; ++j) { float e = __builtin_amdgcn_exp2f(s[kb][qb][j]); s[kb][qb][j] = e; sum += e; } }
        l[qb] += sum;
      }
      m[qb] = mn;
#pragma unroll
      for (int k2 = 0; k2 < 2; ++k2) {
        u32x4 pk;
        pk[0] = pack2(s[2 * k2][qb][0], s[2 * k2][qb][1]); pk[1] = pack2(s[2 * k2][qb][2], s[2 * k2][qb][3]);
        pk[2] = pack2(s[2 * k2 + 1][qb][0], s[2 * k2 + 1][qb][1]); pk[3] = pack2(s[2 * k2 + 1][qb][2], s[2 * k2 + 1][qb][3]);
        pf[qb][k2] = __builtin_bit_cast(bf16x8, pk);
      }
    }
    __builtin_amdgcn_s_setprio(1);
#pragma unroll
    for (int k2 = 0; k2 < 2; ++k2) {
#pragma unroll
      for (int d = 0; d < DV / 16; ++d) {
        const u16* vp = Vts + (d * 16 + fr) * VSTR + k2 * 32 + fq * 4;
        const uint2 h0 = *reinterpret_cast<const uint2*>(vp);
        const uint2 h1 = *reinterpret_cast<const uint2*>(vp + 16);
        const bf16x8 vfv = __builtin_bit_cast(bf16x8, (u32x4{h0.x, h0.y, h1.x, h1.y}));
#pragma unroll
        for (int qb = 0; qb < NQB; ++qb) o[qb][d] = __builtin_amdgcn_mfma_f32_16x16x32_bf16(vfv, pf[qb][k2], o[qb][d], 0, 0, 0);
      }
    }
    __builtin_amdgcn_s_setprio(0);
  }
  DI float lsum(int qb) { float t = l[qb]; t += __shfl_xor(t, 16); t += __shfl_xor(t, 32); return t; }
};

DI void diff_attn_item(const PRef& p, int l, int b, int h, int qt) {
  extern __shared__ __attribute__((aligned(16))) u16 shm[];
  u16* Ks = shm;
  u16* Vts = shm + 2 * 64 * 72;
  float* comb = reinterpret_cast<float*>(shm + 2 * 64 * 72 + 128 * 72);
  const u16* qk = (const u16*)(p.ws + OFF_QK);
  const u16* vt = (const u16*)(p.ws + OFF_VT);
  u16* hcat = (u16*)(p.ws + OFF_HCAT);
  const int tid = ltid(), w = tid >> 6, lane = tid & 63, fr = lane & 15, fq = lane >> 4;
  const int n = w >> 2, qsub = w & 3;
  const int tok0 = b * SEQ + qt * 128;
  float lam;
  {
    float a1 = ((const float*)p.in[I_LQ1])[l * 64 + lane] * ((const float*)p.in[I_LK1])[l * 64 + lane];
    float a2 = ((const float*)p.in[I_LQ2])[l * 64 + lane] * ((const float*)p.in[I_LK2])[l * 64 + lane];
    a1 = wave_sum(a1); a2 = wave_sum(a2);
    lam = __expf(a1) - __expf(a2) + p.lam_init[l];
  }
  FlashWave<64, 128, 2> fw;
  fw.init();
#pragma unroll
  for (int qb = 0; qb < 2; ++qb)
#pragma unroll
    for (int ks = 0; ks < 2; ++ks)
    fw.qf[qb][ks] = *reinterpret_cast<const bf16x8*>(qk + (size_t)(tok0 + qsub * 32 + qb * 16 + fr) * 1024 + h * 128 + n * 64 + ks * 32 + fq * 8);
  const int nkt = 2 * qt + 2;
  const int my_last = 2 * qt + (qsub >> 1);
  uint4 kreg0, kreg1, vreg0, vreg1;
  const int seg0 = tid, seg1 = tid + 512;
  const u16* kbase0 = qk + (size_t)(b * SEQ + ((seg0 >> 3) & 63)) * 1024 + 512 + h * 128 + (seg0 >> 9) * 64 + (seg0 & 7) * 8;
  const u16* kbase1 = qk + (size_t)(b * SEQ + ((seg1 >> 3) & 63)) * 1024 + 512 + h * 128 + (seg1 >> 9) * 64 + (seg1 & 7) * 8;
  const u16* vbase0 = vt + (size_t)(h * 128 + (seg0 >> 3)) * NTOK + b * SEQ + (seg0 & 7) * 8;
  const u16* vbase1 = vt + (size_t)(h * 128 + (seg1 >> 3)) * NTOK + b * SEQ + (seg1 & 7) * 8;
  u16* kdst0 = Ks + ((seg0 >> 9) * 64 + ((seg0 >> 3) & 63)) * 72 + (seg0 & 7) * 8;
  u16* kdst1 = Ks + ((seg1 >> 9) * 64 + ((seg1 >> 3) & 63)) * 72 + (seg1 & 7) * 8;
  u16* vdst0 = Vts + (seg0 >> 3) * 72 + (seg0 & 7) * 8;
  u16* vdst1 = Vts + (seg1 >> 3) * 72 + (seg1 & 7) * 8;
#define load_tile(kt) do { \
    kreg0 = *reinterpret_cast<const uint4*>(kbase0 + (size_t)(kt) * 64 * 1024); \
    kreg1 = *reinterpret_cast<const uint4*>(kbase1 + (size_t)(kt) * 64 * 1024); \
    vreg0 = *reinterpret_cast<const uint4*>(vbase0 + (kt) * 64); \
    vreg1 = *reinterpret_cast<const uint4*>(vbase1 + (kt) * 64); } while (0)
#define store_tile() do { \
    *reinterpret_cast<uint4*>(kdst0) = kreg0; *reinterpret_cast<uint4*>(kdst1) = kreg1; \
    *reinterpret_cast<uint4*>(vdst0) = vreg0; *reinterpret_cast<uint4*>(vdst1) = vreg1; } while (0)
  load_tile(0);
  for (int kt = 0; kt < nkt; ++kt) {
    __syncthreads();
    store_tile();
    __syncthreads();
    if (kt + 1 < nkt) load_tile(kt + 1);
    if (kt <= my_last) fw.tile(Ks + n * 64 * 72, Vts);
  }
  float inv[2];
#pragma unroll
  for (int qb = 0; qb < 2; ++qb) inv[qb] = 1.f / fw.lsum(qb);
  __syncthreads();
  if (n == 1) {
#pragma unroll
    for (int qb = 0; qb < 2; ++qb)
#pragma unroll
      for (int d = 0; d < 8; ++d) {
      float4 v; v.x = fw.o[qb][d][0] * inv[qb]; v.y = fw.o[qb][d][1] * inv[qb]; v.z = fw.o[qb][d][2] * inv[qb]; v.w = fw.o[qb][d][3] * inv[qb];
      *reinterpret_cast<float4*>(&comb[(qsub * 32 + qb * 16 + fr) * 132 + d * 16 + fq * 4]) = v;
    }
  }
  __syncthreads();
  if (n == 0) {
    const float* sg = (const float*)p.in[I_SUBLN] + l * 128;
    const float post = 1.f - p.lam_init[l];
#pragma unroll
    for (int qb = 0; qb < 2; ++qb) {
      float ss = 0.f;
#pragma unroll
      for (int d = 0; d < 8; ++d) {
        float4 c2 = *reinterpret_cast<const float4*>(&comb[(qsub * 32 + qb * 16 + fr) * 132 + d * 16 + fq * 4]);
        fw.o[qb][d][0] = fw.o[qb][d][0] * inv[qb] - lam * c2.x;
        fw.o[qb][d][1] = fw.o[qb][d][1] * inv[qb] - lam * c2.y;
        fw.o[qb][d][2] = fw.o[qb][d][2] * inv[qb] - lam * c2.z;
        fw.o[qb][d][3] = fw.o[qb][d][3] * inv[qb] - lam * c2.w;
        for (int j = 0; j < 4; ++j) ss += fw.o[qb][d][j] * fw.o[qb][d][j];
      }
      ss += __shfl_xor(ss, 16); ss += __shfl_xor(ss, 32);
      const float rms = rsqrtf(ss * (1.f / 128.f) + 1e-6f) * post;
      u16* op = hcat + (size_t)(tok0 + qsub * 32 + qb * 16 + fr) * 1024 + h * 128;
#pragma unroll
      for (int d = 0; d < 8; ++d) {
        const int dv = d * 16 + fq * 4;
        uint2 ov;
        ov.x = pack2(fw.o[qb][d][0] * rms * sg[dv], fw.o[qb][d][1] * rms * sg[dv + 1]);
        ov.y = pack2(fw.o[qb][d][2] * rms * sg[dv + 2], fw.o[qb][d][3] * rms * sg[dv + 3]);
        *reinterpret_cast<uint2*>(op + dv) = ov;
      }
    }
  }
  __syncthreads();
}

#undef load_tile
#undef store_tile
DI void cross_attn_item(const PRef& p, int tokblk, int h) {
  extern __shared__ __attribute__((aligned(16))) u16 shm[];
  u16* Ks = shm;
  u16* Vts = shm + 64 * 264;
  const u16* qc = (const u16*)(p.ws + OFF_QC);
  const u16* km = (const u16*)(p.ws + OFF_KMEM);
  const u16* vm = (const u16*)(p.ws + OFF_VMEMT);
  u16* oc = (u16*)(p.ws + OFF_OC);
  const int tid = ltid(), w = tid >> 6, lane = tid & 63, fr = lane & 15, fq = lane >> 4;
  const int tok0 = tokblk * 128, b = tok0 >> 12;
  FlashWave<256, 256, 1> fw;
  fw.init();
#pragma unroll
  for (int ks = 0; ks < 8; ++ks)
    fw.qf[0][ks] = *reinterpret_cast<const bf16x8*>(qc + (size_t)(tok0 + w * 16 + fr) * 1024 + h * 256 + ks * 32 + fq * 8);
  uint4 kreg0, kreg1, kreg2, kreg3, vreg0, vreg1, vreg2, vreg3;
  const u16* kbase = km + (size_t)(b * 256 + (tid >> 5)) * 1024 + h * 256 + (tid & 31) * 8;
  const u16* vbase = vm + (size_t)(h * 256 + (tid >> 3)) * 2048 + b * 256 + (tid & 7) * 8;
  u16* kdst = Ks + (tid >> 5) * 264 + (tid & 31) * 8;
  u16* vdst = Vts + (tid >> 3) * 72 + (tid & 7) * 8;
#define load_tile(kt) do { \
    kreg0 = *reinterpret_cast<const uint4*>(kbase + (size_t)((kt) * 64 + 0) * 1024); \
    kreg1 = *reinterpret_cast<const uint4*>(kbase + (size_t)((kt) * 64 + 16) * 1024); \
    kreg2 = *reinterpret_cast<const uint4*>(kbase + (size_t)((kt) * 64 + 32) * 1024); \
    kreg3 = *reinterpret_cast<const uint4*>(kbase + (size_t)((kt) * 64 + 48) * 1024); \
    vreg0 = *reinterpret_cast<const uint4*>(vbase + (size_t)0 * 2048 + (kt) * 64); \
    vreg1 = *reinterpret_cast<const uint4*>(vbase + (size_t)64 * 2048 + (kt) * 64); \
    vreg2 = *reinterpret_cast<const uint4*>(vbase + (size_t)128 * 2048 + (kt) * 64); \
    vreg3 = *reinterpret_cast<const uint4*>(vbase + (size_t)192 * 2048 + (kt) * 64); } while (0)
#define store_tile() do { \
    *reinterpret_cast<uint4*>(kdst) = kreg0; *reinterpret_cast<uint4*>(kdst + 16 * 264) = kreg1; \
    *reinterpret_cast<uint4*>(kdst + 32 * 264) = kreg2; *reinterpret_cast<uint4*>(kdst + 48 * 264) = kreg3; \
    *reinterpret_cast<uint4*>(vdst) = vreg0; *reinterpret_cast<uint4*>(vdst + 64 * 72) = vreg1; \
    *reinterpret_cast<uint4*>(vdst + 128 * 72) = vreg2; *reinterpret_cast<uint4*>(vdst + 192 * 72) = vreg3; } while (0)
  load_tile(0);
  for (int kt = 0; kt < 4; ++kt) {
    __syncthreads();
    store_tile();
    __syncthreads();
    if (kt + 1 < 4) load_tile(kt + 1);
    fw.tile(Ks, Vts);
  }
  const float inv = 1.f / fw.lsum(0);
  u16* op = oc + (size_t)(tok0 + w * 16 + fr) * 1024 + h * 256;
#pragma unroll
  for (int d = 0; d < 16; ++d) {
    uint2 ov;
    ov.x = pack2(fw.o[0][d][0] * inv, fw.o[0][d][1] * inv);
    ov.y = pack2(fw.o[0][d][2] * inv, fw.o[0][d][3] * inv);
    *reinterpret_cast<uint2*>(op + d * 16 + fq * 4) = ov;
  }
  __syncthreads();
}

#undef load_tile
#undef store_tile
DI float row8_sum(float x) {
  x += dpp_f<0xB1>(x);
  x += dpp_f<0x4E>(x);
  x += dpp_f<0x141>(x);
  return x;
}
DI f32v2 bfpair(unsigned q) { f32v2 r; r.x = __uint_as_float(q << 16); r.y = __uint_as_float(q & 0xffff0000u); return r; }

DI void rwkv_scan_item(const PRef& p, int b, int h, int half) {
  extern __shared__ __attribute__((aligned(16))) u16 shm[];
  char* buf = reinterpret_cast<char*>(shm);
  float* ybuf = reinterpret_cast<float*>(buf + 2 * 16 * 1152);
  float* dummy = ybuf + 1024;
  const char* rec = p.ws + OFF_REC + (size_t)((b * 4 + h) * SEQ) * 1152;
  float* Y = (float*)(p.ws + OFF_Y);
  const int tid = ltid(), w = tid >> 6, lane = tid & 63;
  const int rl = (w & 3) * 8 + (lane >> 3);
  const int row = half * 32 + rl;
  const int ks = (lane & 7) * 8;
  const bool compute = w < 4;
  const bool leader = (lane & 7) == 0;
  float* ydst0 = leader ? (ybuf + rl) : (dummy + (tid & 255));
  const int ystride = leader ? 32 : 0;
  f32v2 S01 = {0.f, 0.f}, S23 = {0.f, 0.f}, S45 = {0.f, 0.f}, S67 = {0.f, 0.f};
  uint4 rg0, rg1, rg2 = make_uint4(0, 0, 0, 0);
  auto load_chunk = [&](int ch) {
    const uint4* src = reinterpret_cast<const uint4*>(rec + (size_t)ch * 16 * 1152);
    rg0 = src[tid]; rg1 = src[tid + 512];
    if (tid < 128) rg2 = src[tid + 1024];
  };
  load_chunk(0);
  __syncthreads();
  for (int ch = 0; ch < SEQ / 16; ++ch) {
    char* cb = buf + (ch & 1) * 16 * 1152;
    {
      uint4* dst = reinterpret_cast<uint4*>(cb);
      dst[tid] = rg0; dst[tid + 512] = rg1;
      if (tid < 128) dst[tid + 1024] = rg2;
    }
    __syncthreads();
    if (ch + 1 < SEQ / 16) load_chunk(ch + 1);
    if (ch > 0) {
      const float* ybp = ybuf + ((ch - 1) & 1) * 512;
      const int st = tid >> 5, r = tid & 31;
      Y[(size_t)(b * SEQ + (ch - 1) * 16 + st) * 256 + h * 64 + half * 32 + r] = ybp[tid];
    }
    if (compute) {
      float* yd = ydst0 + (leader ? (ch & 1) * 512 : 0);
      const char* sp = cb;
      float4 wa = *reinterpret_cast<const float4*>(sp + ks * 4), wb = *reinterpret_cast<const float4*>(sp + ks * 4 + 16);
      float4 ka = *reinterpret_cast<const float4*>(sp + 256 + ks * 4), kb = *reinterpret_cast<const float4*>(sp + 256 + ks * 4 + 16);
      float4 ba = *reinterpret_cast<const float4*>(sp + 512 + ks * 4), bbv = *reinterpret_cast<const float4*>(sp + 512 + ks * 4 + 16);
      uint4 kq = *reinterpret_cast<const uint4*>(sp + 768 + ks * 2);
      uint4 rq = *reinterpret_cast<const uint4*>(sp + 896 + ks * 2);
      unsigned vq = *reinterpret_cast<const u16*>(sp + 1024 + row * 2);
#pragma unroll
      for (int st = 0; st < 16; ++st) {
        float4 wan, wbn, kan, kbn, ban, bbn; uint4 kqn, rqn; unsigned vqn;
        if (st < 15) {
          const char* sn = cb + (st + 1) * 1152;
          wan = *reinterpret_cast<const float4*>(sn + ks * 4); wbn = *reinterpret_cast<const float4*>(sn + ks * 4 + 16);
          kan = *reinterpret_cast<const float4*>(sn + 256 + ks * 4); kbn = *reinterpret_cast<const float4*>(sn + 256 + ks * 4 + 16);
          ban = *reinterpret_cast<const float4*>(sn + 512 + ks * 4); bbn = *reinterpret_cast<const float4*>(sn + 512 + ks * 4 + 16);
          kqn = *reinterpret_cast<const uint4*>(sn + 768 + ks * 2);
          rqn = *reinterpret_cast<const uint4*>(sn + 896 + ks * 2);
          vqn = *reinterpret_cast<const u16*>(sn + 1024 + row * 2);
        }
        const float v = __uint_as_float(vq << 16);
        const f32v2 vv = {v, v};
        const f32v2 kk01 = {ka.x, ka.y}, kk23 = {ka.z, ka.w}, kk45 = {kb.x, kb.y}, kk67 = {kb.z, kb.w};
        f32v2 sa2 = S01 * kk01 + S23 * kk23;
        f32v2 sb2 = S45 * kk45 + S67 * kk67;
        sa2 += sb2;
        float sa = row8_sum(sa2.x + sa2.y);
        const f32v2 sav = {sa, sa};
        S01 = S01 * f32v2{wa.x, wa.y} - sav * f32v2{ba.x, ba.y} + vv * bfpair(kq.x);
        S23 = S23 * f32v2{wa.z, wa.w} - sav * f32v2{ba.z, ba.w} + vv * bfpair(kq.y);
        S45 = S45 * f32v2{wb.x, wb.y} - sav * f32v2{bbv.x, bbv.y} + vv * bfpair(kq.z);
        S67 = S67 * f32v2{wb.z, wb.w} - sav * f32v2{bbv.z, bbv.w} + vv * bfpair(kq.w);
        f32v2 ya = S01 * bfpair(rq.x) + S23 * bfpair(rq.y);
        f32v2 yb2 = S45 * bfpair(rq.z) + S67 * bfpair(rq.w);
        ya += yb2;
        float y = row8_sum(ya.x + ya.y);
        yd[st * ystride] = y;
        if (st < 15) { wa = wan; wb = wbn; ka = kan; kb = kbn; ba = ban; bbv = bbn; kq = kqn; rq = rqn; vq = vqn; }
      }
    }
  }
  __syncthreads();
  {
    const int ch = SEQ / 16 - 1;
    const float* ybp = ybuf + (ch & 1) * 512;
    const int st = tid >> 5, r = tid & 31;
    Y[(size_t)(b * SEQ + ch * 16 + st) * 256 + h * 64 + half * 32 + r] = ybp[tid];
  }
  __syncthreads();
}

DI float gelu_tanh(float x) {
  float u = 0.7978845608028654f * (x + 0.044715f * x * x * x);
  return 0.5f * x * (1.f + tanhf(u));
}
DI void s5_item(const PRef& p, int l, int b, int g) {
  extern __shared__ __attribute__((aligned(16))) u16 shm[];
  float* uL = reinterpret_cast<float*>(shm);
  float* fin = uL + 8 * 256;
  float* xL = fin + 8 * 128;
  const u16* s5 = (const u16*)(p.ws + OFF_S5);
  u16* Z = (u16*)(p.ws + OFF_Z);
  const int tid = ltid(), w = tid >> 6, lane = tid & 63;
  const float Are = ((const float*)p.in[I_SARE])[(l * 16 + g) * 64 + lane];
  const float Aim = ((const float*)p.in[I_SAIM])[(l * 16 + g) * 64 + lane];
  const float delta = expf(((const float*)p.in[I_SLOG])[l * 16 + g]);
  float cr, ci;
  {
    float er = expf(delta * Are); float sn, cs; sincosf(delta * Aim, &sn, &cs);
    cr = er * cs; ci = er * sn;
  }
  float Bre[16], Bim[16];
  {
    const float x = cr - 1.f, y = ci, den = 1.f / (Are * Are + Aim * Aim);
    const float qre = (x * Are + y * Aim) * den, qim = (y * Are - x * Aim) * den;
    const float* bre = (const float*)p.in[I_SBRE] + ((size_t)(l * 16 + g) * 64 + lane) * 16;
    const float* bim = (const float*)p.in[I_SBIM] + ((size_t)(l * 16 + g) * 64 + lane) * 16;
#pragma unroll
    for (int hh = 0; hh < 16; ++hh) { float br = bre[hh], bi = bim[hh]; Bre[hh] = qre * br - qim * bi; Bim[hh] = qre * bi + qim * br; }
  }
  __syncthreads();
  bf16x8 cf[4];
  {
    const int hq = lane & 15, q4 = lane >> 4;
    const float* cre = (const float*)p.in[I_SCRE] + ((size_t)(l * 16 + g) * 16 + hq) * 64;
    const float* cim = (const float*)p.in[I_SCIM] + ((size_t)(l * 16 + g) * 16 + hq) * 64;
#pragma unroll
    for (int s4 = 0; s4 < 4; ++s4) {
      const float4 re = *reinterpret_cast<const float4*>(cre + 16 * s4 + 4 * q4);
      const float4 im = *reinterpret_cast<const float4*>(cim + 16 * s4 + 4 * q4);
      cf[s4] = __builtin_bit_cast(bf16x8, (u32x4{pack2(re.x, -im.x), pack2(re.y, -im.y), pack2(re.z, -im.z), pack2(re.w, -im.w)}));
    }
  }
  const int tbase = b * SEQ + w * 512;
  float* uw = uL + w * 256;
  auto load_u = [&](int ch) {
    const int tt = lane >> 2, c4 = (lane & 3) * 4;
    uint2 raw = *reinterpret_cast<const uint2*>(s5 + (size_t)(tbase + ch * 16 + tt) * 256 + g * 16 + c4);
    float4 f; f.x = __uint_as_float(raw.x << 16); f.y = __uint_as_float(raw.x & 0xffff0000u);
    f.z = __uint_as_float(raw.y << 16); f.w = __uint_as_float(raw.y & 0xffff0000u);
    *reinterpret_cast<float4*>(uw + tt * 16 + c4) = f;
  };
  float xr = 0.f, xi = 0.f;
  for (int ch = 0; ch < 32; ++ch) {
    __syncthreads();
    load_u(ch);
    __syncthreads();
#pragma unroll 4
    for (int tt = 0; tt < 16; ++tt) {
      float bur = 0.f, bui = 0.f;
#pragma unroll
      for (int h4 = 0; h4 < 4; ++h4) {
        float4 u = *reinterpret_cast<const float4*>(uw + tt * 16 + h4 * 4);
        bur += Bre[h4 * 4] * u.x + Bre[h4 * 4 + 1] * u.y + Bre[h4 * 4 + 2] * u.z + Bre[h4 * 4 + 3] * u.w;
        bui += Bim[h4 * 4] * u.x + Bim[h4 * 4 + 1] * u.y + Bim[h4 * 4 + 2] * u.z + Bim[h4 * 4 + 3] * u.w;
      }
      float nr = cr * xr - ci * xi + bur, ni = cr * xi + ci * xr + bui;
      xr = nr; xi = ni;
    }
  }
  fin[(w * 64 + lane) * 2] = xr; fin[(w * 64 + lane) * 2 + 1] = xi;
  __syncthreads();
  {
    float pr = cr, pi = ci;
    for (int i = 0; i < 9; ++i) { float nr = pr * pr - pi * pi, ni = 2.f * pr * pi; pr = nr; pi = ni; }
    float vr = 0.f, vi = 0.f;
    for (int ww = 0; ww < w; ++ww) {
      float fr_ = fin[(ww * 64 + lane) * 2], fi_ = fin[(ww * 64 + lane) * 2 + 1];
      float nr = pr * vr - pi * vi + fr_, ni = pr * vi + pi * vr + fi_;
      vr = nr; vi = ni;
    }
    xr = vr; xi = vi;
  }
  float* xw = xL + w * (16 * 66 * 2);
  const int ot = lane & 15, oh = (lane >> 4) * 4;
  const float* dsk = (const float*)p.in[I_SD] + l * 256 + g * 16 + oh;
  const float d0 = dsk[0], d1 = dsk[1], d2 = dsk[2], d3 = dsk[3];
  for (int ch = 0; ch < 32; ++ch) {
    __syncthreads();
    load_u(ch);
    __syncthreads();
#pragma unroll 4
    for (int tt = 0; tt < 16; ++tt) {
      float bur = 0.f, bui = 0.f;
#pragma unroll
      for (int h4 = 0; h4 < 4; ++h4) {
        float4 u = *reinterpret_cast<const float4*>(uw + tt * 16 + h4 * 4);
        bur += Bre[h4 * 4] * u.x + Bre[h4 * 4 + 1] * u.y + Bre[h4 * 4 + 2] * u.z + Bre[h4 * 4 + 3] * u.w;
        bui += Bim[h4 * 4] * u.x + Bim[h4 * 4 + 1] * u.y + Bim[h4 * 4 + 2] * u.z + Bim[h4 * 4 + 3] * u.w;
      }
      float nr = cr * xr - ci * xi + bur, ni = cr * xi + ci * xr + bui;
      xr = nr; xi = ni;
      *reinterpret_cast<float2*>(xw + (tt * 66 + lane) * 2) = make_float2(xr, xi);
    }
    __syncthreads();
    f32x4 yacc = f32x4{0.f, 0.f, 0.f, 0.f};
#pragma unroll
    for (int s4 = 0; s4 < 4; ++s4) {
      const float* xp = xw + (ot * 66 + 16 * s4 + oh) * 2;
      const float4 f0 = *reinterpret_cast<const float4*>(xp), f1 = *reinterpret_cast<const float4*>(xp + 4);
      const bf16x8 xf = __builtin_bit_cast(bf16x8, (u32x4{pack2(f0.x, f0.y), pack2(f0.z, f0.w), pack2(f1.x, f1.y), pack2(f1.z, f1.w)}));
      yacc = __builtin_amdgcn_mfma_f32_16x16x32_bf16(cf[s4], xf, yacc, 0, 0, 0);
    }
    float a0 = yacc[0], a1 = yacc[1], a2 = yacc[2], a3 = yacc[3];
    float4 u = *reinterpret_cast<const float4*>(uw + ot * 16 + oh);
    a0 = gelu_tanh(a0 + d0 * u.x); a1 = gelu_tanh(a1 + d1 * u.y); a2 = gelu_tanh(a2 + d2 * u.z); a3 = gelu_tanh(a3 + d3 * u.w);
    uint2 ov; ov.x = pack2(a0, a1); ov.y = pack2(a2, a3);
    *reinterpret_cast<uint2*>(Z + (size_t)(tbase + ch * 16 + ot) * 256 + g * 16 + oh) = ov;
  }
  __syncthreads();
}

DI void phase_mixers(const PRef& p, int lc) {
  __shared__ int s_item;
  unsigned* cnt = (unsigned*)(p.ws + OFF_CNT) + lc;
  const int l = lc & 7;
  const int total = 64 + 128 + 1024;
  while (true) {
    __syncthreads();
    if (ltid() == 0) s_item = (int)atomicAdd(cnt, 1u);
    __syncthreads();
    const int item = s_item;
    if (item >= total) break;
    kaptr_t ka2 = p.in.ka; asm volatile("" : "+s"(ka2)); const PRef q(ka2);
    const int cls = (lc >= 8) ? (PROBE_DUP >> 4) : 7;
    if (item < 64) { if (cls & 1) rwkv_scan_item(q, item >> 3, (item >> 1) & 3, item & 1); }
    else if (item < 192) { int i = item - 64; if (cls & 2) s5_item(q, l, i >> 4, i & 15); }
    else { int i = item - 192; int qt = 31 - (i >> 5); int bh = i & 31; if (cls & 4) diff_attn_item(q, l, bh >> 2, bh & 3, qt); }
  }
}

DI void phase_post(const PRef& p, int l) {
  const float* Y = (const float*)(p.ws + OFF_Y);
  const u16* gbuf = (const u16*)(p.ws + OFF_G);
  const u16* Z = (const u16*)(p.ws + OFF_Z);
  const float* bonus = (const float*)(p.ws + OFF_BONUS);
  const char* rec = p.ws + OFF_REC;
  u16* hcat = (u16*)(p.ws + OFF_HCAT);
  const u16* glut = (const u16*)(p.ws + OFF_WT + WT_GLU);
  const float* lng = (const float*)p.in[I_LNXG] + l * 256;
  const float* lnb = (const float*)p.in[I_LNXB] + l * 256;
  const float* glub = (const float*)p.in[I_GLUB] + l * 256;
  const float* outg = (const float*)p.in[I_SOUTG] + l * 256;
  const int tid = ltid(), w = tid >> 6, lane = tid & 63, fr = lane & 15, fq = lane >> 4;
  for (int item = blockIdx.x; item < NTOK / 128; item += gridDim.x) {
    const int tk0 = item * 128;
    {
      const int c = tid & 255, half = tid >> 8, h = c >> 6, cc = c & 63;
      const float gw = lng[c], gb = lnb[c];
      for (int i0 = 0; i0 < 64; i0 += 8) {
        float yv[8], vv[8], gq[8], bo[8];
#pragma unroll
        for (int u = 0; u < 8; ++u) {
          const int tok = tk0 + half * 64 + i0 + u;
          const int b = tok >> 12, t = tok & (SEQ - 1);
          const char* rp = rec + ((size_t)((b * 4 + h) * SEQ + t)) * 1152;
          yv[u] = Y[(size_t)tok * 256 + c];
          vv[u] = bf2f(reinterpret_cast<const u16*>(rp + 1024)[cc]);
          gq[u] = bf2f(gbuf[(size_t)tok * 256 + c]);
          bo[u] = bonus[(size_t)tok * 4 + h];
        }
        float mean[8], var[8];
#pragma unroll
        for (int u = 0; u < 8; ++u) { float t = row16_sum(yv[u]); t += __shfl_xor(t, 16); t += __shfl_xor(t, 32); mean[u] = t * (1.f / 64.f); }
#pragma unroll
        for (int u = 0; u < 8; ++u) { float d = yv[u] - mean[u]; float t = row16_sum(d * d); t += __shfl_xor(t, 16); t += __shfl_xor(t, 32); var[u] = t * (1.f / 64.f); }
#pragma unroll
        for (int u = 0; u < 8; ++u) {
          const int tok = tk0 + half * 64 + i0 + u;
          float out = (yv[u] - mean[u]) * rsqrtf(var[u] + 64e-5f) * gw + gb + bo[u] * vv[u];
          out *= gq[u];
          hcat[(size_t)tok * 1024 + 512 + c] = f2bf(out);
        }
      }
    }
    {
      const int tokw = tk0 + w * 16;
      bf16x8 zf[8];
#pragma unroll
      for (int s = 0; s < 8; ++s) zf[s] = *reinterpret_cast<const bf16x8*>(Z + (size_t)(tokw + fr) * 256 + s * 32 + fq * 8);
      float ss = 0.f, rms = 0.f;
      for (int pass = 0; pass < 2; ++pass) {
#pragma unroll 2
        for (int nb = 0; nb < 16; ++nb) {
          f32x4 acc = f32x4{0.f, 0.f, 0.f, 0.f};
#pragma unroll
          for (int s = 0; s < 8; ++s) {
            bf16x8 wf = *reinterpret_cast<const bf16x8*>(glut + (size_t)(nb * 16 + fr) * 256 + s * 32 + fq * 8);
            acc = __builtin_amdgcn_mfma_f32_16x16x32_bf16(wf, zf[s], acc, 0, 0, 0);
          }
          const int col = nb * 16 + fq * 4;
          uint2 zr = *reinterpret_cast<const uint2*>(Z + (size_t)(tokw + fr) * 256 + col);
          float z0 = __uint_as_float(zr.x << 16), z1 = __uint_as_float(zr.x & 0xffff0000u);
          float z2 = __uint_as_float(zr.y << 16), z3 = __uint_as_float(zr.y & 0xffff0000u);
          float o0 = z0 * sigmoidf_(acc[0] + glub[col]), o1 = z1 * sigmoidf_(acc[1] + glub[col + 1]);
          float o2 = z2 * sigmoidf_(acc[2] + glub[col + 2]), o3 = z3 * sigmoidf_(acc[3] + glub[col + 3]);
          if (pass == 0) ss += o0 * o0 + o1 * o1 + o2 * o2 + o3 * o3;
          else {
            uint2 ov;
            ov.x = pack2(o0 * rms * outg[col], o1 * rms * outg[col + 1]);
            ov.y = pack2(o2 * rms * outg[col + 2], o3 * rms * outg[col + 3]);
            *reinterpret_cast<uint2*>(hcat + (size_t)(tokw + fr) * 1024 + 768 + col) = ov;
          }
        }
        if (pass == 0) { ss += __shfl_xor(ss, 16); ss += __shfl_xor(ss, 32); rms = rsqrtf(ss * (1.f / 256.f) + 1e-6f); }
      }
    }
  }
}

DI void phase_ln(const PRef& p, const float* g, const float* bta) {
  float* xs = p.xs; u16* xb = (u16*)(p.ws + OFF_XB);
  const int w = ltid() >> 6, lane = ltid() & 63;
  for (int tok = blockIdx.x * 8 + w; tok < NTOK; tok += gridDim.x * 8) {
    float4* row = reinterpret_cast<float4*>(xs + (size_t)tok * DM);
    float4 v[4]; float s = 0.f;
    for (int i = 0; i < 4; ++i) { v[i] = row[lane + i * 64]; s += v[i].x + v[i].y + v[i].z + v[i].w; }
    const float mean = wave_sum(s) * (1.f / 1024.f);
    float q = 0.f;
    for (int i = 0; i < 4; ++i) { float a = v[i].x - mean, b = v[i].y - mean, c = v[i].z - mean, d = v[i].w - mean; q += a * a + b * b + c * c + d * d; }
    const float rstd = rsqrtf(wave_sum(q) * (1.f / 1024.f) + 1e-5f);
    for (int i = 0; i < 4; ++i) {
      const int col = (lane + i * 64) * 4;
      float4 gg = *reinterpret_cast<const float4*>(g + col), bb = *reinterpret_cast<const float4*>(bta + col);
      float4 o;
      o.x = (v[i].x - mean) * rstd * gg.x + bb.x; o.y = (v[i].y - mean) * rstd * gg.y + bb.y;
      o.z = (v[i].z - mean) * rstd * gg.z + bb.z; o.w = (v[i].w - mean) * rstd * gg.w + bb.w;
      row[lane + i * 64] = o;
      uint2 ob; ob.x = pack2(o.x, o.y); ob.y = pack2(o.z, o.w);
      *reinterpret_cast<uint2*>(xb + (size_t)tok * DM + col) = ob;
    }
  }
}

DI void phase_conv(const PRef& p, int l) {
  char* ws = p.ws;
  u16* hmid = (u16*)(ws + OFF_AG);
  const float* af = (const float*)(ws + OFF_AF); const float* gf = (const float*)(ws + OFF_GF); const float* al = (const float*)(ws + OFF_AL);
  const float* cw = (const float*)p.in[I_CONVW] + (size_t)l * 3 * DFF;
  const float* cb = (const float*)p.in[I_CONVB] + (size_t)l * DFF;
  for (int it = blockIdx.x * 512 + ltid(); it < 128 * DFF; it += gridDim.x * 512) {
    const int pm = it / DFF, c = it % DFF;
    const float a0 = af[(size_t)(pm * 2) * DFF + c], a1 = af[(size_t)(pm * 2 + 1) * DFF + c];
    const float g0 = gf[(size_t)(pm * 2) * DFF + c], g1 = gf[(size_t)(pm * 2 + 1) * DFF + c];
    float l0 = 0.f, l1 = 0.f;
    if ((pm & 15) != 0) { l0 = al[(size_t)((pm - 1) * 2) * DFF + c]; l1 = al[(size_t)((pm - 1) * 2 + 1) * DFF + c]; }
    const float w0 = cw[c], w1 = cw[DFF + c], w2 = cw[2 * DFF + c], bs = cb[c];
    const float cv0 = bs + w0 * l0 + w1 * l1 + w2 * a0;
    const float cv1 = bs + w0 * l1 + w1 * a0 + w2 * a1;
    hmid[(size_t)(pm * 256) * DFF + c] = f2bf(cv0 * sigmoidf_(cv0) * g0);
    hmid[(size_t)(pm * 256 + 1) * DFF + c] = f2bf(cv1 * sigmoidf_(cv1) * g1);
  }
}

DI void phase_gemm(const PRef& p, int kind, int l) {
  int nN = 4, K = 1024, lda = 1024, ldb = 1024;
  if (kind == 0) nN = 9;
  if (kind == 10) nN = 22;
  if (kind == 12) { lda = 2816; ldb = 2816; K = 2816; }
  const int ntile = 128 * nN;
  const bool remap = (gridDim.x & 7) == 0;
  const int per = remap ? (ntile >> 3) : ntile, xcd = blockIdx.x & 7;
  const int slot = remap ? (int)(blockIdx.x >> 3) : (int)blockIdx.x, nslot = remap ? (int)(gridDim.x >> 3) : (int)gridDim.x;
  const int n_main = (slot < per) ? (per - slot + nslot - 1) / nslot : 0;
  const int t0x = remap ? (int)((((blockIdx.x >> 3) + 16) & 31) * 8 + (blockIdx.x & 7)) : (int)blockIdx.x;
  const int n_extra = (kind == 0 && t0x < 320) ? (320 - t0x + (int)gridDim.x - 1) / (int)gridDim.x : 0;
  const kaptr_t ka = p.in.ka;
  auto tile_fn = [&](int idx) -> TileDesc {
    const PRef q(ka);
    char* ws = q.ws; char* wt = ws + OFF_WT;
    const u16* xb = (const u16*)(ws + OFF_XB);
    TileDesc d; d.sub = 0; d.A = xb;
    if (idx < n_main) {
      const int jj = slot + idx * nslot;
      const int t = remap ? xcd * per + jj : jj;
      int pm = t / nN, pn = t % nN;
      if (kind == 0) { d.B = (const u16*)(wt + WT_IN); pn = (pn < 4) ? pn : pn + 2; }
      else if (kind == 4) { d.A = (const u16*)(ws + OFF_HCAT); d.B = (const u16*)(wt + WT_OUT); }
      else if (kind == 6) d.B = (const u16*)(wt + WT_Q);
      else if (kind == 8) { d.A = (const u16*)(ws + OFF_OC); d.B = (const u16*)(wt + WT_O); }
      else if (kind == 10) d.B = (const u16*)(wt + WT_UP);
      else { d.A = (const u16*)(ws + OFF_AG); d.B = (const u16*)(wt + WT_DOWN); }
      d.brow = pm * 256; d.bcol = pn * 256;
    } else {
      const int t = t0x + (idx - n_main) * (int)gridDim.x;
      const u16* wint = (const u16*)(wt + WT_IN); const u16* wkvt = (const u16*)(wt + WT_KV); const u16* memb = (const u16*)(ws + OFF_MEMB);
      int pm, pn;
      if (t < 256) { pn = t >> 1; pm = t & 1; d.A = wint + (size_t)1024 * 1024; d.B = xb; d.sub = 1; }
      else if (t < 288) { int i = t - 256; pm = i >> 2; pn = i & 3; d.A = memb; d.B = wkvt; d.sub = 2; }
      else { int i = t - 288; pm = i >> 3; pn = i & 7; d.A = wkvt + (size_t)1024 * 1024; d.B = memb; d.sub = 3; }
      d.brow = pm * 256; d.bcol = pn * 256;
    }
    return d;
  };
  EpiGen e; e.kind = kind; e.lay = l; e.ka = ka;
  gemm_stream(n_main + n_extra, lda, ldb, K, tile_fn, e);
}
DI void phase_cross(const PRef& p) {
  for (int it = blockIdx.x; it < 1024; it += gridDim.x) cross_attn_item(p, it >> 2, it & 3);
}

constexpr int PH_PER_LAYER = 14, N_PHASES = 1 + DEPTH * PH_PER_LAYER;

DI void run_phase(const PRef& p, int ph) {
  if (ph == 0) { phase_init(p); phase_transposes(p, 0); return; }
  const int l = (ph - 1) / PH_PER_LAYER, s = (ph - 1) % PH_PER_LAYER;
  if (s == 0 || s == 4 || s == 6 || s == 8 || s == 10 || s == 12) {
    phase_gemm(p, s, l);
    if ((PROBE_DUP & 1) && (s == 0 || s == 6 || s == 10)) phase_gemm(p, s, l);
    return;
  }
  switch (s) {
    case 1: phase_prep(p, l); break;
    case 2: phase_mixers(p, l); if (PROBE_DUP & 2) phase_mixers(p, l + 8); break;
    case 3: phase_post(p, l); if (PROBE_DUP & 8) phase_post(p, l); break;
    case 5: phase_ln(p, (const float*)p.in[I_LN1G] + l * DM, (const float*)p.in[I_LN1B] + l * DM); break;
    case 7: phase_cross(p); if (PROBE_DUP & 4) phase_cross(p); break;
    case 9: phase_ln(p, (const float*)p.in[I_LN2G] + l * DM, (const float*)p.in[I_LN2B] + l * DM); break;
    case 11: phase_conv(p, l); break;
    case 13:
      phase_ln(p, (const float*)p.in[I_LN3G] + l * DM, (const float*)p.in[I_LN3B] + l * DM);
      if (l + 1 < DEPTH) phase_transposes(p, l + 1);
      break;
  }
}

template <int S>
__global__ void __launch_bounds__(512) ph_kernel(Params p_unused, int l) {
  kaptr_t ka = (kaptr_t)__builtin_amdgcn_kernarg_segment_ptr();
  const PRef p(ka);
  if (S < 0) { phase_init(p); phase_transposes(p, 0); return; }
  if (S == 0 || S == 4 || S == 6 || S == 8 || S == 10 || S == 12) { phase_gemm(p, S, l); return; }
  if (S == 1) phase_prep(p, l);
  if (S == 2) phase_mixers(p, l);
  if (S == 3) phase_post(p, l);
  if (S == 5) phase_ln(p, (const float*)p.in[I_LN1G] + l * DM, (const float*)p.in[I_LN1B] + l * DM);
  if (S == 7) phase_cross(p);
  if (S == 9) phase_ln(p, (const float*)p.in[I_LN2G] + l * DM, (const float*)p.in[I_LN2B] + l * DM);
  if (S == 11) phase_conv(p, l);
  if (S == 13) {
    phase_ln(p, (const float*)p.in[I_LN3G] + l * DM, (const float*)p.in[I_LN3B] + l * DM);
    if (l + 1 < DEPTH) phase_transposes(p, l + 1);
  }
}

#if !MULTI_LAUNCH
__device__ unsigned g_bar = 0;
#ifndef USE_COOP
#define USE_COOP 1
#endif

__global__ void __launch_bounds__(512) fwd_kernel(Params p_unused, int ph_begin, int ph_end) {
#if USE_COOP
  cg::this_grid().sync();
#endif
  __shared__ unsigned s_base;
  for (int ph = ph_begin; ph < ph_end; ++ph) {
    kaptr_t ka = (kaptr_t)__builtin_amdgcn_kernarg_segment_ptr();
    asm volatile("" : "+s"(ka));
    const PRef p(ka);
    run_phase(p, ph);
    if (ph + 1 < ph_end) {
      asm volatile("s_waitcnt vmcnt(0) lgkmcnt(0)" ::: "memory");
      __syncthreads();
      if (threadIdx.x == 0) {
        __builtin_amdgcn_fence(__ATOMIC_RELEASE, "agent");
        asm volatile("s_waitcnt vmcnt(0)" ::: "memory");
        const unsigned nbar = (unsigned)(ph - ph_begin + 1);
        unsigned old = __hip_atomic_fetch_add(&g_bar, 1u, __ATOMIC_RELAXED, __HIP_MEMORY_SCOPE_AGENT);
        if (nbar == 1) { const unsigned per_launch = (unsigned)(ph_end - ph_begin - 1) * gridDim.x; s_base = old - (old % per_launch); }
        const unsigned target = s_base + nbar * gridDim.x;
        while ((int)(__hip_atomic_load(&g_bar, __ATOMIC_RELAXED, __HIP_MEMORY_SCOPE_AGENT) - target) < 0) __builtin_amdgcn_s_sleep(4);
        __builtin_amdgcn_fence(__ATOMIC_ACQUIRE, "agent");
        asm volatile("s_waitcnt vmcnt(0)" ::: "memory");
      }
      __syncthreads();
    }
  }
}
#endif

constexpr size_t kDynLds = 131072 + 4096;

template <int S> static void launch_ph(const Params& p, int l, int grid, hipStream_t stream) {
  static bool attr_done = false;
  if (!attr_done) { (void)hipFuncSetAttribute((const void*)ph_kernel<S>, hipFuncAttributeMaxDynamicSharedMemorySize, (int)kDynLds); attr_done = true; }
  hipLaunchKernelGGL(ph_kernel<S>, dim3(grid), dim3(512), kDynLds, stream, p, l);
}

extern "C" void kernel_launch(void* const* d_in, const int* in_sizes, int n_in, void* d_out, int out_size, void* d_ws, size_t ws_size,
                              hipStream_t stream) {
  Params p;
  memset(&p, 0, sizeof(p));
  for (int i = 0; i < N_IN && i < n_in; ++i) p.in[i] = d_in[i];
  p.xs = (float*)d_out;
  p.ws = (char*)d_ws;
  for (int l = 0; l < 4; ++l) p.lam_init[l] = (float)(0.8 - 0.6 * exp(-0.3 * (double)l));
#if MULTI_LAUNCH
  const int grid = 256;
  launch_ph<-1>(p, 0, grid, stream);
  for (int l = 0; l < DEPTH; ++l) {
    launch_ph<0>(p, l, grid, stream); launch_ph<1>(p, l, grid, stream); launch_ph<2>(p, l, grid, stream); launch_ph<3>(p, l, grid, stream);
    launch_ph<4>(p, l, grid, stream); launch_ph<5>(p, l, grid, stream); launch_ph<6>(p, l, grid, stream); launch_ph<7>(p, l, grid, stream);
    launch_ph<8>(p, l, grid, stream); launch_ph<9>(p, l, grid, stream); launch_ph<10>(p, l, grid, stream); launch_ph<11>(p, l, grid, stream);
    launch_ph<12>(p, l, grid, stream); launch_ph<13>(p, l, grid, stream);
  }
#else
  static int grid_blocks = 0;
  if (!grid_blocks) {
    (void)hipFuncSetAttribute((const void*)fwd_kernel, hipFuncAttributeMaxDynamicSharedMemorySize, (int)kDynLds);
    int dev = 0, cus = 0, per_cu = 0;
    (void)hipGetDevice(&dev);
    (void)hipDeviceGetAttribute(&cus, hipDeviceAttributeMultiprocessorCount, dev);
    (void)hipOccupancyMaxActiveBlocksPerMultiprocessor(&per_cu, fwd_kernel, 512, kDynLds);
    if (per_cu < 1) per_cu = 1;
    grid_blocks = cus * per_cu;
    if (grid_blocks <= 0) grid_blocks = 256;
    if (per_cu > 1) grid_blocks = cus;
  }
  int b = 0, e = N_PHASES;
#if USE_COOP
  void* args[] = {&p, &b, &e};
  hipError_t err = hipLaunchCooperativeKernel((void*)fwd_kernel, dim3(grid_blocks), dim3(512), args, kDynLds, stream);
  if (err != hipSuccess) fprintf(stderr, "cooperative launch failed: %s (grid %d)\n", hipGetErrorString(err), grid_blocks);
#else
#ifdef BISECT_PER_PHASE
  for (int ph = 0; ph < N_PHASES; ++ph) hipLaunchKernelGGL(fwd_kernel, dim3(grid_blocks), dim3(512), kDynLds, stream, p, ph, ph + 1);
#else
  hipLaunchKernelGGL(fwd_kernel, dim3(grid_blocks), dim3(512), kDynLds, stream, p, b, e);
#endif
#endif
#endif
}
```

```cpp
#include <hip/hip_runtime.h>
#include <hip/hip_bf16.h>
#include <hip/hip_cooperative_groups.h>
#include <cstdio>
#include <cstring>
#include <cmath>
#include <cstddef>
namespace cg = cooperative_groups;

#ifndef PROBE_DUP
#define PROBE_DUP 0
#endif
#ifndef MULTI_LAUNCH
#define MULTI_LAUNCH 0
#endif

typedef unsigned short u16;
using bf16x8 = __attribute__((ext_vector_type(8))) short;
using f32x4 = __attribute__((ext_vector_type(4))) float;
using u32x4 = __attribute__((ext_vector_type(4))) unsigned;
#define DI __device__ __forceinline__

constexpr int NTOK = 32768, DM = 1024, SEQ = 4096, NBATCH = 8, DEPTH = 4;
constexpr int INW = 2688, DFF = 2816;
constexpr float ALPHA = 1.681792830507429f;
constexpr float LOG2E = 1.4426950408889634f;

enum { I_X = 0, I_MEM, I_POS, I_WIN, I_LQ1, I_LK1, I_LQ2, I_LK2, I_SUBLN, I_MU, I_W0, I_W2, I_A0, I_A2, I_G2, I_KK, I_KA, I_RK,
       I_LNXG, I_LNXB, I_SARE, I_SAIM, I_SBRE, I_SBIM, I_SCRE, I_SCIM, I_SD, I_SLOG, I_GLUW, I_GLUB, I_SOUTG, I_WOUT, I_LN1G, I_LN1B,
       I_WQ, I_WKV, I_WO, I_LN2G, I_LN2B, I_WUP, I_CONVW, I_CONVB, I_WDOWN, I_LN3G, I_LN3B, N_IN };

constexpr size_t MiB = 1024 * 1024;
constexpr size_t OFF_XB = 0;
constexpr size_t OFF_Y = 0, OFF_G = 32 * MiB, OFF_Z = 48 * MiB;
constexpr size_t OFF_WT = 64 * MiB;
constexpr size_t WT_IN = 0, WT_OUT = WT_IN + 2816ul * 1024 * 2, WT_Q = WT_OUT + 2 * MiB, WT_KV = WT_Q + 2 * MiB, WT_O = WT_KV + 4 * MiB,
                 WT_UP = WT_O + 2 * MiB, WT_DOWN = WT_UP + 11 * MiB, WT_GLU = WT_DOWN + 2816ul * 1024 * 2,
                 WT_W2T = WT_GLU + 131072, WT_A2T = WT_W2T + 16384, WT_G2T = WT_A2T + 16384;
constexpr size_t OFF_KMEM = 97 * MiB;
constexpr size_t OFF_VMEMT = 101 * MiB;
constexpr size_t OFF_MEMB = 105 * MiB;
constexpr size_t OFF_ROPE = 109 * MiB;
constexpr size_t OFF_CNT = 117 * MiB;
constexpr size_t OFF_BONUS = 118 * MiB;
constexpr size_t OFF_DR = 120 * MiB;
constexpr size_t OFF_QK = OFF_DR;
constexpr size_t OFF_RW = OFF_DR + 64 * MiB;
constexpr size_t OFF_S5 = OFF_DR + 120 * MiB;
constexpr size_t OFF_VT = OFF_DR + 136 * MiB;
constexpr size_t OFF_HCAT = OFF_DR + 168 * MiB;
constexpr size_t OFF_REC = OFF_DR + 232 * MiB;
constexpr size_t OFF_QC = OFF_DR;
constexpr size_t OFF_OC = OFF_DR + 64 * MiB;
constexpr size_t OFF_AG = OFF_DR;
constexpr size_t OFF_AF = OFF_DR + 200 * MiB;
constexpr size_t OFF_GF = OFF_AF + 3 * MiB;
constexpr size_t OFF_AL = OFF_GF + 3 * MiB;

struct Params {
  const void* in[48];
  float* xs;
  char* ws;
  float lam_init[4];
  int pad[4];
};

typedef const char __attribute__((address_space(4)))* kaptr_t;
struct PRef {
  struct In { kaptr_t ka; DI const void* operator[](int i) const { return *(const void* const __attribute__((address_space(4)))*)(ka + i * 8); } } in;
  struct Xs { kaptr_t ka; DI operator float*() const { return *(float* const __attribute__((address_space(4)))*)(ka + 384); } } xs;
  struct Ws { kaptr_t ka; DI operator char*() const { return *(char* const __attribute__((address_space(4)))*)(ka + 392); } } ws;
  struct Lam { kaptr_t ka; DI float operator[](int i) const { return *(const float __attribute__((address_space(4)))*)(ka + 400 + i * 4); } } lam_init;
  DI explicit PRef(kaptr_t k) : in{k}, xs{k}, ws{k}, lam_init{k} {}
};
static_assert(offsetof(Params, xs) == 384 && offsetof(Params, ws) == 392 && offsetof(Params, lam_init) == 400, "layout");

DI int ltid() { int t = threadIdx.x; asm volatile("" : "+v"(t)); return t; }
typedef __bf16 bf16v2 __attribute__((ext_vector_type(2)));
typedef float f32v2 __attribute__((ext_vector_type(2)));
DI unsigned pack2(float a, float b) { f32v2 v = {a, b}; return __builtin_bit_cast(unsigned, __builtin_convertvector(v, bf16v2)); }
DI u16 f2bf(float x) { return (u16)(pack2(x, 0.f) & 0xffffu); }
DI float bf2f(u16 h) { return __uint_as_float(((unsigned)h) << 16); }
DI float sigmoidf_(float x) { return 1.f / (1.f + __expf(-x)); }
DI float wave_sum(float v) {
  for (int o = 32; o > 0; o >>= 1) v += __shfl_xor(v, o);
  return v;
}
template <int CTRL> DI float dpp_f(float x) {
  return __int_as_float(__builtin_amdgcn_mov_dpp(__float_as_int(x), CTRL, 0xF, 0xF, true));
}
DI float row16_sum(float x) {
  x += dpp_f<0xB1>(x);
  x += dpp_f<0x4E>(x);
  x += dpp_f<0x141>(x);
  x += dpp_f<0x140>(x);
  return x;
}

constexpr int BM = 256, BK = 64, HALF = 128, HT = HALF * BK;

DI int lds_byte(int r, int c) {
  int st = (r >> 4) * 2 + (c >> 5), rr = r & 15, cc = c & 31, ob = rr * 64 + cc * 2;
  return st * 1024 + (ob ^ (((ob >> 9) & 1) << 5));
}
DI void stage_rc(int b, int& R, int& C) {
  int st = b / 1024, sb = b % 1024, swz = sb ^ (((sb >> 9) & 1) << 5);
  R = (st >> 1) * 16 + swz / 64; C = (st & 1) * 32 + (swz % 64) / 2;
}

struct TileDesc { const u16* A; const u16* B; int brow, bcol, sub; };
DI void rope_epilogue(const PRef& p, const f32x4 (&acc)[2][2][4][2], int brow, int bcol, int wr, int wc, int fr, int fq);
template <class TileFn, class Epi>
DI void gemm_stream(int ntiles, int lda, int ldb, int K, TileFn tile_fn, Epi epi) {
  extern __shared__ __attribute__((aligned(16))) u16 shm[];
  if (ntiles <= 0) return;
#define SA(b, h) (shm + ((b) * 2 + (h)) * HT)
#define SB(b, h) (shm + (4 + (b) * 2 + (h)) * HT)
#define STAGE(P, PTR, V, S64, HH, KREL) do { \
    const char* _p = (PTR) + ((KREL) * 128 + (size_t)(2 * (HH)) * (S64)); asm volatile("" : "+s"(_p)); \
    __builtin_amdgcn_global_load_lds((const unsigned*)(_p + (size_t)(V)), (unsigned*)((char*)(P) + tid * 16), 16, 0, 0); \
    const char* _q = (PTR) + ((KREL) * 128 + (size_t)(2 * (HH) + 1) * (S64)); asm volatile("" : "+s"(_q)); \
    __builtin_amdgcn_global_load_lds((const unsigned*)(_q + (size_t)(V)), (unsigned*)((char*)(P) + tid * 16 + 8192), 16, 0, 0); } while (0)
#define LDA(dst, b, h) for (int m = 0; m < 4; ++m) for (int k = 0; k < 2; ++k) \
    dst[m][k] = *reinterpret_cast<const bf16x8*>((char*)SA(b, h) + lds_byte(wr * 64 + m * 16 + fr, k * 32 + fq * 8))
#define LDB(dst, b, h) for (int n = 0; n < 2; ++n) for (int k = 0; k < 2; ++k) \
    dst[n][k] = *reinterpret_cast<const bf16x8*>((char*)SB(b, h) + lds_byte(wc * 32 + n * 16 + fr, k * 32 + fq * 8))
#define MMA(ai, bj, At_, Bt_) do { __builtin_amdgcn_s_setprio(1); \
    for (int m = 0; m < 4; ++m) for (int n = 0; n < 2; ++n) for (int k = 0; k < 2; ++k) \
      acc[ai][bj][m][n] = __builtin_amdgcn_mfma_f32_16x16x32_bf16(Bt_[n][k], At_[m][k], acc[ai][bj][m][n], 0, 0, 0); \
    __builtin_amdgcn_s_setprio(0); } while (0)
#define WAIT_V(n) asm volatile("s_waitcnt vmcnt(" #n ")" ::: "memory")
#define WAIT_L(n) asm volatile("s_waitcnt lgkmcnt(" #n ")" ::: "memory")
#define BAR __builtin_amdgcn_s_barrier()
#define SCHED __builtin_amdgcn_sched_barrier(0)
#define SA0(P_, K) STAGE(SA(0, 0), P_, vA, sA64, 0, K)
#define SA0H(P_, K) STAGE(SA(0, 1), P_, vA, sA64, 1, K)
#define SA1(P_, K) STAGE(SA(1, 0), P_, vA, sA64, 0, K)
#define SA1H(P_, K) STAGE(SA(1, 1), P_, vA, sA64, 1, K)
#define SB0(P_, K) STAGE(SB(0, 0), P_, vB, sB64, 0, K)
#define SB0H(P_, K) STAGE(SB(0, 1), P_, vB, sB64, 1, K)
#define SB1(P_, K) STAGE(SB(1, 0), P_, vB, sB64, 0, K)
#define SB1H(P_, K) STAGE(SB(1, 1), P_, vB, sB64, 1, K)

  const int tid = ltid();
  const int wid = tid >> 6, lane = tid & 63, wr = wid >> 2, wc = wid & 3, fr = lane & 15, fq = lane >> 4;
  unsigned vA, vB;
  { int r0, c0; stage_rc(tid * 16, r0, c0); vA = (unsigned)(r0 * lda + c0) * 2u; vB = (unsigned)(r0 * ldb + c0) * 2u; }
  const unsigned sA64 = (unsigned)lda * 128u, sB64 = (unsigned)ldb * 128u;
  const int nt = K / BK;
  TileDesc cur = tile_fn(0);
  const char* pA = (const char*)(cur.A + (long)cur.brow * lda);
  const char* pB = (const char*)(cur.B + (long)cur.bcol * ldb);
  SB0(pB, 0); SA0(pA, 0); SB0H(pB, 0); SA0H(pA, 0);
  if (wr == 1) BAR;
  WAIT_V(4); BAR;
  SB1(pB, 1); SA1(pA, 1); SB1H(pB, 1);
  WAIT_V(6); BAR;
  for (int ti = 0; ti < ntiles; ++ti) {
    const TileDesc nxt = tile_fn(ti + 1 < ntiles ? ti + 1 : ti);
    const char* pAn = (const char*)(nxt.A + (long)nxt.brow * lda);
    const char* pBn = (const char*)(nxt.B + (long)nxt.bcol * ldb);
    f32x4 acc[2][2][4][2];
    for (int a = 0; a < 2; ++a) for (int b = 0; b < 2; ++b) for (int m = 0; m < 4; ++m) for (int n = 0; n < 2; ++n) acc[a][b][m][n] = f32x4{0.f, 0.f, 0.f, 0.f};
    bf16x8 At[4][2], B0[2][2], B1[2][2];
    for (int t = 0; t < nt; t += 2) {
      const bool last = (t == nt - 2);
      const char* pA2 = last ? pAn - 256 : pA;
      const char* pB2 = last ? pBn - 256 : pB;
      LDB(B0, 0, 0); SCHED; LDA(At, 0, 0); SA1H(pA, 1);
      WAIT_L(8); BAR; WAIT_L(0); MMA(0, 0, At, B0); BAR; SCHED;
      LDB(B1, 0, 1); SB0(pB2, 2);
      BAR; WAIT_L(0); MMA(0, 1, At, B1); BAR;
      LDA(At, 0, 1); SA0(pA2, 2);
      BAR; WAIT_L(0); MMA(1, 0, At, B0); BAR; SCHED;
      SB0H(pB2, 2);
      WAIT_V(6); BAR; MMA(1, 1, At, B1); BAR;
      LDB(B0, 1, 0); SCHED; LDA(At, 1, 0); SA0H(pA2, 2);
      WAIT_L(8); BAR; WAIT_L(0); MMA(0, 0, At, B0); BAR; SCHED;
      LDB(B1, 1, 1); SB1(pB2, 3);
      BAR; WAIT_L(0); MMA(0, 1, At, B1); BAR;
      LDA(At, 1, 1); SA1(pA2, 3);
      BAR; WAIT_L(0); MMA(1, 0, At, B0); BAR; SCHED;
      SB1H(pB2, 3);
      WAIT_V(6); BAR; MMA(1, 1, At, B1); BAR;
      pA += 256; pB += 256;
    }
    if (wr == 0) BAR;
    if (epi.kind == 0 && cur.sub == 0 && cur.bcol < 1024) {
      const PRef pe(epi.ka);
      rope_epilogue(pe, acc, cur.brow, cur.bcol, wr, wc, fr, fq);
    } else if (epi.kind == 10) {
      const PRef pe(epi.ka);
      up_epilogue(pe, epi.lay, acc, cur.brow, cur.bcol, wr, wc, fr, fq, reinterpret_cast<float*>(reinterpret_cast<char*>(shm) + 131072));
    } else {
#pragma unroll
      for (int ai = 0; ai < 2; ++ai)
#pragma unroll
        for (int bj = 0; bj < 2; ++bj)
#pragma unroll
          for (int m = 0; m < 4; ++m)
#pragma unroll
            for (int n = 0; n < 2; ++n)
              epi(cur.sub, cur.brow + ai * HALF + wr * 64 + m * 16 + fr, cur.bcol + bj * HALF + wc * 32 + n * 16 + fq * 4, acc[ai][bj][m][n]);
    }
    WAIT_V(0);
    cur = nxt; pA = pAn; pB = pBn;
    if (wr == 1 && ti + 1 < ntiles) BAR;
  }
  __syncthreads();
#undef SA
#undef SB
}

template <int CTRL> DI float dppz(float x) {
  return __int_as_float(__builtin_amdgcn_update_dpp(0, __float_as_int(x), CTRL, 0xF, 0xF, true));
}
DI void up_epilogue(const PRef& p, int l, const f32x4 (&acc)[2][2][4][2], int brow, int bcol, int wr, int wc, int fr, int fq, float* exch) {
  char* ws = p.ws;
  u16* hmid = (u16*)(ws + OFF_AG);
  const int pm = brow >> 8, pn = bcol >> 8;
  const int cw0 = pn * 128 + wc * 32 + fq * 4;
  const float* cwp = (const float*)p.in[I_CONVW] + (size_t)l * 3 * DFF;
  const float* cbp = (const float*)p.in[I_CONVB] + (size_t)l * DFF;
#pragma unroll
  for (int ai = 0; ai < 2; ++ai)
#pragma unroll
    for (int n = 0; n < 2; ++n) {
      if (fr >= 14) {
        const f32x4 v = acc[ai][0][3][n];
        *reinterpret_cast<float4*>(exch + (((ai * 2 + wr) * 2 + (fr - 14)) * 128 + wc * 32 + n * 16 + fq * 4)) = make_float4(v[0], v[1], v[2], v[3]);
        if (ai == 1 && wr == 1)
          *reinterpret_cast<float4*>((float*)(ws + OFF_AL) + ((size_t)(pm * 2 + (fr - 14)) * DFF + cw0 + n * 16)) = make_float4(v[0], v[1], v[2], v[3]);
      }
      if (ai == 0 && wr == 0 && fr < 2) {
        const f32x4 va = acc[0][0][0][n], vg = acc[0][1][0][n];
        *reinterpret_cast<float4*>((float*)(ws + OFF_AF) + ((size_t)(pm * 2 + fr) * DFF + cw0 + n * 16)) = make_float4(va[0], va[1], va[2], va[3]);
        *reinterpret_cast<float4*>((float*)(ws + OFF_GF) + ((size_t)(pm * 2 + fr) * DFF + cw0 + n * 16)) = make_float4(vg[0], vg[1], vg[2], vg[3]);
      }
    }
  __syncthreads();
#pragma unroll
  for (int ai = 0; ai < 2; ++ai) {
    const int sp = ai * 2 + wr;
#pragma unroll
    for (int n = 0; n < 2; ++n) {
      const int c = cw0 + n * 16;
      const float4 w0 = *reinterpret_cast<const float4*>(cwp + c), w1 = *reinterpret_cast<const float4*>(cwp + DFF + c);
      const float4 w2 = *reinterpret_cast<const float4*>(cwp + 2 * DFF + c), bs = *reinterpret_cast<const float4*>(cbp + c);
      float4 p62 = make_float4(0.f, 0.f, 0.f, 0.f), p63 = p62;
      if (sp > 0) {
        p62 = *reinterpret_cast<const float4*>(exch + (((sp - 1) * 2 + 0) * 128 + wc * 32 + n * 16 + fq * 4));
        p63 = *reinterpret_cast<const float4*>(exch + (((sp - 1) * 2 + 1) * 128 + wc * 32 + n * 16 + fq * 4));
      }
      const float w0a[4] = {w0.x, w0.y, w0.z, w0.w}, w1a[4] = {w1.x, w1.y, w1.z, w1.w}, w2a[4] = {w2.x, w2.y, w2.z, w2.w}, bsa[4] = {bs.x, bs.y, bs.z, bs.w};
      const float p62a[4] = {p62.x, p62.y, p62.z, p62.w}, p63a[4] = {p63.x, p63.y, p63.z, p63.w};
#pragma unroll
      for (int m = 0; m < 4; ++m) {
        float o[4];
#pragma unroll
        for (int j = 0; j < 4; ++j) {
          const float a = acc[ai][0][m][n][j], g = acc[ai][1][m][n][j];
          float pr1 = dppz<0x111>(a), pr2 = dppz<0x112>(a);
          if (m == 0) {
            if (fr == 0) { pr1 = p63a[j]; pr2 = p62a[j]; }
            if (fr == 1) { pr2 = p63a[j]; }
          } else {
            const float am = acc[ai][0][m - 1][n][j];
            const float mir = dppz<0x140>(am);
            const float swp = dppz<0xB1>(mir);
            if (fr == 0) { pr1 = mir; }
            if (fr < 2) { pr2 = swp; }
          }
          const float cv = bsa[j] + w0a[j] * pr2 + w1a[j] * pr1 + w2a[j] * a;
          o[j] = cv * sigmoidf_(cv) * g;
        }
        uint2 ov; ov.x = pack2(o[0], o[1]); ov.y = pack2(o[2], o[3]);
        *reinterpret_cast<uint2*>(hmid + (size_t)(brow + ai * HALF + wr * 64 + m * 16 + fr) * DFF + c) = ov;
      }
    }
  }
  __syncthreads();
}

DI void rope_epilogue(const PRef& p, const f32x4 (&acc)[2][2][4][2], int brow, int bcol, int wr, int wc, int fr, int fq) {
  char* ws = p.ws;
  u16* qk = (u16*)(ws + OFF_QK);
  const float* rc = (const float*)(ws + OFF_ROPE); const float* rs = rc + (size_t)NTOK * 32;
  const int d0 = (wc & 1) * 16 + fq * 4;
#pragma unroll
  for (int ai = 0; ai < 2; ++ai)
#pragma unroll
    for (int m = 0; m < 4; ++m) {
      const int tok = brow + ai * HALF + wr * 64 + m * 16 + fr;
      const float4 c4 = *reinterpret_cast<const float4*>(rc + (size_t)tok * 32 + d0);
      const float4 s4 = *reinterpret_cast<const float4*>(rs + (size_t)tok * 32 + d0);
      const float ca[4] = {c4.x, c4.y, c4.z, c4.w}, sa[4] = {s4.x, s4.y, s4.z, s4.w};
#pragma unroll
      for (int bj = 0; bj < 2; ++bj) {
        const int hh = (bcol >> 6) + bj * 2 + (wc >> 1);
        const float sc = (hh < 8) ? 0.125f * LOG2E : 1.f;
        float o0[4], o1[4];
#pragma unroll
        for (int j = 0; j < 4; ++j) {
          const float t0 = acc[ai][bj][m][0][j], t1 = acc[ai][bj][m][1][j];
          o0[j] = (t0 * ca[j] - t1 * sa[j]) * sc;
          o1[j] = (t1 * ca[j] + t0 * sa[j]) * sc;
        }
        u16* dst = qk + (size_t)tok * 1024 + hh * 64 + d0;
        uint2 v0; v0.x = pack2(o0[0], o0[1]); v0.y = pack2(o0[2], o0[3]);
        uint2 v1; v1.x = pack2(o1[0], o1[1]); v1.y = pack2(o1[2], o1[3]);
        *reinterpret_cast<uint2*>(dst) = v0;
        *reinterpret_cast<uint2*>(dst + 32) = v1;
      }
    }
}

struct EpiGen {
  int kind, lay; kaptr_t ka;
  DI void operator()(int sub, int row, int col, f32x4 v) const {
    const PRef p(ka);
    if (kind == 4 || kind == 8 || kind == 12) {
      float* X = p.xs;
      float4* q = reinterpret_cast<float4*>(X + (size_t)row * DM + col);
      const float4* qi = (kind == 4 && lay == 0) ? reinterpret_cast<const float4*>((const float*)p.in[I_X] + (size_t)row * DM + col) : q;
      float4 x = *qi;
      x.x = ALPHA * x.x + v[0]; x.y = ALPHA * x.y + v[1]; x.z = ALPHA * x.z + v[2]; x.w = ALPHA * x.w + v[3];
      *q = x;
      return;
    }
    char* ws = p.ws;
    const float scale = (kind == 6) ? 0.0625f * LOG2E : 1.f;
    uint2 o; o.x = pack2(v[0] * scale, v[1] * scale); o.y = pack2(v[2] * scale, v[3] * scale);
    u16* dst;
    if (kind == 6) dst = (u16*)(ws + OFF_QC) + (size_t)row * 1024 + col;
    else if (sub == 1) dst = (u16*)(ws + OFF_VT) + (size_t)row * NTOK + col;
    else if (sub == 2) dst = (u16*)(ws + OFF_KMEM) + (size_t)row * 1024 + col;
    else if (sub == 3) dst = (u16*)(ws + OFF_VMEMT) + (size_t)row * 2048 + col;
    else if (col < 1024) dst = (u16*)(ws + OFF_QK) + (size_t)row * 1024 + col;
    else if (col < 2432) dst = (u16*)(ws + OFF_RW) + (size_t)row * 896 + (col - 1536);
    else if (col < 2688) dst = (u16*)(ws + OFF_S5) + (size_t)row * 256 + (col - 2432);
    else return;
    *reinterpret_cast<uint2*>(dst) = o;
  }
};

DI void transpose_tiles(const float* __restrict__ src, int K, int N, int Npad, u16* __restrict__ dst, int& tbase, int tile_begin, int tile_stride, bool upmap = false, int rope_rows = 0) {
  extern __shared__ __attribute__((aligned(16))) u16 shm[];
  float* tile = reinterpret_cast<float*>(shm);
  const int nkt = K / 64, nnt = Npad / 64, total = nkt * nnt;
  int first = tile_begin;
  if (first < tbase) { int d = tbase - first; first += ((d + tile_stride - 1) / tile_stride) * tile_stride; }
  for (int g = first; g < tbase + total; g += tile_stride) {
    int t = g - tbase; int kt = t % nkt, ntile = t / nkt; int k0 = kt * 64, n0 = ntile * 64;
    __syncthreads();
    const int tid = ltid();
#pragma unroll
    for (int r = 0; r < 2; ++r) {
      const int e = tid + r * 512, i = e >> 4, j4 = (e & 15) * 4;
      float4 v = make_float4(0.f, 0.f, 0.f, 0.f);
      const int sn0 = upmap ? ((n0 & 255) >> 7) * DFF + (n0 >> 8) * 128 + (n0 & 127) : n0;
      if (n0 + j4 < N) v = *reinterpret_cast<const float4*>(src + (size_t)(k0 + i) * N + sn0 + j4);
      tile[i * 65 + j4] = v.x; tile[i * 65 + j4 + 1] = v.y; tile[i * 65 + j4 + 2] = v.z; tile[i * 65 + j4 + 3] = v.w;
    }
    __syncthreads();
    {
      const int jn = tid >> 3, seg = tid & 7;
      const float* tp = tile + (seg * 8) * 65 + jn;
      uint4 o;
      o.x = pack2(tp[0], tp[65]); o.y = pack2(tp[2 * 65], tp[3 * 65]); o.z = pack2(tp[4 * 65], tp[5 * 65]); o.w = pack2(tp[6 * 65], tp[7 * 65]);
      const int jd = (n0 < rope_rows) ? (((jn >> 4) & 1) * 32 + (jn >> 5) * 16 + (jn & 15)) : jn;
      *reinterpret_cast<uint4*>(dst + (size_t)(n0 + jd) * K + k0 + seg * 8) = o;
    }
  }
  tbase += total;
}

DI void phase_transposes(const PRef& p, int l) {
  char* wt = p.ws + OFF_WT;
  int tbase = 0; const int tb = blockIdx.x, ts = gridDim.x;
  transpose_tiles((const float*)p.in[I_WIN] + (size_t)l * 1024 * INW, 1024, INW, 2816, (u16*)(wt + WT_IN), tbase, tb, ts, false, 1024);
  transpose_tiles((const float*)p.in[I_WOUT] + (size_t)l * 1024 * 1024, 1024, 1024, 1024, (u16*)(wt + WT_OUT), tbase, tb, ts);
  transpose_tiles((const float*)p.in[I_WQ] + (size_t)l * 1024 * 1024, 1024, 1024, 1024, (u16*)(wt + WT_Q), tbase, tb, ts);
  transpose_tiles((const float*)p.in[I_WKV] + (size_t)l * 1024 * 2048, 1024, 2048, 2048, (u16*)(wt + WT_KV), tbase, tb, ts);
  transpose_tiles((const float*)p.in[I_WO] + (size_t)l * 1024 * 1024, 1024, 1024, 1024, (u16*)(wt + WT_O), tbase, tb, ts);
  transpose_tiles((const float*)p.in[I_WUP] + (size_t)l * 1024 * 5632, 1024, 5632, 5632, (u16*)(wt + WT_UP), tbase, tb, ts, true);
  transpose_tiles((const float*)p.in[I_WDOWN] + (size_t)l * 2816 * 1024, 2816, 1024, 1024, (u16*)(wt + WT_DOWN), tbase, tb, ts);
  transpose_tiles((const float*)p.in[I_GLUW] + (size_t)l * 256 * 256, 256, 256, 256, (u16*)(wt + WT_GLU), tbase, tb, ts);
  __syncthreads();
  {
    const float* w2 = (const float*)p.in[I_W2] + l * 32 * 256;
    const float* a2 = (const float*)p.in[I_A2] + l * 32 * 256;
    const float* g2 = (const float*)p.in[I_G2] + l * 64 * 256;
    u16* w2t = (u16*)(wt + WT_W2T); u16* a2t = (u16*)(wt + WT_A2T); u16* g2t = (u16*)(wt + WT_G2T);
    for (int e = blockIdx.x * 512 + ltid(); e < 256 * 128; e += gridDim.x * 512) {
      const int n = e & 255, kk = e >> 8;
      if (kk < 32) w2t[n * 32 + kk] = f2bf(w2[kk * 256 + n]);
      else if (kk < 64) a2t[n * 32 + (kk - 32)] = f2bf(a2[(kk - 32) * 256 + n]);
      else g2t[n * 64 + (kk - 64)] = f2bf(g2[(kk - 64) * 256 + n]);
    }
  }
}

DI void phase_init(const PRef& p) {
  const size_t gtid = (size_t)blockIdx.x * 512 + ltid(), gsz = (size_t)gridDim.x * 512;
  const float4* x4 = (const float4*)p.in[I_X];
  uint2* xb2 = (uint2*)(p.ws + OFF_XB);
  for (size_t i = gtid; i < (size_t)NTOK * DM / 4; i += gsz) {
    float4 v = x4[i];
    uint2 o; o.x = pack2(v.x, v.y); o.y = pack2(v.z, v.w); xb2[i] = o;
  }
  const float4* m4 = (const float4*)p.in[I_MEM];
  uint2* mb2 = (uint2*)(p.ws + OFF_MEMB);
  for (size_t i = gtid; i < (size_t)2048 * 1024 / 4; i += gsz) {
    float4 v = m4[i]; uint2 o; o.x = pack2(v.x, v.y); o.y = pack2(v.z, v.w); mb2[i] = o;
  }
  const int* pos = (const int*)p.in[I_POS];
  float* rc = (float*)(p.ws + OFF_ROPE); float* rs = rc + (size_t)NTOK * 32;
  for (size_t i = gtid; i < (size_t)NTOK * 32; i += gsz) {
    int tok = (int)(i >> 5), d = (int)(i & 31);
    float invf = exp2f(-(float)d * (13.287712379549449f / 32.f));
    float angf = (float)pos[tok] * invf;
    double rev = (double)angf * 0.15915494309189535;
    float xr = (float)((rev - rint(rev)) * 6.283185307179586);
    float sv = __sinf(xr), cv = __cosf(xr);
    rc[i] = cv; rs[i] = sv;
  }
  if (blockIdx.x == 0 && ltid() < 64) ((unsigned*)(p.ws + OFF_CNT))[ltid()] = 0u;
}

DI void phase_prep(const PRef& p, int l) {
  extern __shared__ __attribute__((aligned(16))) u16 shm[];
  float* act = reinterpret_cast<float*>(shm);
  u16* qk = (u16*)(p.ws + OFF_QK);
  const u16* rw = (const u16*)(p.ws + OFF_RW);
  const float* rc = (const float*)(p.ws + OFF_ROPE); const float* rs = rc + (size_t)NTOK * 32;
  const float* mu = (const float*)p.in[I_MU] + l * 896;
  const float* w0 = (const float*)p.in[I_W0] + l * 256;
  const float* w2 = (const float*)p.in[I_W2] + l * 32 * 256;
  const float* a0 = (const float*)p.in[I_A0] + l * 256;
  const float* a2 = (const float*)p.in[I_A2] + l * 32 * 256;
  const float* g2 = (const float*)p.in[I_G2] + l * 64 * 256;
  const float* k_k = (const float*)p.in[I_KK] + l * 256;
  const float* k_a = (const float*)p.in[I_KA] + l * 256;
  const float* r_k = (const float*)p.in[I_RK] + l * 256;
  char* rec = p.ws + OFF_REC;
  u16* gbuf = (u16*)(p.ws + OFF_G);
  float* bonus = (float*)(p.ws + OFF_BONUS);
  const int tid = ltid();
  for (int item = blockIdx.x; item < NTOK / 32; item += gridDim.x) {
    const int tk0 = item * 32;
    __syncthreads();
    for (int idx = tid; idx < 32 * 128; idx += 512) {
      const int i = idx >> 7, j = idx & 127, tok = tk0 + i, col = 768 + j;
      float pv = bf2f(rw[(size_t)tok * 896 + col]);
      float pp = ((tok & (SEQ - 1)) != 0) ? bf2f(rw[(size_t)(tok - 1) * 896 + col]) : 0.f;
      float ps = pv + (pp - pv) * mu[col];
      float a = (j < 32) ? tanhf(ps) : (j < 64) ? ps : sigmoidf_(ps);
      act[i * 128 + j] = a;
    }
    __syncthreads();
    const int c = tid & 255, half = tid >> 8, h = c >> 6;
    {
      float* lora = act + 32 * 128;
      const int w8 = tid >> 6, ln = tid & 63, fr = ln & 15, fq = ln >> 4;
      const u16* w2t = (const u16*)(p.ws + OFF_WT + WT_W2T);
      const u16* a2t = (const u16*)(p.ws + OFF_WT + WT_A2T);
      const u16* g2t = (const u16*)(p.ws + OFF_WT + WT_G2T);
#pragma unroll
      for (int nbi = 0; nbi < 2; ++nbi) {
        const int col0 = (w8 * 2 + nbi) * 16;
        const bf16x8 bw = *reinterpret_cast<const bf16x8*>(w2t + (size_t)(col0 + fr) * 32 + fq * 8);
        const bf16x8 ba = *reinterpret_cast<const bf16x8*>(a2t + (size_t)(col0 + fr) * 32 + fq * 8);
        const bf16x8 bg0 = *reinterpret_cast<const bf16x8*>(g2t + (size_t)(col0 + fr) * 64 + fq * 8);
        const bf16x8 bg1 = *reinterpret_cast<const bf16x8*>(g2t + (size_t)(col0 + fr) * 64 + 32 + fq * 8);
#pragma unroll
        for (int mb = 0; mb < 2; ++mb) {
          const float* ap = act + (mb * 16 + fr) * 128 + fq * 8;
          bf16x8 af[4];
#pragma unroll
          for (int ks = 0; ks < 4; ++ks) {
            const float4 f0 = *reinterpret_cast<const float4*>(ap + ks * 32), f1 = *reinterpret_cast<const float4*>(ap + ks * 32 + 4);
            af[ks] = __builtin_bit_cast(bf16x8, (u32x4{pack2(f0.x, f0.y), pack2(f0.z, f0.w), pack2(f1.x, f1.y), pack2(f1.z, f1.w)}));
          }
          const f32x4 z4 = f32x4{0.f, 0.f, 0.f, 0.f};
          f32x4 dw = __builtin_amdgcn_mfma_f32_16x16x32_bf16(bw, af[0], z4, 0, 0, 0);
          f32x4 da = __builtin_amdgcn_mfma_f32_16x16x32_bf16(ba, af[1], z4, 0, 0, 0);
          f32x4 dg = __builtin_amdgcn_mfma_f32_16x16x32_bf16(bg0, af[2], z4, 0, 0, 0);
          dg = __builtin_amdgcn_mfma_f32_16x16x32_bf16(bg1, af[3], dg, 0, 0, 0);
          float* lp = lora + (mb * 16 + fr) * 256 + col0 + fq * 4;
          *reinterpret_cast<float4*>(lp) = make_float4(dw[0], dw[1], dw[2], dw[3]);
          *reinterpret_cast<float4*>(lp + 32 * 256) = make_float4(da[0], da[1], da[2], da[3]);
          *reinterpret_cast<float4*>(lp + 2 * 32 * 256) = make_float4(dg[0], dg[1], dg[2], dg[3]);
        }
      }
    }
    __syncthreads();
    float accw[16], acca[16], accg[16];
#pragma unroll
    for (int i = 0; i < 16; ++i) {
      const float* lp = act + 32 * 128 + (half * 16 + i) * 256 + c;
      accw[i] = lp[0]; acca[i] = lp[32 * 256]; accg[i] = lp[2 * 32 * 256];
    }
    const float mur = mu[c], muk = mu[256 + c], muv = mu[512 + c];
    const float w0c = w0[c], a0c = a0[c], kkc = k_k[c], kac = k_a[c], rkc = r_k[c];
#pragma unroll
    for (int i = 0; i < 16; ++i) {
      const int tok = tk0 + half * 16 + i;
      const bool has_prev = (tok & (SEQ - 1)) != 0;
      const u16* pr_ = rw + (size_t)tok * 896;
      float r0 = bf2f(pr_[c]), k0 = bf2f(pr_[256 + c]), v0 = bf2f(pr_[512 + c]);
      float r1 = 0.f, k1 = 0.f, v1 = 0.f;
      if (has_prev) { r1 = bf2f(pr_[c - 896]); k1 = bf2f(pr_[256 + c - 896]); v1 = bf2f(pr_[512 + c - 896]); }
      float r = r0 + (r1 - r0) * mur, k = k0 + (k1 - k0) * muk, v = v0 + (v1 - v0) * muv;
      float w = __expf(-0.6065306597126334f * sigmoidf_(w0c + accw[i]));
      float a = sigmoidf_(a0c + acca[i]);
      float kk = k * kkc;
      float ss = wave_sum(kk * kk);
      kk *= rsqrtf(fmaxf(ss, 1e-24f));
      float kp = k * (1.f + (a - 1.f) * kac);
      float bb = kk * a;
      float bo = wave_sum(r * kp * rkc);
      const int b = tok >> 12, t = tok & (SEQ - 1);
      char* rp = rec + ((size_t)((b * 4 + h) * SEQ + t)) * 1152;
      const int cc = c & 63;
      reinterpret_cast<float*>(rp)[cc] = w;
      reinterpret_cast<float*>(rp + 256)[cc] = kk;
      reinterpret_cast<float*>(rp + 512)[cc] = bb;
      reinterpret_cast<u16*>(rp + 768)[cc] = f2bf(kp);
      reinterpret_cast<u16*>(rp + 896)[cc] = f2bf(r);
      reinterpret_cast<u16*>(rp + 1024)[cc] = f2bf(v);
      gbuf[(size_t)tok * 256 + c] = f2bf(accg[i]);
      if (cc == 0) bonus[(size_t)tok * 4 + h] = bo;
    }
    __syncthreads();
  }
}

template <int DK, int DV, int NQB>
struct FlashWave {
  bf16x8 qf[NQB][DK / 32];
  f32x4 o[NQB][DV / 16];
  float m[NQB], l[NQB];
  DI void init() {
#pragma unroll
    for (int qb = 0; qb < NQB; ++qb) { m[qb] = -INFINITY; l[qb] = 0.f;
#pragma unroll
      for (int d = 0; d < DV / 16; ++d) o[qb][d] = f32x4{0.f, 0.f, 0.f, 0.f}; }
  }
  DI void tile(const u16* Ks, const u16* Vts) {
    constexpr int KSTR = DK + 8, VSTR = 72;
    const int lane = ltid() & 63, fr = lane & 15, fq = lane >> 4;
    float base[NQB];
#pragma unroll
    for (int qb = 0; qb < NQB; ++qb) base[qb] = (m[qb] == -INFINITY) ? 0.f : m[qb];
    f32x4 s[4][NQB];
    __builtin_amdgcn_s_setprio(1);
#pragma unroll
    for (int kb = 0; kb < 4; ++kb) {
#pragma unroll
      for (int qb = 0; qb < NQB; ++qb) s[kb][qb] = f32x4{-base[qb], -base[qb], -base[qb], -base[qb]};
#pragma unroll
      for (int ks = 0; ks < DK / 32; ++ks) {
        bf16x8 kf = *reinterpret_cast<const bf16x8*>(Ks + (kb * 16 + fr) * KSTR + ks * 32 + fq * 8);
#pragma unroll
        for (int qb = 0; qb < NQB; ++qb) s[kb][qb] = __builtin_amdgcn_mfma_f32_16x16x32_bf16(kf, qf[qb][ks], s[kb][qb], 0, 0, 0);
      }
    }
    __builtin_amdgcn_s_setprio(0);
    bf16x8 pf[NQB][2];
#pragma unroll
    for (int qb = 0; qb < NQB; ++qb) {
      float mx = -INFINITY;
#pragma unroll
      for (int kb = 0; kb < 4; ++kb) {
#pragma unroll
        for (int j = 0; j < 4; ++j) mx = fmaxf(mx, s[kb][qb][j]); }
      mx = fmaxf(mx, __shfl_xor(mx, 16));
      mx = fmaxf(mx, __shfl_xor(mx, 32));
      const float mn = fmaxf(m[qb], base[qb] + mx);
      const bool changed = __any(mn > m[qb]);
      float sum = 0.f;
      if (changed) {
        const float delta = mn - base[qb];
        const float alpha = __builtin_amdgcn_exp2f(m[qb] - mn);
#pragma unroll
        for (int kb = 0; kb < 4; ++kb) {
#pragma unroll
          for (int j = 0; j < 4; ++j) { float e = __builtin_amdgcn_exp2f(s[kb][qb][j] - delta); s[kb][qb][j] = e; sum += e; } }
        l[qb] = l[qb] * alpha + sum;
#pragma unroll
        for (int d = 0; d < DV / 16; ++d) { o[qb][d][0] *= alpha; o[qb][d][1] *= alpha; o[qb][d][2] *= alpha; o[qb][d][3] *= alpha; }
      } else {
#pragma unroll
        for (int kb = 0; kb < 4; ++kb) {
#pragma unroll
          for (int j = 0; j < 4; ++j) { float e = __builtin_amdgcn_exp2f(s[kb][qb][j]); s[kb][qb][j] = e; sum += e; } }
        l[qb] += sum;
      }
      m[qb] = mn;
#pragma unroll
      for (int k2 = 0; k2 < 2; ++k2) {
        u32x4 pk;
        pk[0] = pack2(s[2 * k2][qb][0], s[2 * k2][qb][1]); pk[1] = pack2(s[2 * k2][qb][2], s[2 * k2][qb][3]);
        pk[2] = pack2(s[2 * k2 + 1][qb][0], s[2 * k2 + 1][qb][1]); pk[3] = pack2(s[2 * k2 + 1][qb][2], s[2 * k2 + 1][qb][3]);
        pf[qb][k2] = __builtin_bit_cast(bf16x8, pk);
      }
    }
    __builtin_amdgcn_s_setprio(1);
#pragma unroll
    for (int k2 = 0; k2 < 2; ++k2) {
#pragma unroll
      for (int d = 0; d < DV / 16; ++d) {
        const u16* vp = Vts + (d * 16 + fr) * VSTR + k2 * 32 + fq * 4;
        const uint2 h0 = *reinterpret_cast<const uint2*>(vp);
        const uint2 h1 = *reinterpret_cast<const uint2*>(vp + 16);
        const bf16x8 vfv = __builtin_bit_cast(bf16x8, (u32x4{h0.x, h0.y, h1.x, h1.y}));
#pragma unroll
        for (int qb = 0; qb < NQB; ++qb) o[qb][d] = __builtin_amdgcn_mfma_f32_16x16x32_bf16(vfv, pf[qb][k2], o[qb][d], 0, 0, 0);
      }
    }
    __builtin_amdgcn_s_setprio(0);
  }
  DI float lsum(int qb) { float t = l[qb]; t += __shfl_xor(t, 16); t += __shfl_xor(t, 32); return t; }
};

DI void diff_attn_item(const PRef& p, int l, int b, int h, int qt) {
  extern __shared__ __attribute__((aligned(16))) u16 shm[];
  u16* Ks = shm;
  u16* Vts = shm + 2 * 64 * 72;
  float* comb = reinterpret_cast<float*>(shm + 2 * 64 * 72 + 128 * 72);
  const u16* qk = (const u16*)(p.ws + OFF_QK);
  const u16* vt = (const u16*)(p.ws + OFF_VT);
  u16* hcat = (u16*)(p.ws + OFF_HCAT);
  const int tid = ltid(), w = tid >> 6, lane = tid & 63, fr = lane & 15, fq = lane >> 4;
  const int n = w >> 2, qsub = w & 3;
  const int tok0 = b * SEQ + qt * 128;
  float lam;
  {
    float a1 = ((const float*)p.in[I_LQ1])[l * 64 + lane] * ((const float*)p.in[I_LK1])[l * 64 + lane];
    float a2 = ((const float*)p.in[I_LQ2])[l * 64 + lane] * ((const float*)p.in[I_LK2])[l * 64 + lane];
    a1 = wave_sum(a1); a2 = wave_sum(a2);
    lam = __expf(a1) - __expf(a2) + p.lam_init[l];
  }
  FlashWave<64, 128, 2> fw;
  fw.init();
#pragma unroll
  for (int qb = 0; qb < 2; ++qb)
#pragma unroll
    for (int ks = 0; ks < 2; ++ks)
    fw.qf[qb][ks] = *reinterpret_cast<const bf16x8*>(qk + (size_t)(tok0 + qsub * 32 + qb * 16 + fr) * 1024 + h * 128 + n * 64 + ks * 32 + fq * 8);
  const int nkt = 2 * qt + 2;
  const int my_last = 2 * qt + (qsub >> 1);
  uint4 kreg0, kreg1, vreg0, vreg1;
  const int seg0 = tid, seg1 = tid + 512;
  const u16* kbase0 = qk + (size_t)(b * SEQ + ((seg0 >> 3) & 63)) * 1024 + 512 + h * 128 + (seg0 >> 9) * 64 + (seg0 & 7) * 8;
  const u16* kbase1 = qk + (size_t)(b * SEQ + ((seg1 >> 3) & 63)) * 1024 + 512 + h * 128 + (seg1 >> 9) * 64 + (seg1 & 7) * 8;
  const u16* vbase0 = vt + (size_t)(h * 128 + (seg0 >> 3)) * NTOK + b * SEQ + (seg0 & 7) * 8;
  const u16* vbase1 = vt + (size_t)(h * 128 + (seg1 >> 3)) * NTOK + b * SEQ + (seg1 & 7) * 8;
  u16* kdst0 = Ks + ((seg0 >> 9) * 64 + ((seg0 >> 3) & 63)) * 72 + (seg0 & 7) * 8;
  u16* kdst1 = Ks + ((seg1 >> 9) * 64 + ((seg1 >> 3) & 63)) * 72 + (seg1 & 7) * 8;
  u16* vdst0 = Vts + (seg0 >> 3) * 72 + (seg0 & 7) * 8;
  u16* vdst1 = Vts + (seg1 >> 3) * 72 + (seg1 & 7) * 8;
#define load_tile(kt) do { \
    kreg0 = *reinterpret_cast<const uint4*>(kbase0 + (size_t)(kt) * 64 * 1024); \
    kreg1 = *reinterpret_cast<const uint4*>(kbase1 + (size_t)(kt) * 64 * 1024); \
    vreg0 = *reinterpret_cast<const uint4*>(vbase0 + (kt) * 64); \
    vreg1 = *reinterpret_cast<const uint4*>(vbase1 + (kt) * 64); } while (0)
#define store_tile() do { \
    *reinterpret_cast<uint4*>(kdst0) = kreg0; *reinterpret_cast<uint4*>(kdst1) = kreg1; \
    *reinterpret_cast<uint4*>(vdst0) = vreg0; *reinterpret_cast<uint4*>(vdst1) = vreg1; } while (0)
  load_tile(0);
  for (int kt = 0; kt < nkt; ++kt) {
    __syncthreads();
    store_tile();
    __syncthreads();
    if (kt + 1 < nkt) load_tile(kt + 1);
    if (kt <= my_last) fw.tile(Ks + n * 64 * 72, Vts);
  }
  float inv[2];
#pragma unroll
  for (int qb = 0; qb < 2; ++qb) inv[qb] = 1.f / fw.lsum(qb);
  __syncthreads();
  if (n == 1) {
#pragma unroll
    for (int qb = 0; qb < 2; ++qb)
#pragma unroll
      for (int d = 0; d < 8; ++d) {
      float4 v; v.x = fw.o[qb][d][0] * inv[qb]; v.y = fw.o[qb][d][1] * inv[qb]; v.z = fw.o[qb][d][2] * inv[qb]; v.w = fw.o[qb][d][3] * inv[qb];
      *reinterpret_cast<float4*>(&comb[(qsub * 32 + qb * 16 + fr) * 132 + d * 16 + fq * 4]) = v;
    }
  }
  __syncthreads();
  if (n == 0) {
    const float* sg = (const float*)p.in[I_SUBLN] + l * 128;
    const float post = 1.f - p.lam_init[l];
#pragma unroll
    for (int qb = 0; qb < 2; ++qb) {
      float ss = 0.f;
#pragma unroll
      for (int d = 0; d < 8; ++d) {
        float4 c2 = *reinterpret_cast<const float4*>(&comb[(qsub * 32 + qb * 16 + fr) * 132 + d * 16 + fq * 4]);
        fw.o[qb][d][0] = fw.o[qb][d][0] * inv[qb] - lam * c2.x;
        fw.o[qb][d][1] = fw.o[qb][d][1] * inv[qb] - lam * c2.y;
        fw.o[qb][d][2] = fw.o[qb][d][2] * inv[qb] - lam * c2.z;
        fw.o[qb][d][3] = fw.o[qb][d][3] * inv[qb] - lam * c2.w;
        for (int j = 0; j < 4; ++j) ss += fw.o[qb][d][j] * fw.o[qb][d][j];
      }
      ss += __shfl_xor(ss, 16); ss += __shfl_xor(ss, 32);
      const float rms = rsqrtf(ss * (1.f / 128.f) + 1e-6f) * post;
      u16* op = hcat + (size_t)(tok0 + qsub * 32 + qb * 16 + fr) * 1024 + h * 128;
#pragma unroll
      for (int d = 0; d < 8; ++d) {
        const int dv = d * 16 + fq * 4;
        uint2 ov;
        ov.x = pack2(fw.o[qb][d][0] * rms * sg[dv], fw.o[qb][d][1] * rms * sg[dv + 1]);
        ov.y = pack2(fw.o[qb][d][2] * rms * sg[dv + 2], fw.o[qb][d][3] * rms * sg[dv + 3]);
        *reinterpret_cast<uint2*>(op + dv) = ov;
      }
    }
  }
  __syncthreads();
}

#undef load_tile
#undef store_tile
DI void cross_attn_item(const PRef& p, int tokblk, int h) {
  extern __shared__ __attribute__((aligned(16))) u16 shm[];
  u16* Ks = shm;
  u16* Vts = shm + 64 * 264;
  const u16* qc = (const u16*)(p.ws + OFF_QC);
  const u16* km = (const u16*)(p.ws + OFF_KMEM);
  const u16* vm = (const u16*)(p.ws + OFF_VMEMT);
  u16* oc = (u16*)(p.ws + OFF_OC);
  const int tid = ltid(), w = tid >> 6, lane = tid & 63, fr = lane & 15, fq = lane >> 4;
  const int tok0 = tokblk * 128, b = tok0 >> 12;
  FlashWave<256, 256, 1> fw;
  fw.init();
#pragma unroll
  for (int ks = 0; ks < 8; ++ks)
    fw.qf[0][ks] = *reinterpret_cast<const bf16x8*>(qc + (size_t)(tok0 + w * 16 + fr) * 1024 + h * 256 + ks * 32 + fq * 8);
  uint4 kreg0, kreg1, kreg2, kreg3, vreg0, vreg1, vreg2, vreg3;
  const u16* kbase = km + (size_t)(b * 256 + (tid >> 5)) * 1024 + h * 256 + (tid & 31) * 8;
  const u16* vbase = vm + (size_t)(h * 256 + (tid >> 3)) * 2048 + b * 256 + (tid & 7) * 8;
  u16* kdst = Ks + (tid >> 5) * 264 + (tid & 31) * 8;
  u16* vdst = Vts + (tid >> 3) * 72 + (tid & 7) * 8;
#define load_tile(kt) do { \
    kreg0 = *reinterpret_cast<const uint4*>(kbase + (size_t)((kt) * 64 + 0) * 1024); \
    kreg1 = *reinterpret_cast<const uint4*>(kbase + (size_t)((kt) * 64 + 16) * 1024); \
    kreg2 = *reinterpret_cast<const uint4*>(kbase + (size_t)((kt) * 64 + 32) * 1024); \
    kreg3 = *reinterpret_cast<const uint4*>(kbase + (size_t)((kt) * 64 + 48) * 1024); \
    vreg0 = *reinterpret_cast<const uint4*>(vbase + (size_t)0 * 2048 + (kt) * 64); \
    vreg1 = *reinterpret_cast<const uint4*>(vbase + (size_t)64 * 2048 + (kt) * 64); \
    vreg2 = *reinterpret_cast<const uint4*>(vbase + (size_t)128 * 2048 + (kt) * 64); \
    vreg3 = *reinterpret_cast<const uint4*>(vbase + (size_t)192 * 2048 + (kt) * 64); } while (0)
#define store_tile() do { \
    *reinterpret_cast<uint4*>(kdst) = kreg0; *reinterpret_cast<uint4*>(kdst + 16 * 264) = kreg1; \
    *reinterpret_cast<uint4*>(kdst + 32 * 264) = kreg2; *reinterpret_cast<uint4*>(kdst + 48 * 264) = kreg3; \
    *reinterpret_cast<uint4*>(vdst) = vreg0; *reinterpret_cast<uint4*>(vdst + 64 * 72) = vreg1; \
    *reinterpret_cast<uint4*>(vdst + 128 * 72) = vreg2; *reinterpret_cast<uint4*>(vdst + 192 * 72) = vreg3; } while (0)
  load_tile(0);
  for (int kt = 0; kt < 4; ++kt) {
    __syncthreads();
    store_tile();
    __syncthreads();
    if (kt + 1 < 4) load_tile(kt + 1);
    fw.tile(Ks, Vts);
  }
  const float inv = 1.f / fw.lsum(0);
  u16* op = oc + (size_t)(tok0 + w * 16 + fr) * 1024 + h * 256;
#pragma unroll
  for (int d = 0; d < 16; ++d) {
    uint2 ov;
    ov.x = pack2(fw.o[0][d][0] * inv, fw.o[0][d][1] * inv);
    ov.y = pack2(fw.o[0][d][2] * inv, fw.o[0][d][3] * inv);
    *reinterpret_cast<uint2*>(op + d * 16 + fq * 4) = ov;
  }
  __syncthreads();
}

#undef load_tile
#undef store_tile
DI float row8_sum(float x) {
  x += dpp_f<0xB1>(x);
  x += dpp_f<0x4E>(x);
  x += dpp_f<0x141>(x);
  return x;
}
DI f32v2 bfpair(unsigned q) { f32v2 r; r.x = __uint_as_float(q << 16); r.y = __uint_as_float(q & 0xffff0000u); return r; }

DI void rwkv_scan_item(const PRef& p, int b, int h, int half) {
  extern __shared__ __attribute__((aligned(16))) u16 shm[];
  char* buf = reinterpret_cast<char*>(shm);
  float* ybuf = reinterpret_cast<float*>(buf + 2 * 16 * 1152);
  float* dummy = ybuf + 1024;
  const char* rec = p.ws + OFF_REC + (size_t)((b * 4 + h) * SEQ) * 1152;
  float* Y = (float*)(p.ws + OFF_Y);
  const int tid = ltid(), w = tid >> 6, lane = tid & 63;
  const int rl = (w & 3) * 8 + (lane >> 3);
  const int row = half * 32 + rl;
  const int ks = (lane & 7) * 8;
  const bool compute = w < 4;
  const bool leader = (lane & 7) == 0;
  float* ydst0 = leader ? (ybuf + rl) : (dummy + (tid & 255));
  const int ystride = leader ? 32 : 0;
  f32v2 S01 = {0.f, 0.f}, S23 = {0.f, 0.f}, S45 = {0.f, 0.f}, S67 = {0.f, 0.f};
  uint4 rg0, rg1, rg2 = make_uint4(0, 0, 0, 0);
  auto load_chunk = [&](int ch) {
    const uint4* src = reinterpret_cast<const uint4*>(rec + (size_t)ch * 16 * 1152);
    rg0 = src[tid]; rg1 = src[tid + 512];
    if (tid < 128) rg2 = src[tid + 1024];
  };
  load_chunk(0);
  __syncthreads();
  for (int ch = 0; ch < SEQ / 16; ++ch) {
    char* cb = buf + (ch & 1) * 16 * 1152;
    {
      uint4* dst = reinterpret_cast<uint4*>(cb);
      dst[tid] = rg0; dst[tid + 512] = rg1;
      if (tid < 128) dst[tid + 1024] = rg2;
    }
    __syncthreads();
    if (ch + 1 < SEQ / 16) load_chunk(ch + 1);
    if (ch > 0) {
      const float* ybp = ybuf + ((ch - 1) & 1) * 512;
      const int st = tid >> 5, r = tid & 31;
      Y[(size_t)(b * SEQ + (ch - 1) * 16 + st) * 256 + h * 64 + half * 32 + r] = ybp[tid];
    }
    if (compute) {
      float* yd = ydst0 + (leader ? (ch & 1) * 512 : 0);
      const char* sp = cb;
      float4 wa = *reinterpret_cast<const float4*>(sp + ks * 4), wb = *reinterpret_cast<const float4*>(sp + ks * 4 + 16);
      float4 ka = *reinterpret_cast<const float4*>(sp + 256 + ks * 4), kb = *reinterpret_cast<const float4*>(sp + 256 + ks * 4 + 16);
      float4 ba = *reinterpret_cast<const float4*>(sp + 512 + ks * 4), bbv = *reinterpret_cast<const float4*>(sp + 512 + ks * 4 + 16);
      uint4 kq = *reinterpret_cast<const uint4*>(sp + 768 + ks * 2);
      uint4 rq = *reinterpret_cast<const uint4*>(sp + 896 + ks * 2);
      unsigned vq = *reinterpret_cast<const u16*>(sp + 1024 + row * 2);
#pragma unroll
      for (int st = 0; st < 16; ++st) {
        float4 wan, wbn, kan, kbn, ban, bbn; uint4 kqn, rqn; unsigned vqn;
        if (st < 15) {
          const char* sn = cb + (st + 1) * 1152;
          wan = *reinterpret_cast<const float4*>(sn + ks * 4); wbn = *reinterpret_cast<const float4*>(sn + ks * 4 + 16);
          kan = *reinterpret_cast<const float4*>(sn + 256 + ks * 4); kbn = *reinterpret_cast<const float4*>(sn + 256 + ks * 4 + 16);
          ban = *reinterpret_cast<const float4*>(sn + 512 + ks * 4); bbn = *reinterpret_cast<const float4*>(sn + 512 + ks * 4 + 16);
          kqn = *reinterpret_cast<const uint4*>(sn + 768 + ks * 2);
          rqn = *reinterpret_cast<const uint4*>(sn + 896 + ks * 2);
          vqn = *reinterpret_cast<const u16*>(sn + 1024 + row * 2);
        }
        const float v = __uint_as_float(vq << 16);
        const f32v2 vv = {v, v};
        const f32v2 kk01 = {ka.x, ka.y}, kk23 = {ka.z, ka.w}, kk45 = {kb.x, kb.y}, kk67 = {kb.z, kb.w};
        f32v2 sa2 = S01 * kk01 + S23 * kk23;
        f32v2 sb2 = S45 * kk45 + S67 * kk67;
        sa2 += sb2;
        float sa = row8_sum(sa2.x + sa2.y);
        const f32v2 sav = {sa, sa};
        S01 = S01 * f32v2{wa.x, wa.y} - sav * f32v2{ba.x, ba.y} + vv * bfpair(kq.x);
        S23 = S23 * f32v2{wa.z, wa.w} - sav * f32v2{ba.z, ba.w} + vv * bfpair(kq.y);
        S45 = S45 * f32v2{wb.x, wb.y} - sav * f32v2{bbv.x, bbv.y} + vv * bfpair(kq.z);
        S67 = S67 * f32v2{wb.z, wb.w} - sav * f32v2{bbv.z, bbv.w} + vv * bfpair(kq.w);
        f32v2 ya = S01 * bfpair(rq.x) + S23 * bfpair(rq.y);
        f32v2 yb2 = S45 * bfpair(rq.z) + S67 * bfpair(rq.w);
        ya += yb2;
        float y = row8_sum(ya.x + ya.y);
        yd[st * ystride] = y;
        if (st < 15) { wa = wan; wb = wbn; ka = kan; kb = kbn; ba = ban; bbv = bbn; kq = kqn; rq = rqn; vq = vqn; }
      }
    }
  }
  __syncthreads();
  {
    const int ch = SEQ / 16 - 1;
    const float* ybp = ybuf + (ch & 1) * 512;
    const int st = tid >> 5, r = tid & 31;
    Y[(size_t)(b * SEQ + ch * 16 + st) * 256 + h * 64 + half * 32 + r] = ybp[tid];
  }
  __syncthreads();
}

DI float gelu_tanh(float x) {
  float u = 0.7978845608028654f * (x + 0.044715f * x * x * x);
  return 0.5f * x * (1.f + tanhf(u));
}
DI void s5_item(const PRef& p, int l, int b, int g) {
  extern __shared__ __attribute__((aligned(16))) u16 shm[];
  float* uL = reinterpret_cast<float*>(shm);
  float* fin = uL + 8 * 256;
  float* xL = fin + 8 * 128;
  const u16* s5 = (const u16*)(p.ws + OFF_S5);
  u16* Z = (u16*)(p.ws + OFF_Z);
  const int tid = ltid(), w = tid >> 6, lane = tid & 63;
  const float Are = ((const float*)p.in[I_SARE])[(l * 16 + g) * 64 + lane];
  const float Aim = ((const float*)p.in[I_SAIM])[(l * 16 + g) * 64 + lane];
  const float delta = expf(((const float*)p.in[I_SLOG])[l * 16 + g]);
  float cr, ci;
  {
    float er = expf(delta * Are); float sn, cs; sincosf(delta * Aim, &sn, &cs);
    cr = er * cs; ci = er * sn;
  }
  float Bre[16], Bim[16];
  {
    const float x = cr - 1.f, y = ci, den = 1.f / (Are * Are + Aim * Aim);
    const float qre = (x * Are + y * Aim) * den, qim = (y * Are - x * Aim) * den;
    const float* bre = (const float*)p.in[I_SBRE] + ((size_t)(l * 16 + g) * 64 + lane) * 16;
    const float* bim = (const float*)p.in[I_SBIM] + ((size_t)(l * 16 + g) * 64 + lane) * 16;
#pragma unroll
    for (int hh = 0; hh < 16; ++hh) { float br = bre[hh], bi = bim[hh]; Bre[hh] = qre * br - qim * bi; Bim[hh] = qre * bi + qim * br; }
  }
  __syncthreads();
  bf16x8 cf[4];
  {
    const int hq = lane & 15, q4 = lane >> 4;
    const float* cre = (const float*)p.in[I_SCRE] + ((size_t)(l * 16 + g) * 16 + hq) * 64;
    const float* cim = (const float*)p.in[I_SCIM] + ((size_t)(l * 16 + g) * 16 + hq) * 64;
#pragma unroll
    for (int s4 = 0; s4 < 4; ++s4) {
      const float4 re = *reinterpret_cast<const float4*>(cre + 16 * s4 + 4 * q4);
      const float4 im = *reinterpret_cast<const float4*>(cim + 16 * s4 + 4 * q4);
      cf[s4] = __builtin_bit_cast(bf16x8, (u32x4{pack2(re.x, -im.x), pack2(re.y, -im.y), pack2(re.z, -im.z), pack2(re.w, -im.w)}));
    }
  }
  const int tbase = b * SEQ + w * 512;
  float* uw = uL + w * 256;
  auto load_u = [&](int ch) {
    const int tt = lane >> 2, c4 = (lane & 3) * 4;
    uint2 raw = *reinterpret_cast<const uint2*>(s5 + (size_t)(tbase + ch * 16 + tt) * 256 + g * 16 + c4);
    float4 f; f.x = __uint_as_float(raw.x << 16); f.y = __uint_as_float(raw.x & 0xffff0000u);
    f.z = __uint_as_float(raw.y << 16); f.w = __uint_as_float(raw.y & 0xffff0000u);
    *reinterpret_cast<float4*>(uw + tt * 16 + c4) = f;
  };
  float xr = 0.f, xi = 0.f;
  for (int ch = 0; ch < 32; ++ch) {
    __syncthreads();
    load_u(ch);
    __syncthreads();
#pragma unroll 4
    for (int tt = 0; tt < 16; ++tt) {
      float bur = 0.f, bui = 0.f;
#pragma unroll
      for (int h4 = 0; h4 < 4; ++h4) {
        float4 u = *reinterpret_cast<const float4*>(uw + tt * 16 + h4 * 4);
        bur += Bre[h4 * 4] * u.x + Bre[h4 * 4 + 1] * u.y + Bre[h4 * 4 + 2] * u.z + Bre[h4 * 4 + 3] * u.w;
        bui += Bim[h4 * 4] * u.x + Bim[h4 * 4 + 1] * u.y + Bim[h4 * 4 + 2] * u.z + Bim[h4 * 4 + 3] * u.w;
      }
      float nr = cr * xr - ci * xi + bur, ni = cr * xi + ci * xr + bui;
      xr = nr; xi = ni;
    }
  }
  fin[(w * 64 + lane) * 2] = xr; fin[(w * 64 + lane) * 2 + 1] = xi;
  __syncthreads();
  {
    float pr = cr, pi = ci;
    for (int i = 0; i < 9; ++i) { float nr = pr * pr - pi * pi, ni = 2.f * pr * pi; pr = nr; pi = ni; }
    float vr = 0.f, vi = 0.f;
    for (int ww = 0; ww < w; ++ww) {
      float fr_ = fin[(ww * 64 + lane) * 2], fi_ = fin[(ww * 64 + lane) * 2 + 1];
      float nr = pr * vr - pi * vi + fr_, ni = pr * vi + pi * vr + fi_;
      vr = nr; vi = ni;
    }
    xr = vr; xi = vi;
  }
  float* xw = xL + w * (16 * 66 * 2);
  const int ot = lane & 15, oh = (lane >> 4) * 4;
  const float* dsk = (const float*)p.in[I_SD] + l * 256 + g * 16 + oh;
  const float d0 = dsk[0], d1 = dsk[1], d2 = dsk[2], d3 = dsk[3];
  for (int ch = 0; ch < 32; ++ch) {
    __syncthreads();
    load_u(ch);
    __syncthreads();
#pragma unroll 4
    for (int tt = 0; tt < 16; ++tt) {
      float bur = 0.f, bui = 0.f;
#pragma unroll
      for (int h4 = 0; h4 < 4; ++h4) {
        float4 u = *reinterpret_cast<const float4*>(uw + tt * 16 + h4 * 4);
        bur += Bre[h4 * 4] * u.x + Bre[h4 * 4 + 1] * u.y + Bre[h4 * 4 + 2] * u.z + Bre[h4 * 4 + 3] * u.w;
        bui += Bim[h4 * 4] * u.x + Bim[h4 * 4 + 1] * u.y + Bim[h4 * 4 + 2] * u.z + Bim[h4 * 4 + 3] * u.w;
      }
      float nr = cr * xr - ci * xi + bur, ni = cr * xi + ci * xr + bui;
      xr = nr; xi = ni;
      *reinterpret_cast<float2*>(xw + (tt * 66 + lane) * 2) = make_float2(xr, xi);
    }
    __syncthreads();
    f32x4 yacc = f32x4{0.f, 0.f, 0.f, 0.f};
#pragma unroll
    for (int s4 = 0; s4 < 4; ++s4) {
      const float* xp = xw + (ot * 66 + 16 * s4 + oh) * 2;
      const float4 f0 = *reinterpret_cast<const float4*>(xp), f1 = *reinterpret_cast<const float4*>(xp + 4);
      const bf16x8 xf = __builtin_bit_cast(bf16x8, (u32x4{pack2(f0.x, f0.y), pack2(f0.z, f0.w), pack2(f1.x, f1.y), pack2(f1.z, f1.w)}));
      yacc = __builtin_amdgcn_mfma_f32_16x16x32_bf16(cf[s4], xf, yacc, 0, 0, 0);
    }
    float a0 = yacc[0], a1 = yacc[1], a2 = yacc[2], a3 = yacc[3];
    float4 u = *reinterpret_cast<const float4*>(uw + ot * 16 + oh);
    a0 = gelu_tanh(a0 + d0 * u.x); a1 = gelu_tanh(a1 + d1 * u.y); a2 = gelu_tanh(a2 + d2 * u.z); a3 = gelu_tanh(a3 + d3 * u.w);
    uint2 ov; ov.x = pack2(a0, a1); ov.y = pack2(a2, a3);
    *reinterpret_cast<uint2*>(Z + (size_t)(tbase + ch * 16 + ot) * 256 + g * 16 + oh) = ov;
  }
  __syncthreads();
}

DI void phase_mixers(const PRef& p, int lc) {
  __shared__ int s_item;
  unsigned* cnt = (unsigned*)(p.ws + OFF_CNT) + lc;
  const int l = lc & 7;
  const int total = 64 + 128 + 1024;
  while (true) {
    __syncthreads();
    if (ltid() == 0) s_item = (int)atomicAdd(cnt, 1u);
    __syncthreads();
    const int item = s_item;
    if (item >= total) break;
    kaptr_t ka2 = p.in.ka; asm volatile("" : "+s"(ka2)); const PRef q(ka2);
    const int cls = (lc >= 8) ? (PROBE_DUP >> 4) : 7;
    if (item < 64) { if (cls & 1) rwkv_scan_item(q, item >> 3, (item >> 1) & 3, item & 1); }
    else if (item < 192) { int i = item - 64; if (cls & 2) s5_item(q, l, i >> 4, i & 15); }
    else { int i = item - 192; int qt = 31 - (i >> 5); int bh = i & 31; if (cls & 4) diff_attn_item(q, l, bh >> 2, bh & 3, qt); }
  }
}

DI void phase_post(const PRef& p, int l) {
  const float* Y = (const float*)(p.ws + OFF_Y);
  const u16* gbuf = (const u16*)(p.ws + OFF_G);
  const u16* Z = (const u16*)(p.ws + OFF_Z);
  const float* bonus = (const float*)(p.ws + OFF_BONUS);
  const char* rec = p.ws + OFF_REC;
  u16* hcat = (u16*)(p.ws + OFF_HCAT);
  const u16* glut = (const u16*)(p.ws + OFF_WT + WT_GLU);
  const float* lng = (const float*)p.in[I_LNXG] + l * 256;
  const float* lnb = (const float*)p.in[I_LNXB] + l * 256;
  const float* glub = (const float*)p.in[I_GLUB] + l * 256;
  const float* outg = (const float*)p.in[I_SOUTG] + l * 256;
  const int tid = ltid(), w = tid >> 6, lane = tid & 63, fr = lane & 15, fq = lane >> 4;
  for (int item = blockIdx.x; item < NTOK / 128; item += gridDim.x) {
    const int tk0 = item * 128;
    {
      const int c = tid & 255, half = tid >> 8, h = c >> 6, cc = c & 63;
      const float gw = lng[c], gb = lnb[c];
      for (int i0 = 0; i0 < 64; i0 += 8) {
        float yv[8], vv[8], gq[8], bo[8];
#pragma unroll
        for (int u = 0; u < 8; ++u) {
          const int tok = tk0 + half * 64 + i0 + u;
          const int b = tok >> 12, t = tok & (SEQ - 1);
          const char* rp = rec + ((size_t)((b * 4 + h) * SEQ + t)) * 1152;
          yv[u] = Y[(size_t)tok * 256 + c];
          vv[u] = bf2f(reinterpret_cast<const u16*>(rp + 1024)[cc]);
          gq[u] = bf2f(gbuf[(size_t)tok * 256 + c]);
          bo[u] = bonus[(size_t)tok * 4 + h];
        }
        float mean[8], var[8];
#pragma unroll
        for (int u = 0; u < 8; ++u) { float t = row16_sum(yv[u]); t += __shfl_xor(t, 16); t += __shfl_xor(t, 32); mean[u] = t * (1.f / 64.f); }
#pragma unroll
        for (int u = 0; u < 8; ++u) { float d = yv[u] - mean[u]; float t = row16_sum(d * d); t += __shfl_xor(t, 16); t += __shfl_xor(t, 32); var[u] = t * (1.f / 64.f); }
#pragma unroll
        for (int u = 0; u < 8; ++u) {
          const int tok = tk0 + half * 64 + i0 + u;
          float out = (yv[u] - mean[u]) * rsqrtf(var[u] + 64e-5f) * gw + gb + bo[u] * vv[u];
          out *= gq[u];
          hcat[(size_t)tok * 1024 + 512 + c] = f2bf(out);
        }
      }
    }
    {
      const int tokw = tk0 + w * 16;
      bf16x8 zf[8];
#pragma unroll
      for (int s = 0; s < 8; ++s) zf[s] = *reinterpret_cast<const bf16x8*>(Z + (size_t)(tokw + fr) * 256 + s * 32 + fq * 8);
      float ss = 0.f, rms = 0.f;
      for (int pass = 0; pass < 2; ++pass) {
#pragma unroll 2
        for (int nb = 0; nb < 16; ++nb) {
          f32x4 acc = f32x4{0.f, 0.f, 0.f, 0.f};
#pragma unroll
          for (int s = 0; s < 8; ++s) {
            bf16x8 wf = *reinterpret_cast<const bf16x8*>(glut + (size_t)(nb * 16 + fr) * 256 + s * 32 + fq * 8);
            acc = __builtin_amdgcn_mfma_f32_16x16x32_bf16(wf, zf[s], acc, 0, 0, 0);
          }
          const int col = nb * 16 + fq * 4;
          uint2 zr = *reinterpret_cast<const uint2*>(Z + (size_t)(tokw + fr) * 256 + col);
          float z0 = __uint_as_float(zr.x << 16), z1 = __uint_as_float(zr.x & 0xffff0000u);
          float z2 = __uint_as_float(zr.y << 16), z3 = __uint_as_float(zr.y & 0xffff0000u);
          float o0 = z0 * sigmoidf_(acc[0] + glub[col]), o1 = z1 * sigmoidf_(acc[1] + glub[col + 1]);
          float o2 = z2 * sigmoidf_(acc[2] + glub[col + 2]), o3 = z3 * sigmoidf_(acc[3] + glub[col + 3]);
          if (pass == 0) ss += o0 * o0 + o1 * o1 + o2 * o2 + o3 * o3;
          else {
            uint2 ov;
            ov.x = pack2(o0 * rms * outg[col], o1 * rms * outg[col + 1]);
            ov.y = pack2(o2 * rms * outg[col + 2], o3 * rms * outg[col + 3]);
            *reinterpret_cast<uint2*>(hcat + (size_t)(tokw + fr) * 1024 + 768 + col) = ov;
          }
        }
        if (pass == 0) { ss += __shfl_xor(ss, 16); ss += __shfl_xor(ss, 32); rms = rsqrtf(ss * (1.f / 256.f) + 1e-6f); }
      }
    }
  }
}

DI void phase_ln(const PRef& p, const float* g, const float* bta) {
  float* xs = p.xs; u16* xb = (u16*)(p.ws + OFF_XB);
  const int w = ltid() >> 6, lane = ltid() & 63;
  for (int tok = blockIdx.x * 8 + w; tok < NTOK; tok += gridDim.x * 8) {
    float4* row = reinterpret_cast<float4*>(xs + (size_t)tok * DM);
    float4 v[4]; float s = 0.f;
    for (int i = 0; i < 4; ++i) { v[i] = row[lane + i * 64]; s += v[i].x + v[i].y + v[i].z + v[i].w; }
    const float mean = wave_sum(s) * (1.f / 1024.f);
    float q = 0.f;
    for (int i = 0; i < 4; ++i) { float a = v[i].x - mean, b = v[i].y - mean, c = v[i].z - mean, d = v[i].w - mean; q += a * a + b * b + c * c + d * d; }
    const float rstd = rsqrtf(wave_sum(q) * (1.f / 1024.f) + 1e-5f);
    for (int i = 0; i < 4; ++i) {
      const int col = (lane + i * 64) * 4;
      float4 gg = *reinterpret_cast<const float4*>(g + col), bb = *reinterpret_cast<const float4*>(bta + col);
      float4 o;
      o.x = (v[i].x - mean) * rstd * gg.x + bb.x; o.y = (v[i].y - mean) * rstd * gg.y + bb.y;
      o.z = (v[i].z - mean) * rstd * gg.z + bb.z; o.w = (v[i].w - mean) * rstd * gg.w + bb.w;
      row[lane + i * 64] = o;
      uint2 ob; ob.x = pack2(o.x, o.y); ob.y = pack2(o.z, o.w);
      *reinterpret_cast<uint2*>(xb + (size_t)tok * DM + col) = ob;
    }
  }
}

DI void phase_conv(const PRef& p, int l) {
  char* ws = p.ws;
  u16* hmid = (u16*)(ws + OFF_AG);
  const float* af = (const float*)(ws + OFF_AF); const float* gf = (const float*)(ws + OFF_GF); const float* al = (const float*)(ws + OFF_AL);
  const float* cw = (const float*)p.in[I_CONVW] + (size_t)l * 3 * DFF;
  const float* cb = (const float*)p.in[I_CONVB] + (size_t)l * DFF;
  for (int it = blockIdx.x * 512 + ltid(); it < 128 * DFF; it += gridDim.x * 512) {
    const int pm = it / DFF, c = it % DFF;
    const float a0 = af[(size_t)(pm * 2) * DFF + c], a1 = af[(size_t)(pm * 2 + 1) * DFF + c];
    const float g0 = gf[(size_t)(pm * 2) * DFF + c], g1 = gf[(size_t)(pm * 2 + 1) * DFF + c];
    float l0 = 0.f, l1 = 0.f;
    if ((pm & 15) != 0) { l0 = al[(size_t)((pm - 1) * 2) * DFF + c]; l1 = al[(size_t)((pm - 1) * 2 + 1) * DFF + c]; }
    const float w0 = cw[c], w1 = cw[DFF + c], w2 = cw[2 * DFF + c], bs = cb[c];
    const float cv0 = bs + w0 * l0 + w1 * l1 + w2 * a0;
    const float cv1 = bs + w0 * l1 + w1 * a0 + w2 * a1;
    hmid[(size_t)(pm * 256) * DFF + c] = f2bf(cv0 * sigmoidf_(cv0) * g0);
    hmid[(size_t)(pm * 256 + 1) * DFF + c] = f2bf(cv1 * sigmoidf_(cv1) * g1);
  }
}

DI void phase_gemm(const PRef& p, int kind, int l) {
  int nN = 4, K = 1024, lda = 1024, ldb = 1024;
  if (kind == 0) nN = 9;
  if (kind == 10) nN = 22;
  if (kind == 12) { lda = 2816; ldb = 2816; K = 2816; }
  const int ntile = 128 * nN;
  const bool remap = (gridDim.x & 7) == 0;
  const int per = remap ? (ntile >> 3) : ntile, xcd = blockIdx.x & 7;
  const int slot = remap ? (int)(blockIdx.x >> 3) : (int)blockIdx.x, nslot = remap ? (int)(gridDim.x >> 3) : (int)gridDim.x;
  const int n_main = (slot < per) ? (per - slot + nslot - 1) / nslot : 0;
  const int t0x = remap ? (int)((((blockIdx.x >> 3) + 16) & 31) * 8 + (blockIdx.x & 7)) : (int)blockIdx.x;
  const int n_extra = (kind == 0 && t0x < 320) ? (320 - t0x + (int)gridDim.x - 1) / (int)gridDim.x : 0;
  const kaptr_t ka = p.in.ka;
  auto tile_fn = [&](int idx) -> TileDesc {
    const PRef q(ka);
    char* ws = q.ws; char* wt = ws + OFF_WT;
    const u16* xb = (const u16*)(ws + OFF_XB);
    TileDesc d; d.sub = 0; d.A = xb;
    if (idx < n_main) {
      const int jj = slot + idx * nslot;
      const int t = remap ? xcd * per + jj : jj;
      int pm = t / nN, pn = t % nN;
      if (kind == 0) { d.B = (const u16*)(wt + WT_IN); pn = (pn < 4) ? pn : pn + 2; }
      else if (kind == 4) { d.A = (const u16*)(ws + OFF_HCAT); d.B = (const u16*)(wt + WT_OUT); }
      else if (kind == 6) d.B = (const u16*)(wt + WT_Q);
      else if (kind == 8) { d.A = (const u16*)(ws + OFF_OC); d.B = (const u16*)(wt + WT_O); }
      else if (kind == 10) d.B = (const u16*)(wt + WT_UP);
      else { d.A = (const u16*)(ws + OFF_AG); d.B = (const u16*)(wt + WT_DOWN); }
      d.brow = pm * 256; d.bcol = pn * 256;
    } else {
      const int t = t0x + (idx - n_main) * (int)gridDim.x;
      const u16* wint = (const u16*)(wt + WT_IN); const u16* wkvt = (const u16*)(wt + WT_KV); const u16* memb = (const u16*)(ws + OFF_MEMB);
      int pm, pn;
      if (t < 256) { pn = t >> 1; pm = t & 1; d.A = wint + (size_t)1024 * 1024; d.B = xb; d.sub = 1; }
      else if (t < 288) { int i = t - 256; pm = i >> 2; pn = i & 3; d.A = memb; d.B = wkvt; d.sub = 2; }
      else { int i = t - 288; pm = i >> 3; pn = i & 7; d.A = wkvt + (size_t)1024 * 1024; d.B = memb; d.sub = 3; }
      d.brow = pm * 256; d.bcol = pn * 256;
    }
    return d;
  };
  EpiGen e; e.kind = kind; e.lay = l; e.ka = ka;
  gemm_stream(n_main + n_extra, lda, ldb, K, tile_fn, e);
}
DI void phase_cross(const PRef& p) {
  for (int it = blockIdx.x; it < 1024; it += gridDim.x) cross_attn_item(p, it >> 2, it & 3);
}

constexpr int PH_PER_LAYER = 14, N_PHASES = 1 + DEPTH * PH_PER_LAYER;

DI void run_phase(const PRef& p, int ph) {
  if (ph == 0) { phase_init(p); phase_transposes(p, 0); return; }
  const int l = (ph - 1) / PH_PER_LAYER, s = (ph - 1) % PH_PER_LAYER;
  if (s == 0 || s == 4 || s == 6 || s == 8 || s == 10 || s == 12) {
    phase_gemm(p, s, l);
    if ((PROBE_DUP & 1) && (s == 0 || s == 6 || s == 10)) phase_gemm(p, s, l);
    return;
  }
  switch (s) {
    case 1: phase_prep(p, l); break;
    case 2: phase_mixers(p, l); if (PROBE_DUP & 2) phase_mixers(p, l + 8); break;
    case 3: phase_post(p, l); if (PROBE_DUP & 8) phase_post(p, l); break;
    case 5: phase_ln(p, (const float*)p.in[I_LN1G] + l * DM, (const float*)p.in[I_LN1B] + l * DM); break;
    case 7: phase_cross(p); if (PROBE_DUP & 4) phase_cross(p); break;
    case 9: phase_ln(p, (const float*)p.in[I_LN2G] + l * DM, (const float*)p.in[I_LN2B] + l * DM); break;
    case 11: phase_conv(p, l); break;
    case 13:
      phase_ln(p, (const float*)p.in[I_LN3G] + l * DM, (const float*)p.in[I_LN3B] + l * DM);
      if (l + 1 < DEPTH) phase_transposes(p, l + 1);
      break;
  }
}

template <int S>
__global__ void __launch_bounds__(512) ph_kernel(Params p_unused, int l) {
  kaptr_t ka = (kaptr_t)__builtin_amdgcn_kernarg_segment_ptr();
  const PRef p(ka);
  if (S < 0) { phase_init(p); phase_transposes(p, 0); return; }
  if (S == 0 || S == 4 || S == 6 || S == 8 || S == 10 || S == 12) { phase_gemm(p, S, l); return; }
  if (S == 1) phase_prep(p, l);
  if (S == 2) phase_mixers(p, l);
  if (S == 3) phase_post(p, l);
  if (S == 5) phase_ln(p, (const float*)p.in[I_LN1G] + l * DM, (const float*)p.in[I_LN1B] + l * DM);
  if (S == 7) phase_cross(p);
  if (S == 9) phase_ln(p, (const float*)p.in[I_LN2G] + l * DM, (const float*)p.in[I_LN2B] + l * DM);
  if (S == 11) phase_conv(p, l);
  if (S == 13) {
    phase_ln(p, (const float*)p.in[I_LN3G] + l * DM, (const float*)p.in[I_LN3B] + l * DM);
    if (l + 1 < DEPTH) phase_transposes(p, l + 1);
  }
}

#if !MULTI_LAUNCH
__device__ unsigned g_bar = 0;
#ifndef USE_COOP
#define USE_COOP 1
#endif

__global__ void __launch_bounds__(512) fwd_kernel(Params p_unused, int ph_begin, int ph_end) {
#if USE_COOP
  cg::this_grid().sync();
#endif
  __shared__ unsigned s_base;
  for (int ph = ph_begin; ph < ph_end; ++ph) {
    kaptr_t ka = (kaptr_t)__builtin_amdgcn_kernarg_segment_ptr();
    asm volatile("" : "+s"(ka));
    const PRef p(ka);
    run_phase(p, ph);
    if (ph + 1 < ph_end) {
      asm volatile("s_waitcnt vmcnt(0) lgkmcnt(0)" ::: "memory");
      __syncthreads();
      if (threadIdx.x == 0) {
        __builtin_amdgcn_fence(__ATOMIC_RELEASE, "agent");
        asm volatile("s_waitcnt vmcnt(0)" ::: "memory");
        const unsigned nbar = (unsigned)(ph - ph_begin + 1);
        unsigned old = __hip_atomic_fetch_add(&g_bar, 1u, __ATOMIC_RELAXED, __HIP_MEMORY_SCOPE_AGENT);
        if (nbar == 1) { const unsigned per_launch = (unsigned)(ph_end - ph_begin - 1) * gridDim.x; s_base = old - (old % per_launch); }
        const unsigned target = s_base + nbar * gridDim.x;
        while ((int)(__hip_atomic_load(&g_bar, __ATOMIC_RELAXED, __HIP_MEMORY_SCOPE_AGENT) - target) < 0) __builtin_amdgcn_s_sleep(4);
        __builtin_amdgcn_fence(__ATOMIC_ACQUIRE, "agent");
        asm volatile("s_waitcnt vmcnt(0)" ::: "memory");
      }
      __syncthreads();
    }
  }
}
#endif

constexpr size_t kDynLds = 131072 + 4096;

template <int S> static void launch_ph(const Params& p, int l, int grid, hipStream_t stream) {
  static bool attr_done = false;
  if (!attr_done) { (void)hipFuncSetAttribute((const void*)ph_kernel<S>, hipFuncAttributeMaxDynamicSharedMemorySize, (int)kDynLds); attr_done = true; }
  hipLaunchKernelGGL(ph_kernel<S>, dim3(grid), dim3(512), kDynLds, stream, p, l);
}

extern "C" void kernel_launch(void* const* d_in, const int* in_sizes, int n_in, void* d_out, int out_size, void* d_ws, size_t ws_size,
                              hipStream_t stream) {
  Params p;
  memset(&p, 0, sizeof(p));
  for (int i = 0; i < N_IN && i < n_in; ++i) p.in[i] = d_in[i];
  p.xs = (float*)d_out;
  p.ws = (char*)d_ws;
  for (int l = 0; l < 4; ++l) p.lam_init[l] = (float)(0.8 - 0.6 * exp(-0.3 * (double)l));
#if MULTI_LAUNCH
  const int grid = 256;
  launch_ph<-1>(p, 0, grid, stream);
  for (int l = 0; l < DEPTH; ++l) {
    launch_ph<0>(p, l, grid, stream); launch_ph<1>(p, l, grid, stream); launch_ph<2>(p, l, grid, stream); launch_ph<3>(p, l, grid, stream);
    launch_ph<4>(p, l, grid, stream); launch_ph<5>(p, l, grid, stream); launch_ph<6>(p, l, grid, stream); launch_ph<7>(p, l, grid, stream);
    launch_ph<8>(p, l, grid, stream); launch_ph<9>(p, l, grid, stream); launch_ph<10>(p, l, grid, stream); launch_ph<11>(p, l, grid, stream);
    launch_ph<12>(p, l, grid, stream); launch_ph<13>(p, l, grid, stream);
  }
#else
  static int grid_blocks = 0;
  if (!grid_blocks) {
    (void)hipFuncSetAttribute((const void*)fwd_kernel, hipFuncAttributeMaxDynamicSharedMemorySize, (int)kDynLds);
    int dev = 0, cus = 0, per_cu = 0;
    (void)hipGetDevice(&dev);
    (void)hipDeviceGetAttribute(&cus, hipDeviceAttributeMultiprocessorCount, dev);
    (void)hipOccupancyMaxActiveBlocksPerMultiprocessor(&per_cu, fwd_kernel, 512, kDynLds);
    if (per_cu < 1) per_cu = 1;
    grid_blocks = cus * per_cu;
    if (grid_blocks <= 0) grid_blocks = 256;
    if (per_cu > 1) grid_blocks = cus;
  }
  int b = 0, e = N_PHASES;
#if USE_COOP
  void* args[] = {&p, &b, &e};
  hipError_t err = hipLaunchCooperativeKernel((void*)fwd_kernel, dim3(grid_blocks), dim3(512), args, kDynLds, stream);
  if (err != hipSuccess) fprintf(stderr, "cooperative launch failed: %s (grid %d)\n", hipGetErrorString(err), grid_blocks);
#else
#ifdef BISECT_PER_PHASE
  for (int ph = 0; ph < N_PHASES; ++ph) hipLaunchKernelGGL(fwd_kernel, dim3(grid_blocks), dim3(512), kDynLds, stream, p, ph, ph + 1);
#else
  hipLaunchKernelGGL(fwd_kernel, dim3(grid_blocks), dim3(512), kDynLds, stream, p, b, e);
#endif
#endif
#endif
}
```

```cpp
#include <hip/hip_runtime.h>
#include <hip/hip_bf16.h>
#include <hip/hip_cooperative_groups.h>
#include <cstdio>
#include <cstring>
#include <cmath>
#include <cstddef>
namespace cg = cooperative_groups;

#ifndef PROBE_DUP
#define PROBE_DUP 0
#endif
#ifndef MULTI_LAUNCH
#define MULTI_LAUNCH 0
#endif

typedef unsigned short u16;
using bf16x8 = __attribute__((ext_vector_type(8))) short;
using f32x4 = __attribute__((ext_vector_type(4))) float;
using u32x4 = __attribute__((ext_vector_type(4))) unsigned;
#define DI __device__ __forceinline__

constexpr int NTOK = 32768, DM = 1024, SEQ = 4096, NBATCH = 8, DEPTH = 4;
constexpr int INW = 2688, DFF = 2816;
constexpr float ALPHA = 1.681792830507429f;
constexpr float LOG2E = 1.4426950408889634f;

enum { I_X = 0, I_MEM, I_POS, I_WIN, I_LQ1, I_LK1, I_LQ2, I_LK2, I_SUBLN, I_MU, I_W0, I_W2, I_A0, I_A2, I_G2, I_KK, I_KA, I_RK,
       I_LNXG, I_LNXB, I_SARE, I_SAIM, I_SBRE, I_SBIM, I_SCRE, I_SCIM, I_SD, I_SLOG, I_GLUW, I_GLUB, I_SOUTG, I_WOUT, I_LN1G, I_LN1B,
       I_WQ, I_WKV, I_WO, I_LN2G, I_LN2B, I_WUP, I_CONVW, I_CONVB, I_WDOWN, I_LN3G, I_LN3B, N_IN };

constexpr size_t MiB = 1024 * 1024;
constexpr size_t OFF_XB = 0;
constexpr size_t OFF_Y = 0, OFF_G = 32 * MiB, OFF_Z = 48 * MiB;
constexpr size_t OFF_WT = 64 * MiB;
constexpr size_t WT_IN = 0, WT_OUT = WT_IN + 2816ul * 1024 * 2, WT_Q = WT_OUT + 2 * MiB, WT_KV = WT_Q + 2 * MiB, WT_O = WT_KV + 4 * MiB,
                 WT_UP = WT_O + 2 * MiB, WT_DOWN = WT_UP + 11 * MiB, WT_GLU = WT_DOWN + 2816ul * 1024 * 2,
                 WT_W2T = WT_GLU + 131072, WT_A2T = WT_W2T + 16384, WT_G2T = WT_A2T + 16384;
constexpr size_t OFF_KMEM = 97 * MiB;
constexpr size_t OFF_VMEMT = 101 * MiB;
constexpr size_t OFF_MEMB = 105 * MiB;
constexpr size_t OFF_ROPE = 109 * MiB;
constexpr size_t OFF_CNT = 117 * MiB;
constexpr size_t OFF_BONUS = 118 * MiB;
constexpr size_t OFF_DR = 120 * MiB;
constexpr size_t OFF_QK = OFF_DR;
constexpr size_t OFF_RW = OFF_DR + 64 * MiB;
constexpr size_t OFF_S5 = OFF_DR + 120 * MiB;
constexpr size_t OFF_VT = OFF_DR + 136 * MiB;
constexpr size_t OFF_HCAT = OFF_DR + 168 * MiB;
constexpr size_t OFF_REC = OFF_DR + 232 * MiB;
constexpr size_t OFF_QC = OFF_DR;
constexpr size_t OFF_OC = OFF_DR + 64 * MiB;
constexpr size_t OFF_AG = OFF_DR;
constexpr size_t OFF_AF = OFF_DR + 200 * MiB;
constexpr size_t OFF_GF = OFF_AF + 3 * MiB;
constexpr size_t OFF_AL = OFF_GF + 3 * MiB;

struct Params {
  const void* in[48];
  float* xs;
  char* ws;
  float lam_init[4];
  int pad[4];
};

typedef const char __attribute__((address_space(4)))* kaptr_t;
struct PRef {
  struct In { kaptr_t ka; DI const void* operator[](int i) const { return *(const void* const __attribute__((address_space(4)))*)(ka + i * 8); } } in;
  struct Xs { kaptr_t ka; DI operator float*() const { return *(float* const __attribute__((address_space(4)))*)(ka + 384); } } xs;
  struct Ws { kaptr_t ka; DI operator char*() const { return *(char* const __attribute__((address_space(4)))*)(ka + 392); } } ws;
  struct Lam { kaptr_t ka; DI float operator[](int i) const { return *(const float __attribute__((address_space(4)))*)(ka + 400 + i * 4); } } lam_init;
  DI explicit PRef(kaptr_t k) : in{k}, xs{k}, ws{k}, lam_init{k} {}
};
static_assert(offsetof(Params, xs) == 384 && offsetof(Params, ws) == 392 && offsetof(Params, lam_init) == 400, "layout");

DI int ltid() { int t = threadIdx.x; asm volatile("" : "+v"(t)); return t; }
typedef __bf16 bf16v2 __attribute__((ext_vector_type(2)));
typedef float f32v2 __attribute__((ext_vector_type(2)));
DI unsigned pack2(float a, float b) { f32v2 v = {a, b}; return __builtin_bit_cast(unsigned, __builtin_convertvector(v, bf16v2)); }
DI u16 f2bf(float x) { return (u16)(pack2(x, 0.f) & 0xffffu); }
DI float bf2f(u16 h) { return __uint_as_float(((unsigned)h) << 16); }
DI float sigmoidf_(float x) { return 1.f / (1.f + __expf(-x)); }
DI float wave_sum(float v) {
  for (int o = 32; o > 0; o >>= 1) v += __shfl_xor(v, o);
  return v;
}
template <int CTRL> DI float dpp_f(float x) {
  return __int_as_float(__builtin_amdgcn_mov_dpp(__float_as_int(x), CTRL, 0xF, 0xF, true));
}
DI float row16_sum(float x) {
  x += dpp_f<0xB1>(x);
  x += dpp_f<0x4E>(x);
  x += dpp_f<0x141>(x);
  x += dpp_f<0x140>(x);
  return x;
}

constexpr int BM = 256, BK = 64, HALF = 128, HT = HALF * BK;

DI int lds_byte(int r, int c) {
  int st = (r >> 4) * 2 + (c >> 5), rr = r & 15, cc = c & 31, ob = rr * 64 + cc * 2;
  return st * 1024 + (ob ^ (((ob >> 9) & 1) << 5));
}
DI void stage_rc(int b, int& R, int& C) {
  int st = b / 1024, sb = b % 1024, swz = sb ^ (((sb >> 9) & 1) << 5);
  R = (st >> 1) * 16 + swz / 64; C = (st & 1) * 32 + (swz % 64) / 2;
}

struct TileDesc { const u16* A; const u16* B; int brow, bcol, sub; };
DI void rope_epilogue(const PRef& p, const f32x4 (&acc)[2][2][4][2], int brow, int bcol, int wr, int wc, int fr, int fq);
template <class TileFn, class Epi>
DI void gemm_stream(int ntiles, int lda, int ldb, int K, TileFn tile_fn, Epi epi) {
  extern __shared__ __attribute__((aligned(16))) u16 shm[];
  if (ntiles <= 0) return;
#define SA(b, h) (shm + ((b) * 2 + (h)) * HT)
#define SB(b, h) (shm + (4 + (b) * 2 + (h)) * HT)
#define STAGE(P, PTR, V, S64, HH, KREL) do { \
    const char* _p = (PTR) + ((KREL) * 128 + (size_t)(2 * (HH)) * (S64)); asm volatile("" : "+s"(_p)); \
    __builtin_amdgcn_global_load_lds((const unsigned*)(_p + (size_t)(V)), (unsigned*)((char*)(P) + tid * 16), 16, 0, 0); \
    const char* _q = (PTR) + ((KREL) * 128 + (size_t)(2 * (HH) + 1) * (S64)); asm volatile("" : "+s"(_q)); \
    __builtin_amdgcn_global_load_lds((const unsigned*)(_q + (size_t)(V)), (unsigned*)((char*)(P) + tid * 16 + 8192), 16, 0, 0); } while (0)
#define LDA(dst, b, h) for (int m = 0; m < 4; ++m) for (int k = 0; k < 2; ++k) \
    dst[m][k] = *reinterpret_cast<const bf16x8*>((char*)SA(b, h) + lda_base + m * 2048 + k * 1024)
#define LDB(dst, b, h) for (int n = 0; n < 2; ++n) for (int k = 0; k < 2; ++k) \
    dst[n][k] = *reinterpret_cast<const bf16x8*>((char*)SB(b, h) + ldb_base + n * 256 + k * 1024)
#define MMA(ai, bj, At_, Bt_) do { __builtin_amdgcn_s_setprio(1); \
    for (int m = 0; m < 4; ++m) for (int n = 0; n < 2; ++n) for (int k = 0; k < 2; ++k) \
      acc[ai][bj][m][n] = __builtin_amdgcn_mfma_f32_16x16x32_bf16(Bt_[n][k], At_[m][k], acc[ai][bj][m][n], 0, 0, 0); \
    __builtin_amdgcn_s_setprio(0); } while (0)
#define WAIT_V(n) asm volatile("s_waitcnt vmcnt(" #n ")" ::: "memory")
#define WAIT_L(n) asm volatile("s_waitcnt lgkmcnt(" #n ")" ::: "memory")
#define BAR __builtin_amdgcn_s_barrier()
#define SCHED __builtin_amdgcn_sched_barrier(0)
#define SA0(P_, K) STAGE(SA(0, 0), P_, vA, sA64, 0, K)
#define SA0H(P_, K) STAGE(SA(0, 1), P_, vA, sA64, 1, K)
#define SA1(P_, K) STAGE(SA(1, 0), P_, vA, sA64, 0, K)
#define SA1H(P_, K) STAGE(SA(1, 1), P_, vA, sA64, 1, K)
#define SB0(P_, K) STAGE(SB(0, 0), P_, vB, sB64, 0, K)
#define SB0H(P_, K) STAGE(SB(0, 1), P_, vB, sB64, 1, K)
#define SB1(P_, K) STAGE(SB(1, 0), P_, vB, sB64, 0, K)
#define SB1H(P_, K) STAGE(SB(1, 1), P_, vB, sB64, 1, K)

  const int tid = ltid();
  const int wid = tid >> 6, lane = tid & 63, wr = wid >> 2, wc = wid & 3, fr = lane & 15, fq = lane >> 4;
  unsigned vA, vB;
  { int r0, c0; stage_rc(tid * 16, r0, c0); vA = (unsigned)(r0 * lda + c0) * 2u; vB = (unsigned)(r0 * ldb + c0) * 2u; }
  const unsigned sA64 = (unsigned)lda * 128u, sB64 = (unsigned)ldb * 128u;
  const int nt = K / BK;
  const int lda_base = lds_byte(wr * 64 + fr, fq * 8);
  const int ldb_base = lds_byte(wc * 32 + (fr >> 2) * 8 + (fr & 3), fq * 8);
  TileDesc cur = tile_fn(0);
  const char* pA = (const char*)(cur.A + (long)cur.brow * lda);
  const char* pB = (const char*)(cur.B + (long)cur.bcol * ldb);
  SB0(pB, 0); SA0(pA, 0); SB0H(pB, 0); SA0H(pA, 0);
  if (wr == 1) BAR;
  WAIT_V(4); BAR;
  SB1(pB, 1); SA1(pA, 1); SB1H(pB, 1);
  WAIT_V(6); BAR;
  for (int ti = 0; ti < ntiles; ++ti) {
    const TileDesc nxt = tile_fn(ti + 1 < ntiles ? ti + 1 : ti);
    const char* pAn = (const char*)(nxt.A + (long)nxt.brow * lda);
    const char* pBn = (const char*)(nxt.B + (long)nxt.bcol * ldb);
    f32x4 acc[2][2][4][2];
    for (int a = 0; a < 2; ++a) for (int b = 0; b < 2; ++b) for (int m = 0; m < 4; ++m) for (int n = 0; n < 2; ++n) acc[a][b][m][n] = f32x4{0.f, 0.f, 0.f, 0.f};
    bf16x8 At[4][2], B0[2][2], B1[2][2];
    for (int t = 0; t < nt; t += 2) {
      const bool last = (t == nt - 2);
      const char* pA2 = last ? pAn - 256 : pA;
      const char* pB2 = last ? pBn - 256 : pB;
      LDB(B0, 0, 0); SCHED; LDA(At, 0, 0); SA1H(pA, 1);
      WAIT_L(8); BAR; WAIT_L(0); MMA(0, 0, At, B0); BAR; SCHED;
      LDB(B1, 0, 1); SB0(pB2, 2);
      BAR; WAIT_L(0); MMA(0, 1, At, B1); BAR;
      LDA(At, 0, 1); SA0(pA2, 2);
      BAR; WAIT_L(0); MMA(1, 0, At, B0); BAR; SCHED;
      SB0H(pB2, 2);
      WAIT_V(6); BAR; MMA(1, 1, At, B1); BAR;
      LDB(B0, 1, 0); SCHED; LDA(At, 1, 0); SA0H(pA2, 2);
      WAIT_L(8); BAR; WAIT_L(0); MMA(0, 0, At, B0); BAR; SCHED;
      LDB(B1, 1, 1); SB1(pB2, 3);
      BAR; WAIT_L(0); MMA(0, 1, At, B1); BAR;
      LDA(At, 1, 1); SA1(pA2, 3);
      BAR; WAIT_L(0); MMA(1, 0, At, B0); BAR; SCHED;
      SB1H(pB2, 3);
      WAIT_V(6); BAR; MMA(1, 1, At, B1); BAR;
      pA += 256; pB += 256;
    }
    if (wr == 0) BAR;
    if (epi.kind == 0 && cur.sub == 0 && cur.bcol < 1024) {
      const PRef pe(epi.ka);
      rope_epilogue(pe, acc, cur.brow, cur.bcol, wr, wc, fr, fq);
    } else if (epi.kind == 10) {
      const PRef pe(epi.ka);
      up_epilogue(pe, epi.lay, acc, cur.brow, cur.bcol, wr, wc, fr, fq, reinterpret_cast<float*>(reinterpret_cast<char*>(shm) + 131072));
    } else {
#pragma unroll
      for (int ai = 0; ai < 2; ++ai)
#pragma unroll
        for (int bj = 0; bj < 2; ++bj)
#pragma unroll
          for (int m = 0; m < 4; ++m)
            epi(cur.sub, cur.brow + ai * HALF + wr * 64 + m * 16 + fr, cur.bcol + bj * HALF + wc * 32 + fq * 8, acc[ai][bj][m][0], acc[ai][bj][m][1]);
    }
    WAIT_V(0);
    cur = nxt; pA = pAn; pB = pBn;
    if (wr == 1 && ti + 1 < ntiles) BAR;
  }
  __syncthreads();
#undef SA
#undef SB
}

template <int CTRL> DI float dppz(float x) {
  return __int_as_float(__builtin_amdgcn_update_dpp(0, __float_as_int(x), CTRL, 0xF, 0xF, true));
}
DI void up_epilogue(const PRef& p, int l, const f32x4 (&acc)[2][2][4][2], int brow, int bcol, int wr, int wc, int fr, int fq, float* exch) {
  char* ws = p.ws;
  u16* hmid = (u16*)(ws + OFF_AG);
  const int pm = brow >> 8, pn = bcol >> 8;
  const int tc0 = wc * 32 + fq * 8;
  const int cw0 = pn * 128 + tc0;
  const float* cwp = (const float*)p.in[I_CONVW] + (size_t)l * 3 * DFF;
  const float* cbp = (const float*)p.in[I_CONVB] + (size_t)l * DFF;
#pragma unroll
  for (int ai = 0; ai < 2; ++ai)
#pragma unroll
    for (int n = 0; n < 2; ++n) {
      if (fr >= 14) {
        const f32x4 v = acc[ai][0][3][n];
        *reinterpret_cast<float4*>(exch + (((ai * 2 + wr) * 2 + (fr - 14)) * 128 + tc0 + n * 4)) = make_float4(v[0], v[1], v[2], v[3]);
        if (ai == 1 && wr == 1)
          *reinterpret_cast<float4*>((float*)(ws + OFF_AL) + ((size_t)(pm * 2 + (fr - 14)) * DFF + cw0 + n * 4)) = make_float4(v[0], v[1], v[2], v[3]);
      }
      if (ai == 0 && wr == 0 && fr < 2) {
        const f32x4 va = acc[0][0][0][n], vg = acc[0][1][0][n];
        *reinterpret_cast<float4*>((float*)(ws + OFF_AF) + ((size_t)(pm * 2 + fr) * DFF + cw0 + n * 4)) = make_float4(va[0], va[1], va[2], va[3]);
        *reinterpret_cast<float4*>((float*)(ws + OFF_GF) + ((size_t)(pm * 2 + fr) * DFF + cw0 + n * 4)) = make_float4(vg[0], vg[1], vg[2], vg[3]);
      }
    }
  __syncthreads();
#pragma unroll
  for (int ai = 0; ai < 2; ++ai) {
    const int sp = ai * 2 + wr;
#pragma unroll
    for (int m = 0; m < 4; ++m) {
      float o[8];
#pragma unroll
      for (int n = 0; n < 2; ++n) {
        const int c = cw0 + n * 4;
        const float4 w0 = *reinterpret_cast<const float4*>(cwp + c), w1 = *reinterpret_cast<const float4*>(cwp + DFF + c);
        const float4 w2 = *reinterpret_cast<const float4*>(cwp + 2 * DFF + c), bs = *reinterpret_cast<const float4*>(cbp + c);
        const float w0a[4] = {w0.x, w0.y, w0.z, w0.w}, w1a[4] = {w1.x, w1.y, w1.z, w1.w}, w2a[4] = {w2.x, w2.y, w2.z, w2.w}, bsa[4] = {bs.x, bs.y, bs.z, bs.w};
        float p62a[4] = {0.f, 0.f, 0.f, 0.f}, p63a[4] = {0.f, 0.f, 0.f, 0.f};
        if (m == 0 && sp > 0) {
          const float4 p62 = *reinterpret_cast<const float4*>(exch + (((sp - 1) * 2 + 0) * 128 + tc0 + n * 4));
          const float4 p63 = *reinterpret_cast<const float4*>(exch + (((sp - 1) * 2 + 1) * 128 + tc0 + n * 4));
          p62a[0] = p62.x; p62a[1] = p62.y; p62a[2] = p62.z; p62a[3] = p62.w;
          p63a[0] = p63.x; p63a[1] = p63.y; p63a[2] = p63.z; p63a[3] = p63.w;
        }
#pragma unroll
        for (int j = 0; j < 4; ++j) {
          const float a = acc[ai][0][m][n][j], g = acc[ai][1][m][n][j];
          float pr1 = dppz<0x111>(a), pr2 = dppz<0x112>(a);
          if (m == 0) {
            if (fr == 0) { pr1 = p63a[j]; pr2 = p62a[j]; }
            if (fr == 1) { pr2 = p63a[j]; }
          } else {
            const float am = acc[ai][0][m > 0 ? m - 1 : 0][n][j];
            const float mir = dppz<0x140>(am);
            const float swp = dppz<0xB1>(mir);
            if (fr == 0) { pr1 = mir; }
            if (fr < 2) { pr2 = swp; }
          }
          const float cv = bsa[j] + w0a[j] * pr2 + w1a[j] * pr1 + w2a[j] * a;
          o[n * 4 + j] = cv * sigmoidf_(cv) * g;
        }
      }
      uint4 ov; ov.x = pack2(o[0], o[1]); ov.y = pack2(o[2], o[3]); ov.z = pack2(o[4], o[5]); ov.w = pack2(o[6], o[7]);
      *reinterpret_cast<uint4*>(hmid + (size_t)(brow + ai * HALF + wr * 64 + m * 16 + fr) * DFF + cw0) = ov;
    }
  }
  __syncthreads();
}

DI void rope_epilogue(const PRef& p, const f32x4 (&acc)[2][2][4][2], int brow, int bcol, int wr, int wc, int fr, int fq) {
  char* ws = p.ws;
  u16* qk = (u16*)(ws + OFF_QK);
  const float* rc = (const float*)(ws + OFF_ROPE); const float* rs = rc + (size_t)NTOK * 32;
  const int d0 = (wc & 1) * 16 + fq * 4;
#pragma unroll
  for (int ai = 0; ai < 2; ++ai)
#pragma unroll
    for (int m = 0; m < 4; ++m) {
      const int tok = brow + ai * HALF + wr * 64 + m * 16 + fr;
      const float4 c4 = *reinterpret_cast<const float4*>(rc + (size_t)tok * 32 + d0);
      const float4 s4 = *reinterpret_cast<const float4*>(rs + (size_t)tok * 32 + d0);
      const float ca[4] = {c4.x, c4.y, c4.z, c4.w}, sa[4] = {s4.x, s4.y, s4.z, s4.w};
#pragma unroll
      for (int bj = 0; bj < 2; ++bj) {
        const int hh = (bcol >> 6) + bj * 2 + (wc >> 1);
        const float sc = (hh < 8) ? 0.125f * LOG2E : 1.f;
        float o0[4], o1[4];
#pragma unroll
        for (int j = 0; j < 4; ++j) {
          const float t0 = acc[ai][bj][m][0][j], t1 = acc[ai][bj][m][1][j];
          o0[j] = (t0 * ca[j] - t1 * sa[j]) * sc;
          o1[j] = (t1 * ca[j] + t0 * sa[j]) * sc;
        }
        uint4 v; v.x = pack2(o0[0], o0[1]); v.y = pack2(o0[2], o0[3]); v.z = pack2(o1[0], o1[1]); v.w = pack2(o1[2], o1[3]);
        *reinterpret_cast<uint4*>(qk + (size_t)tok * 1024 + bcol + bj * HALF + wc * 32 + fq * 8) = v;
      }
    }
}

struct EpiGen {
  int kind, lay; kaptr_t ka;
  DI void operator()(int sub, int row, int col, f32x4 v, f32x4 w) const {
    const PRef p(ka);
    if (kind == 4 || kind == 8 || kind == 12) {
      float* X = p.xs;
      float4* q = reinterpret_cast<float4*>(X + (size_t)row * DM + col);
      const float4* qi = (kind == 4 && lay == 0) ? reinterpret_cast<const float4*>((const float*)p.in[I_X] + (size_t)row * DM + col) : q;
      float4 x = qi[0], y = qi[1];
      x.x = ALPHA * x.x + v[0]; x.y = ALPHA * x.y + v[1]; x.z = ALPHA * x.z + v[2]; x.w = ALPHA * x.w + v[3];
      y.x = ALPHA * y.x + w[0]; y.y = ALPHA * y.y + w[1]; y.z = ALPHA * y.z + w[2]; y.w = ALPHA * y.w + w[3];
      q[0] = x; q[1] = y;
      return;
    }
    char* ws = p.ws;
    const float scale = (kind == 6) ? 0.0625f * LOG2E : 1.f;
    uint4 o; o.x = pack2(v[0] * scale, v[1] * scale); o.y = pack2(v[2] * scale, v[3] * scale);
    o.z = pack2(w[0] * scale, w[1] * scale); o.w = pack2(w[2] * scale, w[3] * scale);
    u16* dst;
    if (kind == 6) dst = (u16*)(ws + OFF_QC) + (size_t)row * 1024 + col;
    else if (sub == 1) dst = (u16*)(ws + OFF_VT) + (size_t)row * NTOK + col;
    else if (sub == 2) dst = (u16*)(ws + OFF_KMEM) + (size_t)row * 1024 + col;
    else if (sub == 3) dst = (u16*)(ws + OFF_VMEMT) + (size_t)row * 2048 + col;
    else if (col < 1024) dst = (u16*)(ws + OFF_QK) + (size_t)row * 1024 + col;
    else if (col < 2432) dst = (u16*)(ws + OFF_RW) + (size_t)row * 896 + (col - 1536);
    else if (col < 2688) dst = (u16*)(ws + OFF_S5) + (size_t)row * 256 + (col - 2432);
    else return;
    *reinterpret_cast<uint4*>(dst) = o;
  }
};

DI void transpose_tiles(const float* __restrict__ src, int K, int N, int Npad, u16* __restrict__ dst, int& tbase, int tile_begin, int tile_stride, bool upmap = false, int rope_rows = 0) {
  extern __shared__ __attribute__((aligned(16))) u16 shm[];
  float* tile = reinterpret_cast<float*>(shm);
  const int nkt = K / 64, nnt = Npad / 64, total = nkt * nnt;
  int first = tile_begin;
  if (first < tbase) { int d = tbase - first; first += ((d + tile_stride - 1) / tile_stride) * tile_stride; }
  for (int g = first; g < tbase + total; g += tile_stride) {
    int t = g - tbase; int kt = t % nkt, ntile = t / nkt; int k0 = kt * 64, n0 = ntile * 64;
    __syncthreads();
    const int tid = ltid();
#pragma unroll
    for (int r = 0; r < 2; ++r) {
      const int e = tid + r * 512, i = e >> 4, j4 = (e & 15) * 4;
      float4 v = make_float4(0.f, 0.f, 0.f, 0.f);
      const int sn0 = upmap ? ((n0 & 255) >> 7) * DFF + (n0 >> 8) * 128 + (n0 & 127) : n0;
      if (n0 + j4 < N) v = *reinterpret_cast<const float4*>(src + (size_t)(k0 + i) * N + sn0 + j4);
      tile[i * 65 + j4] = v.x; tile[i * 65 + j4 + 1] = v.y; tile[i * 65 + j4 + 2] = v.z; tile[i * 65 + j4 + 3] = v.w;
    }
    __syncthreads();
    {
      const int jn = tid >> 3, seg = tid & 7;
      const float* tp = tile + (seg * 8) * 65 + jn;
      uint4 o;
      o.x = pack2(tp[0], tp[65]); o.y = pack2(tp[2 * 65], tp[3 * 65]); o.z = pack2(tp[4 * 65], tp[5 * 65]); o.w = pack2(tp[6 * 65], tp[7 * 65]);
      const int jd = (n0 < rope_rows) ? (((jn >> 4) & 1) * 32 + ((jn & 15) >> 2) * 8 + (jn >> 5) * 4 + (jn & 3)) : jn;
      *reinterpret_cast<uint4*>(dst + (size_t)(n0 + jd) * K + k0 + seg * 8) = o;
    }
  }
  tbase += total;
}

DI void phase_transposes(const PRef& p, int l) {
  char* wt = p.ws + OFF_WT;
  int tbase = 0; const int tb = blockIdx.x, ts = gridDim.x;
  transpose_tiles((const float*)p.in[I_WIN] + (size_t)l * 1024 * INW, 1024, INW, 2816, (u16*)(wt + WT_IN), tbase, tb, ts, false, 1024);
  transpose_tiles((const float*)p.in[I_WOUT] + (size_t)l * 1024 * 1024, 1024, 1024, 1024, (u16*)(wt + WT_OUT), tbase, tb, ts);
  transpose_tiles((const float*)p.in[I_WQ] + (size_t)l * 1024 * 1024, 1024, 1024, 1024, (u16*)(wt + WT_Q), tbase, tb, ts);
  transpose_tiles((const float*)p.in[I_WKV] + (size_t)l * 1024 * 2048, 1024, 2048, 2048, (u16*)(wt + WT_KV), tbase, tb, ts);
  transpose_tiles((const float*)p.in[I_WO] + (size_t)l * 1024 * 1024, 1024, 1024, 1024, (u16*)(wt + WT_O), tbase, tb, ts);
  transpose_tiles((const float*)p.in[I_WUP] + (size_t)l * 1024 * 5632, 1024, 5632, 5632, (u16*)(wt + WT_UP), tbase, tb, ts, true);
  transpose_tiles((const float*)p.in[I_WDOWN] + (size_t)l * 2816 * 1024, 2816, 1024, 1024, (u16*)(wt + WT_DOWN), tbase, tb, ts);
  transpose_tiles((const float*)p.in[I_GLUW] + (size_t)l * 256 * 256, 256, 256, 256, (u16*)(wt + WT_GLU), tbase, tb, ts);
  __syncthreads();
  {
    const float* w2 = (const float*)p.in[I_W2] + l * 32 * 256;
    const float* a2 = (const float*)p.in[I_A2] + l * 32 * 256;
    const float* g2 = (const float*)p.in[I_G2] + l * 64 * 256;
    u16* w2t = (u16*)(wt + WT_W2T); u16* a2t = (u16*)(wt + WT_A2T); u16* g2t = (u16*)(wt + WT_G2T);
    for (int e = blockIdx.x * 512 + ltid(); e < 256 * 128; e += gridDim.x * 512) {
      const int n = e & 255, kk = e >> 8;
      if (kk < 32) w2t[n * 32 + kk] = f2bf(w2[kk * 256 + n]);
      else if (kk < 64) a2t[n * 32 + (kk - 32)] = f2bf(a2[(kk - 32) * 256 + n]);
      else g2t[n * 64 + (kk - 64)] = f2bf(g2[(kk - 64) * 256 + n]);
    }
  }
}

DI void phase_init(const PRef& p) {
  const size_t gtid = (size_t)blockIdx.x * 512 + ltid(), gsz = (size_t)gridDim.x * 512;
  const float4* x4 = (const float4*)p.in[I_X];
  uint2* xb2 = (uint2*)(p.ws + OFF_XB);
  for (size_t i = gtid; i < (size_t)NTOK * DM / 4; i += gsz) {
    float4 v = x4[i];
    uint2 o; o.x = pack2(v.x, v.y); o.y = pack2(v.z, v.w); xb2[i] = o;
  }
  const float4* m4 = (const float4*)p.in[I_MEM];
  uint2* mb2 = (uint2*)(p.ws + OFF_MEMB);
  for (size_t i = gtid; i < (size_t)2048 * 1024 / 4; i += gsz) {
    float4 v = m4[i]; uint2 o; o.x = pack2(v.x, v.y); o.y = pack2(v.z, v.w); mb2[i] = o;
  }
  const int* pos = (const int*)p.in[I_POS];
  float* rc = (float*)(p.ws + OFF_ROPE); float* rs = rc + (size_t)NTOK * 32;
  for (size_t i = gtid; i < (size_t)NTOK * 32; i += gsz) {
    int tok = (int)(i >> 5), d = (int)(i & 31);
    float invf = exp2f(-(float)d * (13.287712379549449f / 32.f));
    float angf = (float)pos[tok] * invf;
    double rev = (double)angf * 0.15915494309189535;
    float xr = (float)((rev - rint(rev)) * 6.283185307179586);
    float sv = __sinf(xr), cv = __cosf(xr);
    rc[i] = cv; rs[i] = sv;
  }
  if (blockIdx.x == 0 && ltid() < 64) ((unsigned*)(p.ws + OFF_CNT))[ltid()] = 0u;
}

DI void phase_prep(const PRef& p, int l) {
  extern __shared__ __attribute__((aligned(16))) u16 shm[];
  float* act = reinterpret_cast<float*>(shm);
  u16* qk = (u16*)(p.ws + OFF_QK);
  const u16* rw = (const u16*)(p.ws + OFF_RW);
  const float* rc = (const float*)(p.ws + OFF_ROPE); const float* rs = rc + (size_t)NTOK * 32;
  const float* mu = (const float*)p.in[I_MU] + l * 896;
  const float* w0 = (const float*)p.in[I_W0] + l * 256;
  const float* w2 = (const float*)p.in[I_W2] + l * 32 * 256;
  const float* a0 = (const float*)p.in[I_A0] + l * 256;
  const float* a2 = (const float*)p.in[I_A2] + l * 32 * 256;
  const float* g2 = (const float*)p.in[I_G2] + l * 64 * 256;
  const float* k_k = (const float*)p.in[I_KK] + l * 256;
  const float* k_a = (const float*)p.in[I_KA] + l * 256;
  const float* r_k = (const float*)p.in[I_RK] + l * 256;
  char* rec = p.ws + OFF_REC;
  u16* gbuf = (u16*)(p.ws + OFF_G);
  float* bonus = (float*)(p.ws + OFF_BONUS);
  const int tid = ltid();
  for (int item = blockIdx.x; item < NTOK / 32; item += gridDim.x) {
    const int tk0 = item * 32;
    __syncthreads();
    for (int idx = tid; idx < 32 * 128; idx += 512) {
      const int i = idx >> 7, j = idx & 127, tok = tk0 + i, col = 768 + j;
      float pv = bf2f(rw[(size_t)tok * 896 + col]);
      float pp = ((tok & (SEQ - 1)) != 0) ? bf2f(rw[(size_t)(tok - 1) * 896 + col]) : 0.f;
      float ps = pv + (pp - pv) * mu[col];
      float a = (j < 32) ? tanhf(ps) : (j < 64) ? ps : sigmoidf_(ps);
      act[i * 128 + j] = a;
    }
    __syncthreads();
    const int c = tid & 255, half = tid >> 8, h = c >> 6;
    {
      float* lora = act + 32 * 128;
      const int w8 = tid >> 6, ln = tid & 63, fr = ln & 15, fq = ln >> 4;
      const u16* w2t = (const u16*)(p.ws + OFF_WT + WT_W2T);
      const u16* a2t = (const u16*)(p.ws + OFF_WT + WT_A2T);
      const u16* g2t = (const u16*)(p.ws + OFF_WT + WT_G2T);
#pragma unroll
      for (int nbi = 0; nbi < 2; ++nbi) {
        const int col0 = (w8 * 2 + nbi) * 16;
        const bf16x8 bw = *reinterpret_cast<const bf16x8*>(w2t + (size_t)(col0 + fr) * 32 + fq * 8);
        const bf16x8 ba = *reinterpret_cast<const bf16x8*>(a2t + (size_t)(col0 + fr) * 32 + fq * 8);
        const bf16x8 bg0 = *reinterpret_cast<const bf16x8*>(g2t + (size_t)(col0 + fr) * 64 + fq * 8);
        const bf16x8 bg1 = *reinterpret_cast<const bf16x8*>(g2t + (size_t)(col0 + fr) * 64 + 32 + fq * 8);
#pragma unroll
        for (int mb = 0; mb < 2; ++mb) {
          const float* ap = act + (mb * 16 + fr) * 128 + fq * 8;
          bf16x8 af[4];
#pragma unroll
          for (int ks = 0; ks < 4; ++ks) {
            const float4 f0 = *reinterpret_cast<const float4*>(ap + ks * 32), f1 = *reinterpret_cast<const float4*>(ap + ks * 32 + 4);
            af[ks] = __builtin_bit_cast(bf16x8, (u32x4{pack2(f0.x, f0.y), pack2(f0.z, f0.w), pack2(f1.x, f1.y), pack2(f1.z, f1.w)}));
          }
          const f32x4 z4 = f32x4{0.f, 0.f, 0.f, 0.f};
          f32x4 dw = __builtin_amdgcn_mfma_f32_16x16x32_bf16(bw, af[0], z4, 0, 0, 0);
          f32x4 da = __builtin_amdgcn_mfma_f32_16x16x32_bf16(ba, af[1], z4, 0, 0, 0);
          f32x4 dg = __builtin_amdgcn_mfma_f32_16x16x32_bf16(bg0, af[2], z4, 0, 0, 0);
          dg = __builtin_amdgcn_mfma_f32_16x16x32_bf16(bg1, af[3], dg, 0, 0, 0);
          float* lp = lora + (mb * 16 + fr) * 256 + col0 + fq * 4;
          *reinterpret_cast<float4*>(lp) = make_float4(dw[0], dw[1], dw[2], dw[3]);
          *reinterpret_cast<float4*>(lp + 32 * 256) = make_float4(da[0], da[1], da[2], da[3]);
          *reinterpret_cast<float4*>(lp + 2 * 32 * 256) = make_float4(dg[0], dg[1], dg[2], dg[3]);
        }
      }
    }
    __syncthreads();
    float accw[16], acca[16], accg[16];
#pragma unroll
    for (int i = 0; i < 16; ++i) {
      const float* lp = act + 32 * 128 + (half * 16 + i) * 256 + c;
      accw[i] = lp[0]; acca[i] = lp[32 * 256]; accg[i] = lp[2 * 32 * 256];
    }
    const float mur = mu[c], muk = mu[256 + c], muv = mu[512 + c];
    const float w0c = w0[c], a0c = a0[c], kkc = k_k[c], kac = k_a[c], rkc = r_k[c];
#pragma unroll
    for (int i = 0; i < 16; ++i) {
      const int tok = tk0 + half * 16 + i;
      const bool has_prev = (tok & (SEQ - 1)) != 0;
      const u16* pr_ = rw + (size_t)tok * 896;
      float r0 = bf2f(pr_[c]), k0 = bf2f(pr_[256 + c]), v0 = bf2f(pr_[512 + c]);
      float r1 = 0.f, k1 = 0.f, v1 = 0.f;
      if (has_prev) { r1 = bf2f(pr_[c - 896]); k1 = bf2f(pr_[256 + c - 896]); v1 = bf2f(pr_[512 + c - 896]); }
      float r = r0 + (r1 - r0) * mur, k = k0 + (k1 - k0) * muk, v = v0 + (v1 - v0) * muv;
      float w = __expf(-0.6065306597126334f * sigmoidf_(w0c + accw[i]));
      float a = sigmoidf_(a0c + acca[i]);
      float kk = k * kkc;
      float ss = wave_sum(kk * kk);
      kk *= rsqrtf(fmaxf(ss, 1e-24f));
      float kp = k * (1.f + (a - 1.f) * kac);
      float bb = kk * a;
      float bo = wave_sum(r * kp * rkc);
      const int b = tok >> 12, t = tok & (SEQ - 1);
      char* rp = rec + ((size_t)((b * 4 + h) * SEQ + t)) * 1152;
      const int cc = c & 63;
      reinterpret_cast<float*>(rp)[cc] = w;
      reinterpret_cast<float*>(rp + 256)[cc] = kk;
      reinterpret_cast<float*>(rp + 512)[cc] = bb;
      reinterpret_cast<u16*>(rp + 768)[cc] = f2bf(kp);
      reinterpret_cast<u16*>(rp + 896)[cc] = f2bf(r);
      reinterpret_cast<u16*>(rp + 1024)[cc] = f2bf(v);
      gbuf[(size_t)tok * 256 + c] = f2bf(accg[i]);
      if (cc == 0) bonus[(size_t)tok * 4 + h] = bo;
    }
    __syncthreads();
  }
}

template <int DK, int DV, int NQB>
struct FlashWave {
  bf16x8 qf[NQB][DK / 32];
  f32x4 o[NQB][DV / 16];
  float m[NQB], l[NQB];
  DI void init() {
#pragma unroll
    for (int qb = 0; qb < NQB; ++qb) { m[qb] = -INFINITY; l[qb] = 0.f;
#pragma unroll
      for (int d = 0; d < DV / 16; ++d) o[qb][d] = f32x4{0.f, 0.f, 0.f, 0.f}; }
  }
  DI void tile(const u16* Ks, const u16* Vts) {
    constexpr int KSTR = DK + 8, VSTR = 72;
    const int lane = ltid() & 63, fr = lane & 15, fq = lane >> 4;
    float base[NQB];
#pragma unroll
    for (int qb = 0; qb < NQB; ++qb) base[qb] = (m[qb] == -INFINITY) ? 0.f : m[qb];
    f32x4 s[4][NQB];
    __builtin_amdgcn_s_setprio(1);
#pragma unroll
    for (int kb = 0; kb < 4; ++kb) {
#pragma unroll
      for (int qb = 0; qb < NQB; ++qb) s[kb][qb] = f32x4{-base[qb], -base[qb], -base[qb], -base[qb]};
#pragma unroll
      for (int ks = 0; ks < DK / 32; ++ks) {
        bf16x8 kf = *reinterpret_cast<const bf16x8*>(Ks + (kb * 16 + fr) * KSTR + ks * 32 + fq * 8);
#pragma unroll
        for (int qb = 0; qb < NQB; ++qb) s[kb][qb] = __builtin_amdgcn_mfma_f32_16x16x32_bf16(kf, qf[qb][ks], s[kb][qb], 0, 0, 0);
      }
    }
    __builtin_amdgcn_s_setprio(0);
    bf16x8 pf[NQB][2];
#pragma unroll
    for (int qb = 0; qb < NQB; ++qb) {
      float mx = -INFINITY;
#pragma unroll
      for (int kb = 0; kb < 4; ++kb) {
#pragma unroll
        for (int j = 0; j < 4; ++j) mx = fmaxf(mx, s[kb][qb][j]); }
      mx = fmaxf(mx, __shfl_xor(mx, 16));
      mx = fmaxf(mx, __shfl_xor(mx, 32));
      const float mn = fmaxf(m[qb], base[qb] + mx);
      const bool changed = __any(mn > m[qb]);
      float sum = 0.f;
      if (changed) {
        const float delta = mn - base[qb];
        const float alpha = __builtin_amdgcn_exp2f(m[qb] - mn);
#pragma unroll
        for (int kb = 0; kb < 4; ++kb) {
#pragma unroll
          for (int j = 0; j < 4; ++j) { float e = __builtin_amdgcn_exp2f(s[kb][qb][j] - delta); s[kb][qb][j] = e; sum += e; } }
        l[qb] = l[qb] * alpha + sum;
#pragma unroll
        for (int d = 0; d < DV / 16; ++d) { o[qb][d][0] *= alpha; o[qb][d][1] *= alpha; o[qb][d][2] *= alpha; o[qb][d][3] *= alpha; }
      } else {
#pragma unroll
        for (int kb = 0; kb < 4; ++kb) {
#pragma unroll
          for (int j = 0; j < 4; ++j) { float e = __builtin_amdgcn_exp2f(s[kb][qb][j]); s[kb][qb][j] = e; sum += e; } }
        l[qb] += sum;
      }
      m[qb] = mn;
#pragma unroll
      for (int k2 = 0; k2 < 2; ++k2) {
        u32x4 pk;
        pk[0] = pack2(s[2 * k2][qb][0], s[2 * k2][qb][1]); pk[1] = pack2(s[2 * k2][qb][2], s[2 * k2][qb][3]);
        pk[2] = pack2(s[2 * k2 + 1][qb][0], s[2 * k2 + 1][qb][1]); pk[3] = pack2(s[2 * k2 + 1][qb][2], s[2 * k2 + 1][qb][3]);
        pf[qb][k2] = __builtin_bit_cast(bf16x8, pk);
      }
    }
    __builtin_amdgcn_s_setprio(1);
#pragma unroll
    for (int k2 = 0; k2 < 2; ++k2) {
#pragma unroll
      for (int d = 0; d < DV / 16; ++d) {
        const u16* vp = Vts + (d * 16 + fr) * VSTR + k2 * 32 + fq * 4;
        const uint2 h0 = *reinterpret_cast<const uint2*>(vp);
        const uint2 h1 = *reinterpret_cast<const uint2*>(vp + 16);
        const bf16x8 vfv = __builtin_bit_cast(bf16x8, (u32x4{h0.x, h0.y, h1.x, h1.y}));
#pragma unroll
        for (int qb = 0; qb < NQB; ++qb) o[qb][d] = __builtin_amdgcn_mfma_f32_16x16x32_bf16(vfv, pf[qb][k2], o[qb][d], 0, 0, 0);
      }
    }
    __builtin_amdgcn_s_setprio(0);
  }
  DI float lsum(int qb) { float t = l[qb]; t += __shfl_xor(t, 16); t += __shfl_xor(t, 32); return t; }
};

DI void diff_attn_item(const PRef& p, int l, int b, int h, int qt) {
  extern __shared__ __attribute__((aligned(16))) u16 shm[];
  u16* Ks = shm;
  u16* Vts = shm + 2 * 64 * 72;
  float* comb = reinterpret_cast<float*>(shm + 2 * 64 * 72 + 128 * 72);
  const u16* qk = (const u16*)(p.ws + OFF_QK);
  const u16* vt = (const u16*)(p.ws + OFF_VT);
  u16* hcat = (u16*)(p.ws + OFF_HCAT);
  const int tid = ltid(), w = tid >> 6, lane = tid & 63, fr = lane & 15, fq = lane >> 4;
  const int n = w >> 2, qsub = w & 3;
  const int tok0 = b * SEQ + qt * 128;
  float lam;
  {
    float a1 = ((const float*)p.in[I_LQ1])[l * 64 + lane] * ((const float*)p.in[I_LK1])[l * 64 + lane];
    float a2 = ((const float*)p.in[I_LQ2])[l * 64 + lane] * ((const float*)p.in[I_LK2])[l * 64 + lane];
    a1 = wave_sum(a1); a2 = wave_sum(a2);
    lam = __expf(a1) - __expf(a2) + p.lam_init[l];
  }
  FlashWave<64, 128, 2> fw;
  fw.init();
#pragma unroll
  for (int qb = 0; qb < 2; ++qb)
#pragma unroll
    for (int ks = 0; ks < 2; ++ks)
    fw.qf[qb][ks] = *reinterpret_cast<const bf16x8*>(qk + (size_t)(tok0 + qsub * 32 + qb * 16 + fr) * 1024 + h * 128 + n * 64 + ks * 32 + fq * 8);
  const int nkt = 2 * qt + 2;
  const int my_last = 2 * qt + (qsub >> 1);
  uint4 kreg0, kreg1, vreg0, vreg1;
  const int seg0 = tid, seg1 = tid + 512;
  const u16* kbase0 = qk + (size_t)(b * SEQ + ((seg0 >> 3) & 63)) * 1024 + 512 + h * 128 + (seg0 >> 9) * 64 + (seg0 & 7) * 8;
  const u16* kbase1 = qk + (size_t)(b * SEQ + ((seg1 >> 3) & 63)) * 1024 + 512 + h * 128 + (seg1 >> 9) * 64 + (seg1 & 7) * 8;
  const u16* vbase0 = vt + (size_t)(h * 128 + (seg0 >> 3)) * NTOK + b * SEQ + (seg0 & 7) * 8;
  const u16* vbase1 = vt + (size_t)(h * 128 + (seg1 >> 3)) * NTOK + b * SEQ + (seg1 & 7) * 8;
  u16* kdst0 = Ks + ((seg0 >> 9) * 64 + ((seg0 >> 3) & 63)) * 72 + (seg0 & 7) * 8;
  u16* kdst1 = Ks + ((seg1 >> 9) * 64 + ((seg1 >> 3) & 63)) * 72 + (seg1 & 7) * 8;
  u16* vdst0 = Vts + (seg0 >> 3) * 72 + (seg0 & 7) * 8;
  u16* vdst1 = Vts + (seg1 >> 3) * 72 + (seg1 & 7) * 8;
#define load_tile(kt) do { \
    kreg0 = *reinterpret_cast<const uint4*>(kbase0 + (size_t)(kt) * 64 * 1024); \
    kreg1 = *reinterpret_cast<const uint4*>(kbase1 + (size_t)(kt) * 64 * 1024); \
    vreg0 = *reinterpret_cast<const uint4*>(vbase0 + (kt) * 64); \
    vreg1 = *reinterpret_cast<const uint4*>(vbase1 + (kt) * 64); } while (0)
#define store_tile() do { \
    *reinterpret_cast<uint4*>(kdst0) = kreg0; *reinterpret_cast<uint4*>(kdst1) = kreg1; \
    *reinterpret_cast<uint4*>(vdst0) = vreg0; *reinterpret_cast<uint4*>(vdst1) = vreg1; } while (0)
  load_tile(0);
  for (int kt = 0; kt < nkt; ++kt) {
    __syncthreads();
    store_tile();
    __syncthreads();
    if (kt + 1 < nkt) load_tile(kt + 1);
    if (kt <= my_last) fw.tile(Ks + n * 64 * 72, Vts);
  }
  float inv[2];
#pragma unroll
  for (int qb = 0; qb < 2; ++qb) inv[qb] = 1.f / fw.lsum(qb);
  __syncthreads();
  if (n == 1) {
#pragma unroll
    for (int qb = 0; qb < 2; ++qb)
#pragma unroll
      for (int d = 0; d < 8; ++d) {
      float4 v; v.x = fw.o[qb][d][0] * inv[qb]; v.y = fw.o[qb][d][1] * inv[qb]; v.z = fw.o[qb][d][2] * inv[qb]; v.w = fw.o[qb][d][3] * inv[qb];
      *reinterpret_cast<float4*>(&comb[(qsub * 32 + qb * 16 + fr) * 132 + d * 16 + fq * 4]) = v;
    }
  }
  __syncthreads();
  if (n == 0) {
    const float* sg = (const float*)p.in[I_SUBLN] + l * 128;
    const float post = 1.f - p.lam_init[l];
#pragma unroll
    for (int qb = 0; qb < 2; ++qb) {
      float ss = 0.f;
#pragma unroll
      for (int d = 0; d < 8; ++d) {
        float4 c2 = *reinterpret_cast<const float4*>(&comb[(qsub * 32 + qb * 16 + fr) * 132 + d * 16 + fq * 4]);
        fw.o[qb][d][0] = fw.o[qb][d][0] * inv[qb] - lam * c2.x;
        fw.o[qb][d][1] = fw.o[qb][d][1] * inv[qb] - lam * c2.y;
        fw.o[qb][d][2] = fw.o[qb][d][2] * inv[qb] - lam * c2.z;
        fw.o[qb][d][3] = fw.o[qb][d][3] * inv[qb] - lam * c2.w;
        for (int j = 0; j < 4; ++j) ss += fw.o[qb][d][j] * fw.o[qb][d][j];
      }
      ss += __shfl_xor(ss, 16); ss += __shfl_xor(ss, 32);
      const float rms = rsqrtf(ss * (1.f / 128.f) + 1e-6f) * post;
      u16* op = hcat + (size_t)(tok0 + qsub * 32 + qb * 16 + fr) * 1024 + h * 128;
#pragma unroll
      for (int d = 0; d < 8; ++d) {
        const int dv = d * 16 + fq * 4;
        uint2 ov;
        ov.x = pack2(fw.o[qb][d][0] * rms * sg[dv], fw.o[qb][d][1] * rms * sg[dv + 1]);
        ov.y = pack2(fw.o[qb][d][2] * rms * sg[dv + 2], fw.o[qb][d][3] * rms * sg[dv + 3]);
        *reinterpret_cast<uint2*>(op + dv) = ov;
      }
    }
  }
  __syncthreads();
}

#undef load_tile
#undef store_tile
DI void cross_attn_item(const PRef& p, int tokblk, int h) {
  extern __shared__ __attribute__((aligned(16))) u16 shm[];
  u16* Ks = shm;
  u16* Vts = shm + 64 * 264;
  const u16* qc = (const u16*)(p.ws + OFF_QC);
  const u16* km = (const u16*)(p.ws + OFF_KMEM);
  const u16* vm = (const u16*)(p.ws + OFF_VMEMT);
  u16* oc = (u16*)(p.ws + OFF_OC);
  const int tid = ltid(), w = tid >> 6, lane = tid & 63, fr = lane & 15, fq = lane >> 4;
  const int tok0 = tokblk * 128, b = tok0 >> 12;
  FlashWave<256, 256, 1> fw;
  fw.init();
#pragma unroll
  for (int ks = 0; ks < 8; ++ks)
    fw.qf[0][ks] = *reinterpret_cast<const bf16x8*>(qc + (size_t)(tok0 + w * 16 + fr) * 1024 + h * 256 + ks * 32 + fq * 8);
  uint4 kreg0, kreg1, kreg2, kreg3, vreg0, vreg1, vreg2, vreg3;
  const u16* kbase = km + (size_t)(b * 256 + (tid >> 5)) * 1024 + h * 256 + (tid & 31) * 8;
  const u16* vbase = vm + (size_t)(h * 256 + (tid >> 3)) * 2048 + b * 256 + (tid & 7) * 8;
  u16* kdst = Ks + (tid >> 5) * 264 + (tid & 31) * 8;
  u16* vdst = Vts + (tid >> 3) * 72 + (tid & 7) * 8;
#define load_tile(kt) do { \
    kreg0 = *reinterpret_cast<const uint4*>(kbase + (size_t)((kt) * 64 + 0) * 1024); \
    kreg1 = *reinterpret_cast<const uint4*>(kbase + (size_t)((kt) * 64 + 16) * 1024); \
    kreg2 = *reinterpret_cast<const uint4*>(kbase + (size_t)((kt) * 64 + 32) * 1024); \
    kreg3 = *reinterpret_cast<const uint4*>(kbase + (size_t)((kt) * 64 + 48) * 1024); \
    vreg0 = *reinterpret_cast<const uint4*>(vbase + (size_t)0 * 2048 + (kt) * 64); \
    vreg1 = *reinterpret_cast<const uint4*>(vbase + (size_t)64 * 2048 + (kt) * 64); \
    vreg2 = *reinterpret_cast<const uint4*>(vbase + (size_t)128 * 2048 + (kt) * 64); \
    vreg3 = *reinterpret_cast<const uint4*>(vbase + (size_t)192 * 2048 + (kt) * 64); } while (0)
#define store_tile() do { \
    *reinterpret_cast<uint4*>(kdst) = kreg0; *reinterpret_cast<uint4*>(kdst + 16 * 264) = kreg1; \
    *reinterpret_cast<uint4*>(kdst + 32 * 264) = kreg2; *reinterpret_cast<uint4*>(kdst + 48 * 264) = kreg3; \
    *reinterpret_cast<uint4*>(vdst) = vreg0; *reinterpret_cast<uint4*>(vdst + 64 * 72) = vreg1; \
    *reinterpret_cast<uint4*>(vdst + 128 * 72) = vreg2; *reinterpret_cast<uint4*>(vdst + 192 * 72) = vreg3; } while (0)
  load_tile(0);
  for (int kt = 0; kt < 4; ++kt) {
    __syncthreads();
    store_tile();
    __syncthreads();
    if (kt + 1 < 4) load_tile(kt + 1);
    fw.tile(Ks, Vts);
  }
  const float inv = 1.f / fw.lsum(0);
  u16* op = oc + (size_t)(tok0 + w * 16 + fr) * 1024 + h * 256;
#pragma unroll
  for (int d = 0; d < 16; ++d) {
    uint2 ov;
    ov.x = pack2(fw.o[0][d][0] * inv, fw.o[0][d][1] * inv);
    ov.y = pack2(fw.o[0][d][2] * inv, fw.o[0][d][3] * inv);
    *reinterpret_cast<uint2*>(op + d * 16 + fq * 4) = ov;
  }
  __syncthreads();
}

#undef load_tile
#undef store_tile
DI float row8_sum(float x) {
  x += dpp_f<0xB1>(x);
  x += dpp_f<0x4E>(x);
  x += dpp_f<0x141>(x);
  return x;
}
DI f32v2 bfpair(unsigned q) { f32v2 r; r.x = __uint_as_float(q << 16); r.y = __uint_as_float(q & 0xffff0000u); return r; }

DI void rwkv_scan_item(const PRef& p, int b, int h, int half) {
  extern __shared__ __attribute__((aligned(16))) u16 shm[];
  char* buf = reinterpret_cast<char*>(shm);
  float* ybuf = reinterpret_cast<float*>(buf + 2 * 16 * 1152);
  float* dummy = ybuf + 1024;
  const char* rec = p.ws + OFF_REC + (size_t)((b * 4 + h) * SEQ) * 1152;
  float* Y = (float*)(p.ws + OFF_Y);
  const int tid = ltid(), w = tid >> 6, lane = tid & 63;
  const int rl = (w & 3) * 8 + (lane >> 3);
  const int row = half * 32 + rl;
  const int ks = (lane & 7) * 8;
  const bool compute = w < 4;
  const bool leader = (lane & 7) == 0;
  float* ydst0 = leader ? (ybuf + rl) : (dummy + (tid & 255));
  const int ystride = leader ? 32 : 0;
  f32v2 S01 = {0.f, 0.f}, S23 = {0.f, 0.f}, S45 = {0.f, 0.f}, S67 = {0.f, 0.f};
  uint4 rg0, rg1, rg2 = make_uint4(0, 0, 0, 0);
  auto load_chunk = [&](int ch) {
    const uint4* src = reinterpret_cast<const uint4*>(rec + (size_t)ch * 16 * 1152);
    rg0 = src[tid]; rg1 = src[tid + 512];
    if (tid < 128) rg2 = src[tid + 1024];
  };
  load_chunk(0);
  __syncthreads();
  for (int ch = 0; ch < SEQ / 16; ++ch) {
    char* cb = buf + (ch & 1) * 16 * 1152;
    {
      uint4* dst = reinterpret_cast<uint4*>(cb);
      dst[tid] = rg0; dst[tid + 512] = rg1;
      if (tid < 128) dst[tid + 1024] = rg2;
    }
    __syncthreads();
    if (ch + 1 < SEQ / 16) load_chunk(ch + 1);
    if (ch > 0) {
      const float* ybp = ybuf + ((ch - 1) & 1) * 512;
      const int st = tid >> 5, r = tid & 31;
      Y[(size_t)(b * SEQ + (ch - 1) * 16 + st) * 256 + h * 64 + half * 32 + r] = ybp[tid];
    }
    if (compute) {
      float* yd = ydst0 + (leader ? (ch & 1) * 512 : 0);
      const char* sp = cb;
      float4 wa = *reinterpret_cast<const float4*>(sp + ks * 4), wb = *reinterpret_cast<const float4*>(sp + ks * 4 + 16);
      float4 ka = *reinterpret_cast<const float4*>(sp + 256 + ks * 4), kb = *reinterpret_cast<const float4*>(sp + 256 + ks * 4 + 16);
      float4 ba = *reinterpret_cast<const float4*>(sp + 512 + ks * 4), bbv = *reinterpret_cast<const float4*>(sp + 512 + ks * 4 + 16);
      uint4 kq = *reinterpret_cast<const uint4*>(sp + 768 + ks * 2);
      uint4 rq = *reinterpret_cast<const uint4*>(sp + 896 + ks * 2);
      unsigned vq = *reinterpret_cast<const u16*>(sp + 1024 + row * 2);
#pragma unroll
      for (int st = 0; st < 16; ++st) {
        float4 wan, wbn, kan, kbn, ban, bbn; uint4 kqn, rqn; unsigned vqn;
        if (st < 15) {
          const char* sn = cb + (st + 1) * 1152;
          wan = *reinterpret_cast<const float4*>(sn + ks * 4); wbn = *reinterpret_cast<const float4*>(sn + ks * 4 + 16);
          kan = *reinterpret_cast<const float4*>(sn + 256 + ks * 4); kbn = *reinterpret_cast<const float4*>(sn + 256 + ks * 4 + 16);
          ban = *reinterpret_cast<const float4*>(sn + 512 + ks * 4); bbn = *reinterpret_cast<const float4*>(sn + 512 + ks * 4 + 16);
          kqn = *reinterpret_cast<const uint4*>(sn + 768 + ks * 2);
          rqn = *reinterpret_cast<const uint4*>(sn + 896 + ks * 2);
          vqn = *reinterpret_cast<const u16*>(sn + 1024 + row * 2);
        }
        const float v = __uint_as_float(vq << 16);
        const f32v2 vv = {v, v};
        const f32v2 kk01 = {ka.x, ka.y}, kk23 = {ka.z, ka.w}, kk45 = {kb.x, kb.y}, kk67 = {kb.z, kb.w};
        f32v2 sa2 = S01 * kk01 + S23 * kk23;
        f32v2 sb2 = S45 * kk45 + S67 * kk67;
        sa2 += sb2;
        float sa = row8_sum(sa2.x + sa2.y);
        const f32v2 sav = {sa, sa};
        S01 = S01 * f32v2{wa.x, wa.y} - sav * f32v2{ba.x, ba.y} + vv * bfpair(kq.x);
        S23 = S23 * f32v2{wa.z, wa.w} - sav * f32v2{ba.z, ba.w} + vv * bfpair(kq.y);
        S45 = S45 * f32v2{wb.x, wb.y} - sav * f32v2{bbv.x, bbv.y} + vv * bfpair(kq.z);
        S67 = S67 * f32v2{wb.z, wb.w} - sav * f32v2{bbv.z, bbv.w} + vv * bfpair(kq.w);
        f32v2 ya = S01 * bfpair(rq.x) + S23 * bfpair(rq.y);
        f32v2 yb2 = S45 * bfpair(rq.z) + S67 * bfpair(rq.w);
        ya += yb2;
        float y = row8_sum(ya.x + ya.y);
        yd[st * ystride] = y;
        if (st < 15) { wa = wan; wb = wbn; ka = kan; kb = kbn; ba = ban; bbv = bbn; kq = kqn; rq = rqn; vq = vqn; }
      }
    }
  }
  __syncthreads();
  {
    const int ch = SEQ / 16 - 1;
    const float* ybp = ybuf + (ch & 1) * 512;
    const int st = tid >> 5, r = tid & 31;
    Y[(size_t)(b * SEQ + ch * 16 + st) * 256 + h * 64 + half * 32 + r] = ybp[tid];
  }
  __syncthreads();
}

DI float gelu_tanh(float x) {
  float u = 0.7978845608028654f * (x + 0.044715f * x * x * x);
  return 0.5f * x * (1.f + tanhf(u));
}
DI void s5_item(const PRef& p, int l, int b, int g) {
  extern __shared__ __attribute__((aligned(16))) u16 shm[];
  float* uL = reinterpret_cast<float*>(shm);
  float* fin = uL + 8 * 256;
  float* xL = fin + 8 * 128;
  const u16* s5 = (const u16*)(p.ws + OFF_S5);
  u16* Z = (u16*)(p.ws + OFF_Z);
  const int tid = ltid(), w = tid >> 6, lane = tid & 63;
  const float Are = ((const float*)p.in[I_SARE])[(l * 16 + g) * 64 + lane];
  const float Aim = ((const float*)p.in[I_SAIM])[(l * 16 + g) * 64 + lane];
  const float delta = expf(((const float*)p.in[I_SLOG])[l * 16 + g]);
  float cr, ci;
  {
    float er = expf(delta * Are); float sn, cs; sincosf(delta * Aim, &sn, &cs);
    cr = er * cs; ci = er * sn;
  }
  float Bre[16], Bim[16];
  {
    const float x = cr - 1.f, y = ci, den = 1.f / (Are * Are + Aim * Aim);
    const float qre = (x * Are + y * Aim) * den, qim = (y * Are - x * Aim) * den;
    const float* bre = (const float*)p.in[I_SBRE] + ((size_t)(l * 16 + g) * 64 + lane) * 16;
    const float* bim = (const float*)p.in[I_SBIM] + ((size_t)(l * 16 + g) * 64 + lane) * 16;
#pragma unroll
    for (int hh = 0; hh < 16; ++hh) { float br = bre[hh], bi = bim[hh]; Bre[hh] = qre * br - qim * bi; Bim[hh] = qre * bi + qim * br; }
  }
  __syncthreads();
  bf16x8 cf[4];
  {
    const int hq = lane & 15, q4 = lane >> 4;
    const float* cre = (const float*)p.in[I_SCRE] + ((size_t)(l * 16 + g) * 16 + hq) * 64;
    const float* cim = (const float*)p.in[I_SCIM] + ((size_t)(l * 16 + g) * 16 + hq) * 64;
#pragma unroll
    for (int s4 = 0; s4 < 4; ++s4) {
      const float4 re = *reinterpret_cast<const float4*>(cre + 16 * s4 + 4 * q4);
      const float4 im = *reinterpret_cast<const float4*>(cim + 16 * s4 + 4 * q4);
      cf[s4] = __builtin_bit_cast(bf16x8, (u32x4{pack2(re.x, -im.x), pack2(re.y, -im.y), pack2(re.z, -im.z), pack2(re.w, -im.w)}));
    }
  }
  const int tbase = b * SEQ + w * 512;
  float* uw = uL + w * 256;
  auto load_u = [&](int ch) {
    const int tt = lane >> 2, c4 = (lane & 3) * 4;
    uint2 raw = *reinterpret_cast<const uint2*>(s5 + (size_t)(tbase + ch * 16 + tt) * 256 + g * 16 + c4);
    float4 f; f.x = __uint_as_float(raw.x << 16); f.y = __uint_as_float(raw.x & 0xffff0000u);
    f.z = __uint_as_float(raw.y << 16); f.w = __uint_as_float(raw.y & 0xffff0000u);
    *reinterpret_cast<float4*>(uw + tt * 16 + c4) = f;
  };
  float xr = 0.f, xi = 0.f;
  for (int ch = 0; ch < 32; ++ch) {
    __syncthreads();
    load_u(ch);
    __syncthreads();
#pragma unroll 4
    for (int tt = 0; tt < 16; ++tt) {
      float bur = 0.f, bui = 0.f;
#pragma unroll
      for (int h4 = 0; h4 < 4; ++h4) {
        float4 u = *reinterpret_cast<const float4*>(uw + tt * 16 + h4 * 4);
        bur += Bre[h4 * 4] * u.x + Bre[h4 * 4 + 1] * u.y + Bre[h4 * 4 + 2] * u.z + Bre[h4 * 4 + 3] * u.w;
        bui += Bim[h4 * 4] * u.x + Bim[h4 * 4 + 1] * u.y + Bim[h4 * 4 + 2] * u.z + Bim[h4 * 4 + 3] * u.w;
      }
      float nr = cr * xr - ci * xi + bur, ni = cr * xi + ci * xr + bui;
      xr = nr; xi = ni;
    }
  }
  fin[(w * 64 + lane) * 2] = xr; fin[(w * 64 + lane) * 2 + 1] = xi;
  __syncthreads();
  {
    float pr = cr, pi = ci;
    for (int i = 0; i < 9; ++i) { float nr = pr * pr - pi * pi, ni = 2.f * pr * pi; pr = nr; pi = ni; }
    float vr = 0.f, vi = 0.f;
    for (int ww = 0; ww < w; ++ww) {
      float fr_ = fin[(ww * 64 + lane) * 2], fi_ = fin[(ww * 64 + lane) * 2 + 1];
      float nr = pr * vr - pi * vi + fr_, ni = pr * vi + pi * vr + fi_;
      vr = nr; vi = ni;
    }
    xr = vr; xi = vi;
  }
  float* xw = xL + w * (16 * 66 * 2);
  const int ot = lane & 15, oh = (lane >> 4) * 4;
  const float* dsk = (const float*)p.in[I_SD] + l * 256 + g * 16 + oh;
  const float d0 = dsk[0], d1 = dsk[1], d2 = dsk[2], d3 = dsk[3];
  for (int ch = 0; ch < 32; ++ch) {
    __syncthreads();
    load_u(ch);
    __syncthreads();
#pragma unroll 4
    for (int tt = 0; tt < 16; ++tt) {
      float bur = 0.f, bui = 0.f;
#pragma unroll
      for (int h4 = 0; h4 < 4; ++h4) {
        float4 u = *reinterpret_cast<const float4*>(uw + tt * 16 + h4 * 4);
        bur += Bre[h4 * 4] * u.x + Bre[h4 * 4 + 1] * u.y + Bre[h4 * 4 + 2] * u.z + Bre[h4 * 4 + 3] * u.w;
        bui += Bim[h4 * 4] * u.x + Bim[h4 * 4 + 1] * u.y + Bim[h4 * 4 + 2] * u.z + Bim[h4 * 4 + 3] * u.w;
      }
      float nr = cr * xr - ci * xi + bur, ni = cr * xi + ci * xr + bui;
      xr = nr; xi = ni;
      *reinterpret_cast<float2*>(xw + (tt * 66 + lane) * 2) = make_float2(xr, xi);
    }
    __syncthreads();
    f32x4 yacc = f32x4{0.f, 0.f, 0.f, 0.f};
#pragma unroll
    for (int s4 = 0; s4 < 4; ++s4) {
      const float* xp = xw + (ot * 66 + 16 * s4 + oh) * 2;
      const float4 f0 = *reinterpret_cast<const float4*>(xp), f1 = *reinterpret_cast<const float4*>(xp + 4);
      const bf16x8 xf = __builtin_bit_cast(bf16x8, (u32x4{pack2(f0.x, f0.y), pack2(f0.z, f0.w), pack2(f1.x, f1.y), pack2(f1.z, f1.w)}));
      yacc = __builtin_amdgcn_mfma_f32_16x16x32_bf16(cf[s4], xf, yacc, 0, 0, 0);
    }
    float a0 = yacc[0], a1 = yacc[1], a2 = yacc[2], a3 = yacc[3];
    float4 u = *reinterpret_cast<const float4*>(uw + ot * 16 + oh);
    a0 = gelu_tanh(a0 + d0 * u.x); a1 = gelu_tanh(a1 + d1 * u.y); a2 = gelu_tanh(a2 + d2 * u.z); a3 = gelu_tanh(a3 + d3 * u.w);
    uint2 ov; ov.x = pack2(a0, a1); ov.y = pack2(a2, a3);
    *reinterpret_cast<uint2*>(Z + (size_t)(tbase + ch * 16 + ot) * 256 + g * 16 + oh) = ov;
  }
  __syncthreads();
}

DI void phase_mixers(const PRef& p, int lc) {
  __shared__ int s_item;
  unsigned* cnt = (unsigned*)(p.ws + OFF_CNT) + lc;
  const int l = lc & 7;
  const int total = 64 + 128 + 1024;
  while (true) {
    __syncthreads();
    if (ltid() == 0) s_item = (int)atomicAdd(cnt, 1u);
    __syncthreads();
    const int item = s_item;
    if (item >= total) break;
    kaptr_t ka2 = p.in.ka; asm volatile("" : "+s"(ka2)); const PRef q(ka2);
    const int cls = (lc >= 8) ? (PROBE_DUP >> 4) : 7;
    if (item < 64) { if (cls & 1) rwkv_scan_item(q, item >> 3, (item >> 1) & 3, item & 1); }
    else if (item < 192) { int i = item - 64; if (cls & 2) s5_item(q, l, i >> 4, i & 15); }
    else { int i = item - 192; int qt = 31 - (i >> 5); int bh = i & 31; if (cls & 4) diff_attn_item(q, l, bh >> 2, bh & 3, qt); }
  }
}

DI void phase_post(const PRef& p, int l) {
  const float* Y = (const float*)(p.ws + OFF_Y);
  const u16* gbuf = (const u16*)(p.ws + OFF_G);
  const u16* Z = (const u16*)(p.ws + OFF_Z);
  const float* bonus = (const float*)(p.ws + OFF_BONUS);
  const char* rec = p.ws + OFF_REC;
  u16* hcat = (u16*)(p.ws + OFF_HCAT);
  const u16* glut = (const u16*)(p.ws + OFF_WT + WT_GLU);
  const float* lng = (const float*)p.in[I_LNXG] + l * 256;
  const float* lnb = (const float*)p.in[I_LNXB] + l * 256;
  const float* glub = (const float*)p.in[I_GLUB] + l * 256;
  const float* outg = (const float*)p.in[I_SOUTG] + l * 256;
  const int tid = ltid(), w = tid >> 6, lane = tid & 63, fr = lane & 15, fq = lane >> 4;
  for (int item = blockIdx.x; item < NTOK / 128; item += gridDim.x) {
    const int tk0 = item * 128;
    {
      const int c = tid & 255, half = tid >> 8, h = c >> 6, cc = c & 63;
      const float gw = lng[c], gb = lnb[c];
      for (int i0 = 0; i0 < 64; i0 += 8) {
        float yv[8], vv[8], gq[8], bo[8];
#pragma unroll
        for (int u = 0; u < 8; ++u) {
          const int tok = tk0 + half * 64 + i0 + u;
          const int b = tok >> 12, t = tok & (SEQ - 1);
          const char* rp = rec + ((size_t)((b * 4 + h) * SEQ + t)) * 1152;
          yv[u] = Y[(size_t)tok * 256 + c];
          vv[u] = bf2f(reinterpret_cast<const u16*>(rp + 1024)[cc]);
          gq[u] = bf2f(gbuf[(size_t)tok * 256 + c]);
          bo[u] = bonus[(size_t)tok * 4 + h];
        }
        float mean[8], var[8];
#pragma unroll
        for (int u = 0; u < 8; ++u) { float t = row16_sum(yv[u]); t += __shfl_xor(t, 16); t += __shfl_xor(t, 32); mean[u] = t * (1.f / 64.f); }
#pragma unroll
        for (int u = 0; u < 8; ++u) { float d = yv[u] - mean[u]; float t = row16_sum(d * d); t += __shfl_xor(t, 16); t += __shfl_xor(t, 32); var[u] = t * (1.f / 64.f); }
#pragma unroll
        for (int u = 0; u < 8; ++u) {
          const int tok = tk0 + half * 64 + i0 + u;
          float out = (yv[u] - mean[u]) * rsqrtf(var[u] + 64e-5f) * gw + gb + bo[u] * vv[u];
          out *= gq[u];
          hcat[(size_t)tok * 1024 + 512 + c] = f2bf(out);
        }
      }
    }
    {
      const int tokw = tk0 + w * 16;
      bf16x8 zf[8];
#pragma unroll
      for (int s = 0; s < 8; ++s) zf[s] = *reinterpret_cast<const bf16x8*>(Z + (size_t)(tokw + fr) * 256 + s * 32 + fq * 8);
      float ss = 0.f, rms = 0.f;
      for (int pass = 0; pass < 2; ++pass) {
#pragma unroll 2
        for (int nb = 0; nb < 16; ++nb) {
          f32x4 acc = f32x4{0.f, 0.f, 0.f, 0.f};
#pragma unroll
          for (int s = 0; s < 8; ++s) {
            bf16x8 wf = *reinterpret_cast<const bf16x8*>(glut + (size_t)(nb * 16 + fr) * 256 + s * 32 + fq * 8);
            acc = __builtin_amdgcn_mfma_f32_16x16x32_bf16(wf, zf[s], acc, 0, 0, 0);
          }
          const int col = nb * 16 + fq * 4;
          uint2 zr = *reinterpret_cast<const uint2*>(Z + (size_t)(tokw + fr) * 256 + col);
          float z0 = __uint_as_float(zr.x << 16), z1 = __uint_as_float(zr.x & 0xffff0000u);
          float z2 = __uint_as_float(zr.y << 16), z3 = __uint_as_float(zr.y & 0xffff0000u);
          float o0 = z0 * sigmoidf_(acc[0] + glub[col]), o1 = z1 * sigmoidf_(acc[1] + glub[col + 1]);
          float o2 = z2 * sigmoidf_(acc[2] + glub[col + 2]), o3 = z3 * sigmoidf_(acc[3] + glub[col + 3]);
          if (pass == 0) ss += o0 * o0 + o1 * o1 + o2 * o2 + o3 * o3;
          else {
            uint2 ov;
            ov.x = pack2(o0 * rms * outg[col], o1 * rms * outg[col + 1]);
            ov.y = pack2(o2 * rms * outg[col + 2], o3 * rms * outg[col + 3]);
            *reinterpret_cast<uint2*>(hcat + (size_t)(tokw + fr) * 1024 + 768 + col) = ov;
          }
        }
        if (pass == 0) { ss += __shfl_xor(ss, 16); ss += __shfl_xor(ss, 32); rms = rsqrtf(ss * (1.f / 256.f) + 1e-6f); }
      }
    }
  }
}

DI void phase_ln(const PRef& p, const float* g, const float* bta) {
  float* xs = p.xs; u16* xb = (u16*)(p.ws + OFF_XB);
  const int w = ltid() >> 6, lane = ltid() & 63;
  for (int tok = blockIdx.x * 8 + w; tok < NTOK; tok += gridDim.x * 8) {
    float4* row = reinterpret_cast<float4*>(xs + (size_t)tok * DM);
    float4 v[4]; float s = 0.f;
    for (int i = 0; i < 4; ++i) { v[i] = row[lane + i * 64]; s += v[i].x + v[i].y + v[i].z + v[i].w; }
    const float mean = wave_sum(s) * (1.f / 1024.f);
    float q = 0.f;
    for (int i = 0; i < 4; ++i) { float a = v[i].x - mean, b = v[i].y - mean, c = v[i].z - mean, d = v[i].w - mean; q += a * a + b * b + c * c + d * d; }
    const float rstd = rsqrtf(wave_sum(q) * (1.f / 1024.f) + 1e-5f);
    for (int i = 0; i < 4; ++i) {
      const int col = (lane + i * 64) * 4;
      float4 gg = *reinterpret_cast<const float4*>(g + col), bb = *reinterpret_cast<const float4*>(bta + col);
      float4 o;
      o.x = (v[i].x - mean) * rstd * gg.x + bb.x; o.y = (v[i].y - mean) * rstd * gg.y + bb.y;
      o.z = (v[i].z - mean) * rstd * gg.z + bb.z; o.w = (v[i].w - mean) * rstd * gg.w + bb.w;
      row[lane + i * 64] = o;
      uint2 ob; ob.x = pack2(o.x, o.y); ob.y = pack2(o.z, o.w);
      *reinterpret_cast<uint2*>(xb + (size_t)tok * DM + col) = ob;
    }
  }
}

DI void phase_conv(const PRef& p, int l) {
  char* ws = p.ws;
  u16* hmid = (u16*)(ws + OFF_AG);
  const float* af = (const float*)(ws + OFF_AF); const float* gf = (const float*)(ws + OFF_GF); const float* al = (const float*)(ws + OFF_AL);
  const float* cw = (const float*)p.in[I_CONVW] + (size_t)l * 3 * DFF;
  const float* cb = (const float*)p.in[I_CONVB] + (size_t)l * DFF;
  for (int it = blockIdx.x * 512 + ltid(); it < 128 * DFF; it += gridDim.x * 512) {
    const int pm = it / DFF, c = it % DFF;
    const float a0 = af[(size_t)(pm * 2) * DFF + c], a1 = af[(size_t)(pm * 2 + 1) * DFF + c];
    const float g0 = gf[(size_t)(pm * 2) * DFF + c], g1 = gf[(size_t)(pm * 2 + 1) * DFF + c];
    float l0 = 0.f, l1 = 0.f;
    if ((pm & 15) != 0) { l0 = al[(size_t)((pm - 1) * 2) * DFF + c]; l1 = al[(size_t)((pm - 1) * 2 + 1) * DFF + c]; }
    const float w0 = cw[c], w1 = cw[DFF + c], w2 = cw[2 * DFF + c], bs = cb[c];
    const float cv0 = bs + w0 * l0 + w1 * l1 + w2 * a0;
    const float cv1 = bs + w0 * l1 + w1 * a0 + w2 * a1;
    hmid[(size_t)(pm * 256) * DFF + c] = f2bf(cv0 * sigmoidf_(cv0) * g0);
    hmid[(size_t)(pm * 256 + 1) * DFF + c] = f2bf(cv1 * sigmoidf_(cv1) * g1);
  }
}

DI void phase_gemm(const PRef& p, int kind, int l) {
  int nN = 4, K = 1024, lda = 1024, ldb = 1024;
  if (kind == 0) nN = 9;
  if (kind == 10) nN = 22;
  if (kind == 12) { lda = 2816; ldb = 2816; K = 2816; }
  const int ntile = 128 * nN;
  const bool remap = (gridDim.x & 7) == 0;
  const int per = remap ? (ntile >> 3) : ntile, xcd = blockIdx.x & 7;
  const int slot = remap ? (int)(blockIdx.x >> 3) : (int)blockIdx.x, nslot = remap ? (int)(gridDim.x >> 3) : (int)gridDim.x;
  const int n_main = (slot < per) ? (per - slot + nslot - 1) / nslot : 0;
  const int t0x = remap ? (int)((((blockIdx.x >> 3) + 16) & 31) * 8 + (blockIdx.x & 7)) : (int)blockIdx.x;
  const int n_extra = (kind == 0 && t0x < 320) ? (320 - t0x + (int)gridDim.x - 1) / (int)gridDim.x : 0;
  const kaptr_t ka = p.in.ka;
  auto tile_fn = [&](int idx) -> TileDesc {
    const PRef q(ka);
    char* ws = q.ws; char* wt = ws + OFF_WT;
    const u16* xb = (const u16*)(ws + OFF_XB);
    TileDesc d; d.sub = 0; d.A = xb;
    if (idx < n_main) {
      const int jj = slot + idx * nslot;
      const int t = remap ? xcd * per + jj : jj;
      int pm = t / nN, pn = t % nN;
      if (kind == 0) { d.B = (const u16*)(wt + WT_IN); pn = (pn < 4) ? pn : pn + 2; }
      else if (kind == 4) { d.A = (const u16*)(ws + OFF_HCAT); d.B = (const u16*)(wt + WT_OUT); }
      else if (kind == 6) d.B = (const u16*)(wt + WT_Q);
      else if (kind == 8) { d.A = (const u16*)(ws + OFF_OC); d.B = (const u16*)(wt + WT_O); }
      else if (kind == 10) d.B = (const u16*)(wt + WT_UP);
      else { d.A = (const u16*)(ws + OFF_AG); d.B = (const u16*)(wt + WT_DOWN); }
      d.brow = pm * 256; d.bcol = pn * 256;
    } else {
      const int t = t0x + (idx - n_main) * (int)gridDim.x;
      const u16* wint = (const u16*)(wt + WT_IN); const u16* wkvt = (const u16*)(wt + WT_KV); const u16* memb = (const u16*)(ws + OFF_MEMB);
      int pm, pn;
      if (t < 256) { pn = t >> 1; pm = t & 1; d.A = wint + (size_t)1024 * 1024; d.B = xb; d.sub = 1; }
      else if (t < 288) { int i = t - 256; pm = i >> 2; pn = i & 3; d.A = memb; d.B = wkvt; d.sub = 2; }
      else { int i = t - 288; pm = i >> 3; pn = i & 7; d.A = wkvt + (size_t)1024 * 1024; d.B = memb; d.sub = 3; }
      d.brow = pm * 256; d.bcol = pn * 256;
    }
    return d;
  };
  EpiGen e; e.kind = kind; e.lay = l; e.ka = ka;
  gemm_stream(n_main + n_extra, lda, ldb, K, tile_fn, e);
}
DI void phase_cross(const PRef& p) {
  for (int it = blockIdx.x; it < 1024; it += gridDim.x) cross_attn_item(p, it >> 2, it & 3);
}

constexpr int PH_PER_LAYER = 14, N_PHASES = 1 + DEPTH * PH_PER_LAYER;

DI void run_phase(const PRef& p, int ph) {
  if (ph == 0) { phase_init(p); phase_transposes(p, 0); return; }
  const int l = (ph - 1) / PH_PER_LAYER, s = (ph - 1) % PH_PER_LAYER;
  if (s == 0 || s == 4 || s == 6 || s == 8 || s == 10 || s == 12) {
    phase_gemm(p, s, l);
    if ((PROBE_DUP & 1) && (s == 0 || s == 6 || s == 10)) phase_gemm(p, s, l);
    return;
  }
  switch (s) {
    case 1: phase_prep(p, l); break;
    case 2: phase_mixers(p, l); if (PROBE_DUP & 2) phase_mixers(p, l + 8); break;
    case 3: phase_post(p, l); if (PROBE_DUP & 8) phase_post(p, l); break;
    case 5: phase_ln(p, (const float*)p.in[I_LN1G] + l * DM, (const float*)p.in[I_LN1B] + l * DM); break;
    case 7: phase_cross(p); if (PROBE_DUP & 4) phase_cross(p); break;
    case 9: phase_ln(p, (const float*)p.in[I_LN2G] + l * DM, (const float*)p.in[I_LN2B] + l * DM); break;
    case 11: phase_conv(p, l); break;
    case 13:
      phase_ln(p, (const float*)p.in[I_LN3G] + l * DM, (const float*)p.in[I_LN3B] + l * DM);
      if (l + 1 < DEPTH) phase_transposes(p, l + 1);
      break;
  }
}

template <int S>
__global__ void __launch_bounds__(512) ph_kernel(Params p_unused, int l) {
  kaptr_t ka = (kaptr_t)__builtin_amdgcn_kernarg_segment_ptr();
  const PRef p(ka);
  if (S < 0) { phase_init(p); phase_transposes(p, 0); return; }
  if (S == 0 || S == 4 || S == 6 || S == 8 || S == 10 || S == 12) { phase_gemm(p, S, l); return; }
  if (S == 1) phase_prep(p, l);
  if (S == 2) phase_mixers(p, l);
  if (S == 3) phase_post(p, l);
  if (S == 5) phase_ln(p, (const float*)p.in[I_LN1G] + l * DM, (const float*)p.in[I_LN1B] + l * DM);
  if (S == 7) phase_cross(p);
  if (S == 9) phase_ln(p, (const float*)p.in[I_LN2G] + l * DM, (const float*)p.in[I_LN2B] + l * DM);
  if (S == 11) phase_conv(p, l);
  if (S == 13) {
    phase_ln(p, (const float*)p.in[I_LN3G] + l * DM, (const float*)p.in[I_LN3B] + l * DM);
    if (l + 1 < DEPTH) phase_transposes(p, l + 1);
  }
}

#if !MULTI_LAUNCH
__device__ unsigned g_bar = 0;
#ifndef USE_COOP
#define USE_COOP 1
#endif

__global__ void __launch_bounds__(512) fwd_kernel(Params p_unused, int ph_begin_arg, int ph_end_arg) {
  constexpr int ph_begin = 0, ph_end = N_PHASES;
#if USE_COOP
  cg::this_grid().sync();
#endif
  __shared__ unsigned s_base;
  for (int ph = ph_begin; ph < ph_end; ++ph) {
    kaptr_t ka = (kaptr_t)__builtin_amdgcn_kernarg_segment_ptr();
    asm volatile("" : "+s"(ka));
    const PRef p(ka);
    run_phase(p, ph);
    if (ph + 1 < ph_end) {
      asm volatile("s_waitcnt vmcnt(0) lgkmcnt(0)" ::: "memory");
      __syncthreads();
      if (threadIdx.x == 0) {
        __builtin_amdgcn_fence(__ATOMIC_RELEASE, "agent");
        asm volatile("s_waitcnt vmcnt(0)" ::: "memory");
        const unsigned nbar = (unsigned)(ph - ph_begin + 1);
        unsigned old = __hip_atomic_fetch_add(&g_bar, 1u, __ATOMIC_RELAXED, __HIP_MEMORY_SCOPE_AGENT);
        if (nbar == 1) { const unsigned per_launch = (unsigned)(ph_end - ph_begin - 1) * gridDim.x; s_base = old - (old % per_launch); }
        const unsigned target = s_base + nbar * gridDim.x;
        while ((int)(__hip_atomic_load(&g_bar, __ATOMIC_RELAXED, __HIP_MEMORY_SCOPE_AGENT) - target) < 0) __builtin_amdgcn_s_sleep(4);
        __builtin_amdgcn_fence(__ATOMIC_ACQUIRE, "agent");
        asm volatile("s_waitcnt vmcnt(0)" ::: "memory");
      }
      __syncthreads();
    }
  }
}
#endif

constexpr size_t kDynLds = 131072 + 4096;

template <int S> static void launch_ph(const Params& p, int l, int grid, hipStream_t stream) {
  static bool attr_done = false;
  if (!attr_done) { (void)hipFuncSetAttribute((const void*)ph_kernel<S>, hipFuncAttributeMaxDynamicSharedMemorySize, (int)kDynLds); attr_done = true; }
  hipLaunchKernelGGL(ph_kernel<S>, dim3(grid), dim3(512), kDynLds, stream, p, l);
}

extern "C" void kernel_launch(void* const* d_in, const int* in_sizes, int n_in, void* d_out, int out_size, void* d_ws, size_t ws_size,
                              hipStream_t stream) {
  Params p;
  memset(&p, 0, sizeof(p));
  for (int i = 0; i < N_IN && i < n_in; ++i) p.in[i] = d_in[i];
  p.xs = (float*)d_out;
  p.ws = (char*)d_ws;
  for (int l = 0; l < 4; ++l) p.lam_init[l] = (float)(0.8 - 0.6 * exp(-0.3 * (double)l));
#if MULTI_LAUNCH
  const int grid = 256;
  launch_ph<-1>(p, 0, grid, stream);
  for (int l = 0; l < DEPTH; ++l) {
    launch_ph<0>(p, l, grid, stream); launch_ph<1>(p, l, grid, stream); launch_ph<2>(p, l, grid, stream); launch_ph<3>(p, l, grid, stream);
    launch_ph<4>(p, l, grid, stream); launch_ph<5>(p, l, grid, stream); launch_ph<6>(p, l, grid, stream); launch_ph<7>(p, l, grid, stream);
    launch_ph<8>(p, l, grid, stream); launch_ph<9>(p, l, grid, stream); launch_ph<10>(p, l, grid, stream); launch_ph<11>(p, l, grid, stream);
    launch_ph<12>(p, l, grid, stream); launch_ph<13>(p, l, grid, stream);
  }
#else
  static int grid_blocks = 0;
  if (!grid_blocks) {
    (void)hipFuncSetAttribute((const void*)fwd_kernel, hipFuncAttributeMaxDynamicSharedMemorySize, (int)kDynLds);
    int dev = 0, cus = 0, per_cu = 0;
    (void)hipGetDevice(&dev);
    (void)hipDeviceGetAttribute(&cus, hipDeviceAttributeMultiprocessorCount, dev);
    (void)hipOccupancyMaxActiveBlocksPerMultiprocessor(&per_cu, fwd_kernel, 512, kDynLds);
    if (per_cu < 1) per_cu = 1;
    grid_blocks = cus * per_cu;
    if (grid_blocks <= 0) grid_blocks = 256;
    if (per_cu > 1) grid_blocks = cus;
  }
  int b = 0, e = N_PHASES;
#if USE_COOP
  void* args[] = {&p, &b, &e};
  hipError_t err = hipLaunchCooperativeKernel((void*)fwd_kernel, dim3(grid_blocks), dim3(512), args, kDynLds, stream);
  if (err != hipSuccess) fprintf(stderr, "cooperative launch failed: %s (grid %d)\n", hipGetErrorString(err), grid_blocks);
#else
#ifdef BISECT_PER_PHASE
  for (int ph = 0; ph < N_PHASES; ++ph) hipLaunchKernelGGL(fwd_kernel, dim3(grid_blocks), dim3(512), kDynLds, stream, p, ph, ph + 1);
#else
  hipLaunchKernelGGL(fwd_kernel, dim3(grid_blocks), dim3(512), kDynLds, stream, p, b, e);
#endif
#endif
#endif
}
```

```cpp
#include <hip/hip_runtime.h>
#include <hip/hip_bf16.h>
#include <hip/hip_cooperative_groups.h>
#include <cstdio>
#include <cstring>
#include <cmath>
#include <cstddef>
namespace cg = cooperative_groups;

#ifndef PROBE_DUP
#define PROBE_DUP 0
#endif
#ifndef MULTI_LAUNCH
#define MULTI_LAUNCH 0
#endif

typedef unsigned short u16;
using bf16x8 = __attribute__((ext_vector_type(8))) short;
using f32x4 = __attribute__((ext_vector_type(4))) float;
using u32x4 = __attribute__((ext_vector_type(4))) unsigned;
#define DI __device__ __forceinline__

constexpr int NTOK = 32768, DM = 1024, SEQ = 4096, NBATCH = 8, DEPTH = 4;
constexpr int INW = 2688, DFF = 2816;
constexpr float ALPHA = 1.681792830507429f;
constexpr float LOG2E = 1.4426950408889634f;

enum { I_X = 0, I_MEM, I_POS, I_WIN, I_LQ1, I_LK1, I_LQ2, I_LK2, I_SUBLN, I_MU, I_W0, I_W2, I_A0, I_A2, I_G2, I_KK, I_KA, I_RK,
       I_LNXG, I_LNXB, I_SARE, I_SAIM, I_SBRE, I_SBIM, I_SCRE, I_SCIM, I_SD, I_SLOG, I_GLUW, I_GLUB, I_SOUTG, I_WOUT, I_LN1G, I_LN1B,
       I_WQ, I_WKV, I_WO, I_LN2G, I_LN2B, I_WUP, I_CONVW, I_CONVB, I_WDOWN, I_LN3G, I_LN3B, N_IN };

constexpr size_t MiB = 1024 * 1024;
constexpr size_t OFF_XB = 0;
constexpr size_t OFF_Y = 0, OFF_G = 32 * MiB, OFF_Z = 48 * MiB;
constexpr size_t OFF_WT = 64 * MiB;
constexpr size_t WT_IN = 0, WT_OUT = WT_IN + 2816ul * 1024 * 2, WT_Q = WT_OUT + 2 * MiB, WT_KV = WT_Q + 2 * MiB, WT_O = WT_KV + 4 * MiB,
                 WT_UP = WT_O + 2 * MiB, WT_DOWN = WT_UP + 11 * MiB, WT_GLU = WT_DOWN + 2816ul * 1024 * 2,
                 WT_W2T = WT_GLU + 131072, WT_A2T = WT_W2T + 16384, WT_G2T = WT_A2T + 16384;
constexpr size_t OFF_KMEM = 97 * MiB;
constexpr size_t OFF_VMEMT = 101 * MiB;
constexpr size_t OFF_MEMB = 105 * MiB;
constexpr size_t OFF_ROPE = 109 * MiB;
constexpr size_t OFF_CNT = 117 * MiB;
constexpr size_t OFF_BONUS = 118 * MiB;
constexpr size_t OFF_DR = 120 * MiB;
constexpr size_t OFF_QK = OFF_DR;
constexpr size_t OFF_RW = OFF_DR + 64 * MiB;
constexpr size_t OFF_S5 = OFF_DR + 120 * MiB;
constexpr size_t OFF_VT = OFF_DR + 136 * MiB;
constexpr size_t OFF_HCAT = OFF_DR + 168 * MiB;
constexpr size_t OFF_REC = OFF_DR + 232 * MiB;
constexpr size_t OFF_QC = OFF_DR;
constexpr size_t OFF_OC = OFF_DR + 64 * MiB;
constexpr size_t OFF_AG = OFF_DR;
constexpr size_t OFF_AF = OFF_DR + 200 * MiB;
constexpr size_t OFF_GF = OFF_AF + 3 * MiB;
constexpr size_t OFF_AL = OFF_GF + 3 * MiB;

struct Params {
  const void* in[48];
  float* xs;
  char* ws;
  float lam_init[4];
  int pad[4];
};

typedef const char __attribute__((address_space(4)))* kaptr_t;
struct PRef {
  struct In { kaptr_t ka; DI const void* operator[](int i) const { return *(const void* const __attribute__((address_space(4)))*)(ka + i * 8); } } in;
  struct Xs { kaptr_t ka; DI operator float*() const { return *(float* const __attribute__((address_space(4)))*)(ka + 384); } } xs;
  struct Ws { kaptr_t ka; DI operator char*() const { return *(char* const __attribute__((address_space(4)))*)(ka + 392); } } ws;
  struct Lam { kaptr_t ka; DI float operator[](int i) const { return *(const float __attribute__((address_space(4)))*)(ka + 400 + i * 4); } } lam_init;
  DI explicit PRef(kaptr_t k) : in{k}, xs{k}, ws{k}, lam_init{k} {}
};
static_assert(offsetof(Params, xs) == 384 && offsetof(Params, ws) == 392 && offsetof(Params, lam_init) == 400, "layout");

DI int ltid() { int t = threadIdx.x; asm volatile("" : "+v"(t)); return t; }
typedef __bf16 bf16v2 __attribute__((ext_vector_type(2)));
typedef float f32v2 __attribute__((ext_vector_type(2)));
DI unsigned pack2(float a, float b) { f32v2 v = {a, b}; return __builtin_bit_cast(unsigned, __builtin_convertvector(v, bf16v2)); }
DI u16 f2bf(float x) { return (u16)(pack2(x, 0.f) & 0xffffu); }
DI float bf2f(u16 h) { return __uint_as_float(((unsigned)h) << 16); }
DI float sigmoidf_(float x) { return 1.f / (1.f + __expf(-x)); }
DI float wave_sum(float v) {
  for (int o = 32; o > 0; o >>= 1) v += __shfl_xor(v, o);
  return v;
}
template <int CTRL> DI float dpp_f(float x) {
  return __int_as_float(__builtin_amdgcn_mov_dpp(__float_as_int(x), CTRL, 0xF, 0xF, true));
}
DI float row16_sum(float x) {
  x += dpp_f<0xB1>(x);
  x += dpp_f<0x4E>(x);
  x += dpp_f<0x141>(x);
  x += dpp_f<0x140>(x);
  return x;
}

constexpr int BM = 256, BK = 64, HALF = 128, HT = HALF * BK;

DI int lds_byte(int r, int c) {
  int st = (r >> 4) * 2 + (c >> 5), rr = r & 15, cc = c & 31, ob = rr * 64 + cc * 2;
  return st * 1024 + (ob ^ (((ob >> 9) & 1) << 5));
}
DI void stage_rc(int b, int& R, int& C) {
  int st = b / 1024, sb = b % 1024, swz = sb ^ (((sb >> 9) & 1) << 5);
  R = (st >> 1) * 16 + swz / 64; C = (st & 1) * 32 + (swz % 64) / 2;
}

struct TileDesc { const u16* A; const u16* B; int brow, bcol, sub; };
DI void rope_epilogue(const PRef& p, const f32x4 (&acc)[2][2][4][2], int brow, int bcol, int wr, int wc, int fr, int fq);
template <class TileFn, class Epi>
DI void gemm_stream(int ntiles, int lda, int ldb, int K, TileFn tile_fn, Epi epi) {
  extern __shared__ __attribute__((aligned(16))) u16 shm[];
  if (ntiles <= 0) return;
#define SA(b, h) (shm + ((b) * 2 + (h)) * HT)
#define SB(b, h) (shm + (4 + (b) * 2 + (h)) * HT)
#define STAGE(P, PTR, V, S64, HH, KREL) do { \
    const char* _p = (PTR) + ((KREL) * 128 + (size_t)(2 * (HH)) * (S64)); asm volatile("" : "+s"(_p)); \
    __builtin_amdgcn_global_load_lds((const unsigned*)(_p + (size_t)(V)), (unsigned*)((char*)(P) + tid * 16), 16, 0, 0); \
    const char* _q = (PTR) + ((KREL) * 128 + (size_t)(2 * (HH) + 1) * (S64)); asm volatile("" : "+s"(_q)); \
    __builtin_amdgcn_global_load_lds((const unsigned*)(_q + (size_t)(V)), (unsigned*)((char*)(P) + tid * 16 + 8192), 16, 0, 0); } while (0)
#define LDA(dst, b, h) for (int m = 0; m < 4; ++m) for (int k = 0; k < 2; ++k) \
    dst[m][k] = *reinterpret_cast<const bf16x8*>((char*)SA(b, h) + lda_base + m * 2048 + k * 1024)
#define LDB(dst, b, h) for (int n = 0; n < 2; ++n) for (int k = 0; k < 2; ++k) \
    dst[n][k] = *reinterpret_cast<const bf16x8*>((char*)SB(b, h) + ldb_base + n * 256 + k * 1024)
#define MMA(ai, bj, At_, Bt_) do { __builtin_amdgcn_s_setprio(1); \
    for (int m = 0; m < 4; ++m) for (int n = 0; n < 2; ++n) for (int k = 0; k < 2; ++k) \
      acc[ai][bj][m][n] = __builtin_amdgcn_mfma_f32_16x16x32_bf16(Bt_[n][k], At_[m][k], acc[ai][bj][m][n], 0, 0, 0); \
    __builtin_amdgcn_s_setprio(0); } while (0)
#define WAIT_V(n) asm volatile("s_waitcnt vmcnt(" #n ")" ::: "memory")
#define WAIT_L(n) asm volatile("s_waitcnt lgkmcnt(" #n ")" ::: "memory")
#define BAR __builtin_amdgcn_s_barrier()
#define SCHED __builtin_amdgcn_sched_barrier(0)
#define SA0(P_, K) STAGE(SA(0, 0), P_, vA, sA64, 0, K)
#define SA0H(P_, K) STAGE(SA(0, 1), P_, vA, sA64, 1, K)
#define SA1(P_, K) STAGE(SA(1, 0), P_, vA, sA64, 0, K)
#define SA1H(P_, K) STAGE(SA(1, 1), P_, vA, sA64, 1, K)
#define SB0(P_, K) STAGE(SB(0, 0), P_, vB, sB64, 0, K)
#define SB0H(P_, K) STAGE(SB(0, 1), P_, vB, sB64, 1, K)
#define SB1(P_, K) STAGE(SB(1, 0), P_, vB, sB64, 0, K)
#define SB1H(P_, K) STAGE(SB(1, 1), P_, vB, sB64, 1, K)

  const int tid = ltid();
  const int wid = tid >> 6, lane = tid & 63, wr = wid >> 2, wc = wid & 3, fr = lane & 15, fq = lane >> 4;
  unsigned vA, vB;
  { int r0, c0; stage_rc(tid * 16, r0, c0); vA = (unsigned)(r0 * lda + c0) * 2u; vB = (unsigned)(r0 * ldb + c0) * 2u; }
  const unsigned sA64 = (unsigned)lda * 128u, sB64 = (unsigned)ldb * 128u;
  const int nt = K / BK;
  const int lda_base = lds_byte(wr * 64 + fr, fq * 8);
  const int ldb_base = lds_byte(wc * 32 + (fr >> 2) * 8 + (fr & 3), fq * 8);
  TileDesc cur = tile_fn(0);
  const char* pA = (const char*)(cur.A + (long)cur.brow * lda);
  const char* pB = (const char*)(cur.B + (long)cur.bcol * ldb);
  SB0(pB, 0); SA0(pA, 0); SB0H(pB, 0); SA0H(pA, 0);
  if (wr == 1) BAR;
  WAIT_V(4); BAR;
  SB1(pB, 1); SA1(pA, 1); SB1H(pB, 1);
  WAIT_V(6); BAR;
  for (int ti = 0; ti < ntiles; ++ti) {
    const TileDesc nxt = tile_fn(ti + 1 < ntiles ? ti + 1 : ti);
    const char* pAn = (const char*)(nxt.A + (long)nxt.brow * lda);
    const char* pBn = (const char*)(nxt.B + (long)nxt.bcol * ldb);
    f32x4 acc[2][2][4][2];
    for (int a = 0; a < 2; ++a) for (int b = 0; b < 2; ++b) for (int m = 0; m < 4; ++m) for (int n = 0; n < 2; ++n) acc[a][b][m][n] = f32x4{0.f, 0.f, 0.f, 0.f};
    bf16x8 At[4][2], B0[2][2], B1[2][2];
    for (int t = 0; t < nt; t += 2) {
      const bool last = (t == nt - 2);
      const char* pA2 = last ? pAn - 256 : pA;
      const char* pB2 = last ? pBn - 256 : pB;
      LDB(B0, 0, 0); SCHED; LDA(At, 0, 0); SA1H(pA, 1);
      WAIT_L(8); BAR; WAIT_L(0); MMA(0, 0, At, B0); BAR; SCHED;
      LDB(B1, 0, 1); SB0(pB2, 2);
      BAR; WAIT_L(0); MMA(0, 1, At, B1); BAR;
      LDA(At, 0, 1); SA0(pA2, 2);
      BAR; WAIT_L(0); MMA(1, 0, At, B0); BAR; SCHED;
      SB0H(pB2, 2);
      WAIT_V(6); BAR; MMA(1, 1, At, B1); BAR;
      LDB(B0, 1, 0); SCHED; LDA(At, 1, 0); SA0H(pA2, 2);
      WAIT_L(8); BAR; WAIT_L(0); MMA(0, 0, At, B0); BAR; SCHED;
      LDB(B1, 1, 1); SB1(pB2, 3);
      BAR; WAIT_L(0); MMA(0, 1, At, B1); BAR;
      LDA(At, 1, 1); SA1(pA2, 3);
      BAR; WAIT_L(0); MMA(1, 0, At, B0); BAR; SCHED;
      SB1H(pB2, 3);
      WAIT_V(6); BAR; MMA(1, 1, At, B1); BAR;
      pA += 256; pB += 256;
    }
    if (wr == 0) BAR;
    if (epi.kind == 0 && cur.sub == 0 && cur.bcol < 1024) {
      const PRef pe(epi.ka);
      rope_epilogue(pe, acc, cur.brow, cur.bcol, wr, wc, fr, fq);
    } else if (epi.kind == 10) {
      const PRef pe(epi.ka);
      up_epilogue(pe, epi.lay, acc, cur.brow, cur.bcol, wr, wc, fr, fq, reinterpret_cast<float*>(reinterpret_cast<char*>(shm) + 131072));
    } else {
#pragma unroll
      for (int ai = 0; ai < 2; ++ai)
#pragma unroll
        for (int bj = 0; bj < 2; ++bj)
#pragma unroll
          for (int m = 0; m < 4; ++m)
            epi(cur.sub, cur.brow + ai * HALF + wr * 64 + m * 16 + fr, cur.bcol + bj * HALF + wc * 32 + fq * 8, acc[ai][bj][m][0], acc[ai][bj][m][1]);
    }
    WAIT_V(0);
    cur = nxt; pA = pAn; pB = pBn;
    if (wr == 1 && ti + 1 < ntiles) BAR;
  }
  __syncthreads();
#undef SA
#undef SB
}

template <int CTRL> DI float dppz(float x) {
  return __int_as_float(__builtin_amdgcn_update_dpp(0, __float_as_int(x), CTRL, 0xF, 0xF, true));
}
DI void up_epilogue(const PRef& p, int l, const f32x4 (&acc)[2][2][4][2], int brow, int bcol, int wr, int wc, int fr, int fq, float* exch) {
  char* ws = p.ws;
  u16* hmid = (u16*)(ws + OFF_AG);
  const int pm = brow >> 8, pn = bcol >> 8;
  const int tc0 = wc * 32 + fq * 8;
  const int cw0 = pn * 128 + tc0;
  const float* cwp = (const float*)p.in[I_CONVW] + (size_t)l * 3 * DFF;
  const float* cbp = (const float*)p.in[I_CONVB] + (size_t)l * DFF;
#pragma unroll
  for (int ai = 0; ai < 2; ++ai)
#pragma unroll
    for (int n = 0; n < 2; ++n) {
      if (fr >= 14) {
        const f32x4 v = acc[ai][0][3][n];
        *reinterpret_cast<float4*>(exch + (((ai * 2 + wr) * 2 + (fr - 14)) * 128 + tc0 + n * 4)) = make_float4(v[0], v[1], v[2], v[3]);
        if (ai == 1 && wr == 1)
          *reinterpret_cast<float4*>((float*)(ws + OFF_AL) + ((size_t)(pm * 2 + (fr - 14)) * DFF + cw0 + n * 4)) = make_float4(v[0], v[1], v[2], v[3]);
      }
      if (ai == 0 && wr == 0 && fr < 2) {
        const f32x4 va = acc[0][0][0][n], vg = acc[0][1][0][n];
        *reinterpret_cast<float4*>((float*)(ws + OFF_AF) + ((size_t)(pm * 2 + fr) * DFF + cw0 + n * 4)) = make_float4(va[0], va[1], va[2], va[3]);
        *reinterpret_cast<float4*>((float*)(ws + OFF_GF) + ((size_t)(pm * 2 + fr) * DFF + cw0 + n * 4)) = make_float4(vg[0], vg[1], vg[2], vg[3]);
      }
    }
  __syncthreads();
#pragma unroll
  for (int ai = 0; ai < 2; ++ai) {
    const int sp = ai * 2 + wr;
#pragma unroll
    for (int m = 0; m < 4; ++m) {
      float o[8];
#pragma unroll
      for (int n = 0; n < 2; ++n) {
        const int c = cw0 + n * 4;
        const float4 w0 = *reinterpret_cast<const float4*>(cwp + c), w1 = *reinterpret_cast<const float4*>(cwp + DFF + c);
        const float4 w2 = *reinterpret_cast<const float4*>(cwp + 2 * DFF + c), bs = *reinterpret_cast<const float4*>(cbp + c);
        const float w0a[4] = {w0.x, w0.y, w0.z, w0.w}, w1a[4] = {w1.x, w1.y, w1.z, w1.w}, w2a[4] = {w2.x, w2.y, w2.z, w2.w}, bsa[4] = {bs.x, bs.y, bs.z, bs.w};
        float p62a[4] = {0.f, 0.f, 0.f, 0.f}, p63a[4] = {0.f, 0.f, 0.f, 0.f};
        if (m == 0 && sp > 0) {
          const float4 p62 = *reinterpret_cast<const float4*>(exch + (((sp - 1) * 2 + 0) * 128 + tc0 + n * 4));
          const float4 p63 = *reinterpret_cast<const float4*>(exch + (((sp - 1) * 2 + 1) * 128 + tc0 + n * 4));
          p62a[0] = p62.x; p62a[1] = p62.y; p62a[2] = p62.z; p62a[3] = p62.w;
          p63a[0] = p63.x; p63a[1] = p63.y; p63a[2] = p63.z; p63a[3] = p63.w;
        }
#pragma unroll
        for (int j = 0; j < 4; ++j) {
          const float a = acc[ai][0][m][n][j], g = acc[ai][1][m][n][j];
          float pr1 = dppz<0x111>(a), pr2 = dppz<0x112>(a);
          if (m == 0) {
            if (fr == 0) { pr1 = p63a[j]; pr2 = p62a[j]; }
            if (fr == 1) { pr2 = p63a[j]; }
          } else {
            const float am = acc[ai][0][m > 0 ? m - 1 : 0][n][j];
            const float mir = dppz<0x140>(am);
            const float swp = dppz<0xB1>(mir);
            if (fr == 0) { pr1 = mir; }
            if (fr < 2) { pr2 = swp; }
          }
          const float cv = bsa[j] + w0a[j] * pr2 + w1a[j] * pr1 + w2a[j] * a;
          o[n * 4 + j] = cv * sigmoidf_(cv) * g;
        }
      }
      uint4 ov; ov.x = pack2(o[0], o[1]); ov.y = pack2(o[2], o[3]); ov.z = pack2(o[4], o[5]); ov.w = pack2(o[6], o[7]);
      *reinterpret_cast<uint4*>(hmid + (size_t)(brow + ai * HALF + wr * 64 + m * 16 + fr) * DFF + cw0) = ov;
    }
  }
  __syncthreads();
}

DI void rope_epilogue(const PRef& p, const f32x4 (&acc)[2][2][4][2], int brow, int bcol, int wr, int wc, int fr, int fq) {
  char* ws = p.ws;
  u16* qk = (u16*)(ws + OFF_QK);
  const float* rc = (const float*)(ws + OFF_ROPE); const float* rs = rc + (size_t)NTOK * 32;
  const int d0 = (wc & 1) * 16 + fq * 4;
#pragma unroll
  for (int ai = 0; ai < 2; ++ai)
#pragma unroll
    for (int m = 0; m < 4; ++m) {
      const int tok = brow + ai * HALF + wr * 64 + m * 16 + fr;
      const float4 c4 = *reinterpret_cast<const float4*>(rc + (size_t)tok * 32 + d0);
      const float4 s4 = *reinterpret_cast<const float4*>(rs + (size_t)tok * 32 + d0);
      const float ca[4] = {c4.x, c4.y, c4.z, c4.w}, sa[4] = {s4.x, s4.y, s4.z, s4.w};
#pragma unroll
      for (int bj = 0; bj < 2; ++bj) {
        const int hh = (bcol >> 6) + bj * 2 + (wc >> 1);
        const float sc = (hh < 8) ? 0.125f * LOG2E : 1.f;
        float o0[4], o1[4];
#pragma unroll
        for (int j = 0; j < 4; ++j) {
          const float t0 = acc[ai][bj][m][0][j], t1 = acc[ai][bj][m][1][j];
          o0[j] = (t0 * ca[j] - t1 * sa[j]) * sc;
          o1[j] = (t1 * ca[j] + t0 * sa[j]) * sc;
        }
        uint4 v; v.x = pack2(o0[0], o0[1]); v.y = pack2(o0[2], o0[3]); v.z = pack2(o1[0], o1[1]); v.w = pack2(o1[2], o1[3]);
        *reinterpret_cast<uint4*>(qk + (size_t)tok * 1024 + bcol + bj * HALF + wc * 32 + fq * 8) = v;
      }
    }
}

struct EpiGen {
  int kind, lay; kaptr_t ka;
  DI void operator()(int sub, int row, int col, f32x4 v, f32x4 w) const {
    const PRef p(ka);
    if (kind == 4 || kind == 8 || kind == 12) {
      float* X = p.xs;
      float4* q = reinterpret_cast<float4*>(X + (size_t)row * DM + col);
      const float4* qi = (kind == 4 && lay == 0) ? reinterpret_cast<const float4*>((const float*)p.in[I_X] + (size_t)row * DM + col) : q;
      float4 x = qi[0], y = qi[1];
      x.x = ALPHA * x.x + v[0]; x.y = ALPHA * x.y + v[1]; x.z = ALPHA * x.z + v[2]; x.w = ALPHA * x.w + v[3];
      y.x = ALPHA * y.x + w[0]; y.y = ALPHA * y.y + w[1]; y.z = ALPHA * y.z + w[2]; y.w = ALPHA * y.w + w[3];
      q[0] = x; q[1] = y;
      return;
    }
    char* ws = p.ws;
    const float scale = (kind == 6) ? 0.0625f * LOG2E : 1.f;
    uint4 o; o.x = pack2(v[0] * scale, v[1] * scale); o.y = pack2(v[2] * scale, v[3] * scale);
    o.z = pack2(w[0] * scale, w[1] * scale); o.w = pack2(w[2] * scale, w[3] * scale);
    u16* dst;
    if (kind == 6) dst = (u16*)(ws + OFF_QC) + (size_t)row * 1024 + col;
    else if (sub == 1) dst = (u16*)(ws + OFF_VT) + (size_t)row * NTOK + col;
    else if (sub == 2) dst = (u16*)(ws + OFF_KMEM) + (size_t)row * 1024 + col;
    else if (sub == 3) dst = (u16*)(ws + OFF_VMEMT) + (size_t)row * 2048 + col;
    else if (col < 1024) dst = (u16*)(ws + OFF_QK) + (size_t)row * 1024 + col;
    else if (col < 2432) dst = (u16*)(ws + OFF_RW) + (size_t)row * 896 + (col - 1536);
    else if (col < 2688) dst = (u16*)(ws + OFF_S5) + (size_t)row * 256 + (col - 2432);
    else return;
    *reinterpret_cast<uint4*>(dst) = o;
  }
};

DI void transpose_tiles(const float* __restrict__ src, int K, int N, int Npad, u16* __restrict__ dst, int& tbase, int tile_begin, int tile_stride, bool upmap = false, int rope_rows = 0) {
  extern __shared__ __attribute__((aligned(16))) u16 shm[];
  float* tile = reinterpret_cast<float*>(shm);
  const int nkt = K / 64, nnt = Npad / 64, total = nkt * nnt;
  int first = tile_begin;
  if (first < tbase) { int d = tbase - first; first += ((d + tile_stride - 1) / tile_stride) * tile_stride; }
  for (int g = first; g < tbase + total; g += tile_stride) {
    int t = g - tbase; int kt = t % nkt, ntile = t / nkt; int k0 = kt * 64, n0 = ntile * 64;
    __syncthreads();
    const int tid = ltid();
#pragma unroll
    for (int r = 0; r < 2; ++r) {
      const int e = tid + r * 512, i = e >> 4, j4 = (e & 15) * 4;
      float4 v = make_float4(0.f, 0.f, 0.f, 0.f);
      const int sn0 = upmap ? ((n0 & 255) >> 7) * DFF + (n0 >> 8) * 128 + (n0 & 127) : n0;
      if (n0 + j4 < N) v = *reinterpret_cast<const float4*>(src + (size_t)(k0 + i) * N + sn0 + j4);
      tile[i * 65 + j4] = v.x; tile[i * 65 + j4 + 1] = v.y; tile[i * 65 + j4 + 2] = v.z; tile[i * 65 + j4 + 3] = v.w;
    }
    __syncthreads();
    {
      const int jn = tid >> 3, seg = tid & 7;
      const float* tp = tile + (seg * 8) * 65 + jn;
      uint4 o;
      o.x = pack2(tp[0], tp[65]); o.y = pack2(tp[2 * 65], tp[3 * 65]); o.z = pack2(tp[4 * 65], tp[5 * 65]); o.w = pack2(tp[6 * 65], tp[7 * 65]);
      const int jd = (n0 < rope_rows) ? (((jn >> 4) & 1) * 32 + ((jn & 15) >> 2) * 8 + (jn >> 5) * 4 + (jn & 3)) : jn;
      *reinterpret_cast<uint4*>(dst + (size_t)(n0 + jd) * K + k0 + seg * 8) = o;
    }
  }
  tbase += total;
}

DI void phase_transposes(const PRef& p, int l) {
  char* wt = p.ws + OFF_WT;
  int tbase = 0; const int tb = blockIdx.x, ts = gridDim.x;
  transpose_tiles((const float*)p.in[I_WIN] + (size_t)l * 1024 * INW, 1024, INW, 2816, (u16*)(wt + WT_IN), tbase, tb, ts, false, 1024);
  transpose_tiles((const float*)p.in[I_WOUT] + (size_t)l * 1024 * 1024, 1024, 1024, 1024, (u16*)(wt + WT_OUT), tbase, tb, ts);
  transpose_tiles((const float*)p.in[I_WQ] + (size_t)l * 1024 * 1024, 1024, 1024, 1024, (u16*)(wt + WT_Q), tbase, tb, ts);
  transpose_tiles((const float*)p.in[I_WKV] + (size_t)l * 1024 * 2048, 1024, 2048, 2048, (u16*)(wt + WT_KV), tbase, tb, ts);
  transpose_tiles((const float*)p.in[I_WO] + (size_t)l * 1024 * 1024, 1024, 1024, 1024, (u16*)(wt + WT_O), tbase, tb, ts);
  transpose_tiles((const float*)p.in[I_WUP] + (size_t)l * 1024 * 5632, 1024, 5632, 5632, (u16*)(wt + WT_UP), tbase, tb, ts, true);
  transpose_tiles((const float*)p.in[I_WDOWN] + (size_t)l * 2816 * 1024, 2816, 1024, 1024, (u16*)(wt + WT_DOWN), tbase, tb, ts);
  transpose_tiles((const float*)p.in[I_GLUW] + (size_t)l * 256 * 256, 256, 256, 256, (u16*)(wt + WT_GLU), tbase, tb, ts);
  __syncthreads();
  {
    const float* w2 = (const float*)p.in[I_W2] + l * 32 * 256;
    const float* a2 = (const float*)p.in[I_A2] + l * 32 * 256;
    const float* g2 = (const float*)p.in[I_G2] + l * 64 * 256;
    u16* w2t = (u16*)(wt + WT_W2T); u16* a2t = (u16*)(wt + WT_A2T); u16* g2t = (u16*)(wt + WT_G2T);
    for (int e = blockIdx.x * 512 + ltid(); e < 256 * 128; e += gridDim.x * 512) {
      const int n = e & 255, kk = e >> 8;
      if (kk < 32) w2t[n * 32 + kk] = f2bf(w2[kk * 256 + n]);
      else if (kk < 64) a2t[n * 32 + (kk - 32)] = f2bf(a2[(kk - 32) * 256 + n]);
      else g2t[n * 64 + (kk - 64)] = f2bf(g2[(kk - 64) * 256 + n]);
    }
  }
}

DI void phase_init(const PRef& p) {
  const size_t gtid = (size_t)blockIdx.x * 512 + ltid(), gsz = (size_t)gridDim.x * 512;
  const float4* x4 = (const float4*)p.in[I_X];
  uint2* xb2 = (uint2*)(p.ws + OFF_XB);
  for (size_t i = gtid; i < (size_t)NTOK * DM / 4; i += gsz) {
    float4 v = x4[i];
    uint2 o; o.x = pack2(v.x, v.y); o.y = pack2(v.z, v.w); xb2[i] = o;
  }
  const float4* m4 = (const float4*)p.in[I_MEM];
  uint2* mb2 = (uint2*)(p.ws + OFF_MEMB);
  for (size_t i = gtid; i < (size_t)2048 * 1024 / 4; i += gsz) {
    float4 v = m4[i]; uint2 o; o.x = pack2(v.x, v.y); o.y = pack2(v.z, v.w); mb2[i] = o;
  }
  const int* pos = (const int*)p.in[I_POS];
  float* rc = (float*)(p.ws + OFF_ROPE); float* rs = rc + (size_t)NTOK * 32;
  for (size_t i = gtid; i < (size_t)NTOK * 32; i += gsz) {
    int tok = (int)(i >> 5), d = (int)(i & 31);
    float invf = exp2f(-(float)d * (13.287712379549449f / 32.f));
    float angf = (float)pos[tok] * invf;
    double rev = (double)angf * 0.15915494309189535;
    float xr = (float)((rev - rint(rev)) * 6.283185307179586);
    float sv = __sinf(xr), cv = __cosf(xr);
    rc[i] = cv; rs[i] = sv;
  }
  if (blockIdx.x == 0 && ltid() < 64) ((unsigned*)(p.ws + OFF_CNT))[ltid()] = 0u;
}

DI void phase_prep(const PRef& p, int l) {
  extern __shared__ __attribute__((aligned(16))) u16 shm[];
  float* act = reinterpret_cast<float*>(shm);
  u16* qk = (u16*)(p.ws + OFF_QK);
  const u16* rw = (const u16*)(p.ws + OFF_RW);
  const float* rc = (const float*)(p.ws + OFF_ROPE); const float* rs = rc + (size_t)NTOK * 32;
  const float* mu = (const float*)p.in[I_MU] + l * 896;
  const float* w0 = (const float*)p.in[I_W0] + l * 256;
  const float* w2 = (const float*)p.in[I_W2] + l * 32 * 256;
  const float* a0 = (const float*)p.in[I_A0] + l * 256;
  const float* a2 = (const float*)p.in[I_A2] + l * 32 * 256;
  const float* g2 = (const float*)p.in[I_G2] + l * 64 * 256;
  const float* k_k = (const float*)p.in[I_KK] + l * 256;
  const float* k_a = (const float*)p.in[I_KA] + l * 256;
  const float* r_k = (const float*)p.in[I_RK] + l * 256;
  char* rec = p.ws + OFF_REC;
  u16* gbuf = (u16*)(p.ws + OFF_G);
  float* bonus = (float*)(p.ws + OFF_BONUS);
  const int tid = ltid();
  for (int item = blockIdx.x; item < NTOK / 32; item += gridDim.x) {
    const int tk0 = item * 32;
    __syncthreads();
    for (int idx = tid; idx < 32 * 128; idx += 512) {
      const int i = idx >> 7, j = idx & 127, tok = tk0 + i, col = 768 + j;
      float pv = bf2f(rw[(size_t)tok * 896 + col]);
      float pp = ((tok & (SEQ - 1)) != 0) ? bf2f(rw[(size_t)(tok - 1) * 896 + col]) : 0.f;
      float ps = pv + (pp - pv) * mu[col];
      float a = (j < 32) ? tanhf(ps) : (j < 64) ? ps : sigmoidf_(ps);
      act[i * 128 + j] = a;
    }
    __syncthreads();
    const int c = tid & 255, half = tid >> 8, h = c >> 6;
    {
      float* lora = act + 32 * 128;
      const int w8 = tid >> 6, ln = tid & 63, fr = ln & 15, fq = ln >> 4;
      const u16* w2t = (const u16*)(p.ws + OFF_WT + WT_W2T);
      const u16* a2t = (const u16*)(p.ws + OFF_WT + WT_A2T);
      const u16* g2t = (const u16*)(p.ws + OFF_WT + WT_G2T);
#pragma unroll
      for (int nbi = 0; nbi < 2; ++nbi) {
        const int col0 = (w8 * 2 + nbi) * 16;
        const bf16x8 bw = *reinterpret_cast<const bf16x8*>(w2t + (size_t)(col0 + fr) * 32 + fq * 8);
        const bf16x8 ba = *reinterpret_cast<const bf16x8*>(a2t + (size_t)(col0 + fr) * 32 + fq * 8);
        const bf16x8 bg0 = *reinterpret_cast<const bf16x8*>(g2t + (size_t)(col0 + fr) * 64 + fq * 8);
        const bf16x8 bg1 = *reinterpret_cast<const bf16x8*>(g2t + (size_t)(col0 + fr) * 64 + 32 + fq * 8);
#pragma unroll
        for (int mb = 0; mb < 2; ++mb) {
          const float* ap = act + (mb * 16 + fr) * 128 + fq * 8;
          bf16x8 af[4];
#pragma unroll
          for (int ks = 0; ks < 4; ++ks) {
            const float4 f0 = *reinterpret_cast<const float4*>(ap + ks * 32), f1 = *reinterpret_cast<const float4*>(ap + ks * 32 + 4);
            af[ks] = __builtin_bit_cast(bf16x8, (u32x4{pack2(f0.x, f0.y), pack2(f0.z, f0.w), pack2(f1.x, f1.y), pack2(f1.z, f1.w)}));
          }
          const f32x4 z4 = f32x4{0.f, 0.f, 0.f, 0.f};
          f32x4 dw = __builtin_amdgcn_mfma_f32_16x16x32_bf16(bw, af[0], z4, 0, 0, 0);
          f32x4 da = __builtin_amdgcn_mfma_f32_16x16x32_bf16(ba, af[1], z4, 0, 0, 0);
          f32x4 dg = __builtin_amdgcn_mfma_f32_16x16x32_bf16(bg0, af[2], z4, 0, 0, 0);
          dg = __builtin_amdgcn_mfma_f32_16x16x32_bf16(bg1, af[3], dg, 0, 0, 0);
          float* lp = lora + (mb * 16 + fr) * 256 + col0 + fq * 4;
          *reinterpret_cast<float4*>(lp) = make_float4(dw[0], dw[1], dw[2], dw[3]);
          *reinterpret_cast<float4*>(lp + 32 * 256) = make_float4(da[0], da[1], da[2], da[3]);
          *reinterpret_cast<float4*>(lp + 2 * 32 * 256) = make_float4(dg[0], dg[1], dg[2], dg[3]);
        }
      }
    }
    __syncthreads();
    float accw[16], acca[16], accg[16];
#pragma unroll
    for (int i = 0; i < 16; ++i) {
      const float* lp = act + 32 * 128 + (half * 16 + i) * 256 + c;
      accw[i] = lp[0]; acca[i] = lp[32 * 256]; accg[i] = lp[2 * 32 * 256];
    }
    const float mur = mu[c], muk = mu[256 + c], muv = mu[512 + c];
    const float w0c = w0[c], a0c = a0[c], kkc = k_k[c], kac = k_a[c], rkc = r_k[c];
#pragma unroll
    for (int i = 0; i < 16; ++i) {
      const int tok = tk0 + half * 16 + i;
      const bool has_prev = (tok & (SEQ - 1)) != 0;
      const u16* pr_ = rw + (size_t)tok * 896;
      float r0 = bf2f(pr_[c]), k0 = bf2f(pr_[256 + c]), v0 = bf2f(pr_[512 + c]);
      float r1 = 0.f, k1 = 0.f, v1 = 0.f;
      if (has_prev) { r1 = bf2f(pr_[c - 896]); k1 = bf2f(pr_[256 + c - 896]); v1 = bf2f(pr_[512 + c - 896]); }
      float r = r0 + (r1 - r0) * mur, k = k0 + (k1 - k0) * muk, v = v0 + (v1 - v0) * muv;
      float w = __expf(-0.6065306597126334f * sigmoidf_(w0c + accw[i]));
      float a = sigmoidf_(a0c + acca[i]);
      float kk = k * kkc;
      float ss = wave_sum(kk * kk);
      kk *= rsqrtf(fmaxf(ss, 1e-24f));
      float kp = k * (1.f + (a - 1.f) * kac);
      float bb = kk * a;
      float bo = wave_sum(r * kp * rkc);
      const int b = tok >> 12, t = tok & (SEQ - 1);
      char* rp = rec + ((size_t)((b * 4 + h) * SEQ + t)) * 1152;
      const int cc = c & 63;
      reinterpret_cast<float*>(rp)[cc] = w;
      reinterpret_cast<float*>(rp + 256)[cc] = kk;
      reinterpret_cast<float*>(rp + 512)[cc] = bb;
      reinterpret_cast<u16*>(rp + 768)[cc] = f2bf(kp);
      reinterpret_cast<u16*>(rp + 896)[cc] = f2bf(r);
      reinterpret_cast<u16*>(rp + 1024)[cc] = f2bf(v);
      gbuf[(size_t)tok * 256 + c] = f2bf(accg[i]);
      if (cc == 0) bonus[(size_t)tok * 4 + h] = bo;
    }
    __syncthreads();
  }
}

template <int DK, int DV, int NQB>
struct FlashWave {
  bf16x8 qf[NQB][DK / 32];
  f32x4 o[NQB][DV / 16];
  float m[NQB], l[NQB];
  DI void init() {
#pragma unroll
    for (int qb = 0; qb < NQB; ++qb) { m[qb] = -INFINITY; l[qb] = 0.f;
#pragma unroll
      for (int d = 0; d < DV / 16; ++d) o[qb][d] = f32x4{0.f, 0.f, 0.f, 0.f}; }
  }
  DI void tile(const u16* Ks, const u16* Vts) {
    constexpr int KSTR = DK + 8, VSTR = 72;
    const int lane = ltid() & 63, fr = lane & 15, fq = lane >> 4;
    float base[NQB];
#pragma unroll
    for (int qb = 0; qb < NQB; ++qb) base[qb] = (m[qb] == -INFINITY) ? 0.f : m[qb];
    f32x4 s[4][NQB];
    __builtin_amdgcn_s_setprio(1);
#pragma unroll
    for (int kb = 0; kb < 4; ++kb) {
#pragma unroll
      for (int qb = 0; qb < NQB; ++qb) s[kb][qb] = f32x4{-base[qb], -base[qb], -base[qb], -base[qb]};
#pragma unroll
      for (int ks = 0; ks < DK / 32; ++ks) {
        bf16x8 kf = *reinterpret_cast<const bf16x8*>(Ks + (kb * 16 + fr) * KSTR + ks * 32 + fq * 8);
#pragma unroll
        for (int qb = 0; qb < NQB; ++qb) s[kb][qb] = __builtin_amdgcn_mfma_f32_16x16x32_bf16(kf, qf[qb][ks], s[kb][qb], 0, 0, 0);
      }
    }
    __builtin_amdgcn_s_setprio(0);
    bf16x8 pf[NQB][2];
#pragma unroll
    for (int qb = 0; qb < NQB; ++qb) {
      float mx = -INFINITY;
#pragma unroll
      for (int kb = 0; kb < 4; ++kb) {
#pragma unroll
        for (int j = 0; j < 4; ++j) mx = fmaxf(mx, s[kb][qb][j]); }
      mx = fmaxf(mx, __shfl_xor(mx, 16));
      mx = fmaxf(mx, __shfl_xor(mx, 32));
      const float mn = fmaxf(m[qb], base[qb] + mx);
      const bool changed = __any(mn > m[qb]);
      float sum = 0.f;
      if (changed) {
        const float delta = mn - base[qb];
        const float alpha = __builtin_amdgcn_exp2f(m[qb] - mn);
#pragma unroll
        for (int kb = 0; kb < 4; ++kb) {
#pragma unroll
          for (int j = 0; j < 4; ++j) { float e = __builtin_amdgcn_exp2f(s[kb][qb][j] - delta); s[kb][qb][j] = e; sum += e; } }
        l[qb] = l[qb] * alpha + sum;
#pragma unroll
        for (int d = 0; d < DV / 16; ++d) { o[qb][d][0] *= alpha; o[qb][d][1] *= alpha; o[qb][d][2] *= alpha; o[qb][d][3] *= alpha; }
      } else {
#pragma unroll
        for (int kb = 0; kb < 4; ++kb) {
#pragma unroll
          for (int j = 0; j < 4; ++j) { float e = __builtin_amdgcn_exp2f(s[kb][qb][j]); s[kb][qb][j] = e; sum += e; } }
        l[qb] += sum;
      }
      m[qb] = mn;
#pragma unroll
      for (int k2 = 0; k2 < 2; ++k2) {
        u32x4 pk;
        pk[0] = pack2(s[2 * k2][qb][0], s[2 * k2][qb][1]); pk[1] = pack2(s[2 * k2][qb][2], s[2 * k2][qb][3]);
        pk[2] = pack2(s[2 * k2 + 1][qb][0], s[2 * k2 + 1][qb][1]); pk[3] = pack2(s[2 * k2 + 1][qb][2], s[2 * k2 + 1][qb][3]);
        pf[qb][k2] = __builtin_bit_cast(bf16x8, pk);
      }
    }
    __builtin_amdgcn_s_setprio(1);
#pragma unroll
    for (int k2 = 0; k2 < 2; ++k2) {
#pragma unroll
      for (int d = 0; d < DV / 16; ++d) {
        const u16* vp = Vts + (d * 16 + fr) * VSTR + k2 * 32 + fq * 4;
        const uint2 h0 = *reinterpret_cast<const uint2*>(vp);
        const uint2 h1 = *reinterpret_cast<const uint2*>(vp + 16);
        const bf16x8 vfv = __builtin_bit_cast(bf16x8, (u32x4{h0.x, h0.y, h1.x, h1.y}));
#pragma unroll
        for (int qb = 0; qb < NQB; ++qb) o[qb][d] = __builtin_amdgcn_mfma_f32_16x16x32_bf16(vfv, pf[qb][k2], o[qb][d], 0, 0, 0);
      }
    }
    __builtin_amdgcn_s_setprio(0);
  }
  DI float lsum(int qb) { float t = l[qb]; t += __shfl_xor(t, 16); t += __shfl_xor(t, 32); return t; }
};

DI void diff_attn_item(const PRef& p, int l, int b, int h, int qt) {
  extern __shared__ __attribute__((aligned(16))) u16 shm[];
  u16* Ks = shm;
  u16* Vts = shm + 2 * 64 * 72;
  float* comb = reinterpret_cast<float*>(shm + 2 * 64 * 72 + 128 * 72);
  const u16* qk = (const u16*)(p.ws + OFF_QK);
  const u16* vt = (const u16*)(p.ws + OFF_VT);
  u16* hcat = (u16*)(p.ws + OFF_HCAT);
  const int tid = ltid(), w = tid >> 6, lane = tid & 63, fr = lane & 15, fq = lane >> 4;
  const int n = w >> 2, qsub = w & 3;
  const int tok0 = b * SEQ + qt * 128;
  float lam;
  {
    float a1 = ((const float*)p.in[I_LQ1])[l * 64 + lane] * ((const float*)p.in[I_LK1])[l * 64 + lane];
    float a2 = ((const float*)p.in[I_LQ2])[l * 64 + lane] * ((const float*)p.in[I_LK2])[l * 64 + lane];
    a1 = wave_sum(a1); a2 = wave_sum(a2);
    lam = __expf(a1) - __expf(a2) + p.lam_init[l];
  }
  FlashWave<64, 128, 2> fw;
  fw.init();
#pragma unroll
  for (int qb = 0; qb < 2; ++qb)
#pragma unroll
    for (int ks = 0; ks < 2; ++ks)
    fw.qf[qb][ks] = *reinterpret_cast<const bf16x8*>(qk + (size_t)(tok0 + qsub * 32 + qb * 16 + fr) * 1024 + h * 128 + n * 64 + ks * 32 + fq * 8);
  const int nkt = 2 * qt + 2;
  const int my_last = 2 * qt + (qsub >> 1);
  uint4 kreg0, kreg1, vreg0, vreg1;
  const int seg0 = tid, seg1 = tid + 512;
  const u16* kbase0 = qk + (size_t)(b * SEQ + ((seg0 >> 3) & 63)) * 1024 + 512 + h * 128 + (seg0 >> 9) * 64 + (seg0 & 7) * 8;
  const u16* kbase1 = qk + (size_t)(b * SEQ + ((seg1 >> 3) & 63)) * 1024 + 512 + h * 128 + (seg1 >> 9) * 64 + (seg1 & 7) * 8;
  const u16* vbase0 = vt + (size_t)(h * 128 + (seg0 >> 3)) * NTOK + b * SEQ + (seg0 & 7) * 8;
  const u16* vbase1 = vt + (size_t)(h * 128 + (seg1 >> 3)) * NTOK + b * SEQ + (seg1 & 7) * 8;
  u16* kdst0 = Ks + ((seg0 >> 9) * 64 + ((seg0 >> 3) & 63)) * 72 + (seg0 & 7) * 8;
  u16* kdst1 = Ks + ((seg1 >> 9) * 64 + ((seg1 >> 3) & 63)) * 72 + (seg1 & 7) * 8;
  u16* vdst0 = Vts + (seg0 >> 3) * 72 + (seg0 & 7) * 8;
  u16* vdst1 = Vts + (seg1 >> 3) * 72 + (seg1 & 7) * 8;
#define load_tile(kt) do { \
    kreg0 = *reinterpret_cast<const uint4*>(kbase0 + (size_t)(kt) * 64 * 1024); \
    kreg1 = *reinterpret_cast<const uint4*>(kbase1 + (size_t)(kt) * 64 * 1024); \
    vreg0 = *reinterpret_cast<const uint4*>(vbase0 + (kt) * 64); \
    vreg1 = *reinterpret_cast<const uint4*>(vbase1 + (kt) * 64); } while (0)
#define store_tile() do { \
    *reinterpret_cast<uint4*>(kdst0) = kreg0; *reinterpret_cast<uint4*>(kdst1) = kreg1; \
    *reinterpret_cast<uint4*>(vdst0) = vreg0; *reinterpret_cast<uint4*>(vdst1) = vreg1; } while (0)
  load_tile(0);
  for (int kt = 0; kt < nkt; ++kt) {
    __syncthreads();
    store_tile();
    __syncthreads();
    if (kt + 1 < nkt) load_tile(kt + 1);
    if (kt <= my_last) fw.tile(Ks + n * 64 * 72, Vts);
  }
  float inv[2];
#pragma unroll
  for (int qb = 0; qb < 2; ++qb) inv[qb] = 1.f / fw.lsum(qb);
  __syncthreads();
  if (n == 1) {
#pragma unroll
    for (int qb = 0; qb < 2; ++qb)
#pragma unroll
      for (int d = 0; d < 8; ++d) {
      float4 v; v.x = fw.o[qb][d][0] * inv[qb]; v.y = fw.o[qb][d][1] * inv[qb]; v.z = fw.o[qb][d][2] * inv[qb]; v.w = fw.o[qb][d][3] * inv[qb];
      *reinterpret_cast<float4*>(&comb[(qsub * 32 + qb * 16 + fr) * 132 + d * 16 + fq * 4]) = v;
    }
  }
  __syncthreads();
  if (n == 0) {
    const float* sg = (const float*)p.in[I_SUBLN] + l * 128;
    const float post = 1.f - p.lam_init[l];
#pragma unroll
    for (int qb = 0; qb < 2; ++qb) {
      float ss = 0.f;
#pragma unroll
      for (int d = 0; d < 8; ++d) {
        float4 c2 = *reinterpret_cast<const float4*>(&comb[(qsub * 32 + qb * 16 + fr) * 132 + d * 16 + fq * 4]);
        fw.o[qb][d][0] = fw.o[qb][d][0] * inv[qb] - lam * c2.x;
        fw.o[qb][d][1] = fw.o[qb][d][1] * inv[qb] - lam * c2.y;
        fw.o[qb][d][2] = fw.o[qb][d][2] * inv[qb] - lam * c2.z;
        fw.o[qb][d][3] = fw.o[qb][d][3] * inv[qb] - lam * c2.w;
        for (int j = 0; j < 4; ++j) ss += fw.o[qb][d][j] * fw.o[qb][d][j];
      }
      ss += __shfl_xor(ss, 16); ss += __shfl_xor(ss, 32);
      const float rms = rsqrtf(ss * (1.f / 128.f) + 1e-6f) * post;
      u16* op = hcat + (size_t)(tok0 + qsub * 32 + qb * 16 + fr) * 1024 + h * 128;
#pragma unroll
      for (int d = 0; d < 8; ++d) {
        const int dv = d * 16 + fq * 4;
        uint2 ov;
        ov.x = pack2(fw.o[qb][d][0] * rms * sg[dv], fw.o[qb][d][1] * rms * sg[dv + 1]);
        ov.y = pack2(fw.o[qb][d][2] * rms * sg[dv + 2], fw.o[qb][d][3] * rms * sg[dv + 3]);
        *reinterpret_cast<uint2*>(op + dv) = ov;
      }
    }
  }
  __syncthreads();
}

#undef load_tile
#undef store_tile
DI void cross_attn_item(const PRef& p, int tokblk, int h) {
  extern __shared__ __attribute__((aligned(16))) u16 shm[];
  u16* Ks = shm;
  u16* Vts = shm + 64 * 264;
  const u16* qc = (const u16*)(p.ws + OFF_QC);
  const u16* km = (const u16*)(p.ws + OFF_KMEM);
  const u16* vm = (const u16*)(p.ws + OFF_VMEMT);
  u16* oc = (u16*)(p.ws + OFF_OC);
  const int tid = ltid(), w = tid >> 6, lane = tid & 63, fr = lane & 15, fq = lane >> 4;
  const int tok0 = tokblk * 128, b = tok0 >> 12;
  FlashWave<256, 256, 1> fw;
  fw.init();
#pragma unroll
  for (int ks = 0; ks < 8; ++ks)
    fw.qf[0][ks] = *reinterpret_cast<const bf16x8*>(qc + (size_t)(tok0 + w * 16 + fr) * 1024 + h * 256 + ks * 32 + fq * 8);
  uint4 kreg0, kreg1, kreg2, kreg3, vreg0, vreg1, vreg2, vreg3;
  const u16* kbase = km + (size_t)(b * 256 + (tid >> 5)) * 1024 + h * 256 + (tid & 31) * 8;
  const u16* vbase = vm + (size_t)(h * 256 + (tid >> 3)) * 2048 + b * 256 + (tid & 7) * 8;
  u16* kdst = Ks + (tid >> 5) * 264 + (tid & 31) * 8;
  u16* vdst = Vts + (tid >> 3) * 72 + (tid & 7) * 8;
#define load_tile(kt) do { \
    kreg0 = *reinterpret_cast<const uint4*>(kbase + (size_t)((kt) * 64 + 0) * 1024); \
    kreg1 = *reinterpret_cast<const uint4*>(kbase + (size_t)((kt) * 64 + 16) * 1024); \
    kreg2 = *reinterpret_cast<const uint4*>(kbase + (size_t)((kt) * 64 + 32) * 1024); \
    kreg3 = *reinterpret_cast<const uint4*>(kbase + (size_t)((kt) * 64 + 48) * 1024); \
    vreg0 = *reinterpret_cast<const uint4*>(vbase + (size_t)0 * 2048 + (kt) * 64); \
    vreg1 = *reinterpret_cast<const uint4*>(vbase + (size_t)64 * 2048 + (kt) * 64); \
    vreg2 = *reinterpret_cast<const uint4*>(vbase + (size_t)128 * 2048 + (kt) * 64); \
    vreg3 = *reinterpret_cast<const uint4*>(vbase + (size_t)192 * 2048 + (kt) * 64); } while (0)
#define store_tile() do { \
    *reinterpret_cast<uint4*>(kdst) = kreg0; *reinterpret_cast<uint4*>(kdst + 16 * 264) = kreg1; \
    *reinterpret_cast<uint4*>(kdst + 32 * 264) = kreg2; *reinterpret_cast<uint4*>(kdst + 48 * 264) = kreg3; \
    *reinterpret_cast<uint4*>(vdst) = vreg0; *reinterpret_cast<uint4*>(vdst + 64 * 72) = vreg1; \
    *reinterpret_cast<uint4*>(vdst + 128 * 72) = vreg2; *reinterpret_cast<uint4*>(vdst + 192 * 72) = vreg3; } while (0)
  load_tile(0);
  for (int kt = 0; kt < 4; ++kt) {
    __syncthreads();
    store_tile();
    __syncthreads();
    if (kt + 1 < 4) load_tile(kt + 1);
    fw.tile(Ks, Vts);
  }
  const float inv = 1.f / fw.lsum(0);
  u16* op = oc + (size_t)(tok0 + w * 16 + fr) * 1024 + h * 256;
#pragma unroll
  for (int d = 0; d < 16; ++d) {
    uint2 ov;
    ov.x = pack2(fw.o[0][d][0] * inv, fw.o[0][d][1] * inv);
    ov.y = pack2(fw.o[0][d][2] * inv, fw.o[0][d][3] * inv);
    *reinterpret_cast<uint2*>(op + d * 16 + fq * 4) = ov;
  }
  __syncthreads();
}

#undef load_tile
#undef store_tile
DI float row8_sum(float x) {
  x += dpp_f<0xB1>(x);
  x += dpp_f<0x4E>(x);
  x += dpp_f<0x141>(x);
  return x;
}
DI f32v2 bfpair(unsigned q) { f32v2 r; r.x = __uint_as_float(q << 16); r.y = __uint_as_float(q & 0xffff0000u); return r; }

DI void rwkv_scan_item(const PRef& p, int b, int h, int half) {
  extern __shared__ __attribute__((aligned(16))) u16 shm[];
  char* buf = reinterpret_cast<char*>(shm);
  float* ybuf = reinterpret_cast<float*>(buf + 2 * 16 * 1152);
  float* dummy = ybuf + 1024;
  const char* rec = p.ws + OFF_REC + (size_t)((b * 4 + h) * SEQ) * 1152;
  float* Y = (float*)(p.ws + OFF_Y);
  const int tid = ltid(), w = tid >> 6, lane = tid & 63;
  const int rl = (w & 3) * 8 + (lane >> 3);
  const int row = half * 32 + rl;
  const int ks = (lane & 7) * 8;
  const bool compute = w < 4;
  const bool leader = (lane & 7) == 0;
  float* ydst0 = leader ? (ybuf + rl) : (dummy + (tid & 255));
  const int ystride = leader ? 32 : 0;
  f32v2 S01 = {0.f, 0.f}, S23 = {0.f, 0.f}, S45 = {0.f, 0.f}, S67 = {0.f, 0.f};
  uint4 rg0, rg1, rg2 = make_uint4(0, 0, 0, 0);
  auto load_chunk = [&](int ch) {
    const uint4* src = reinterpret_cast<const uint4*>(rec + (size_t)ch * 16 * 1152);
    rg0 = src[tid]; rg1 = src[tid + 512];
    if (tid < 128) rg2 = src[tid + 1024];
  };
  load_chunk(0);
  __syncthreads();
  for (int ch = 0; ch < SEQ / 16; ++ch) {
    char* cb = buf + (ch & 1) * 16 * 1152;
    {
      uint4* dst = reinterpret_cast<uint4*>(cb);
      dst[tid] = rg0; dst[tid + 512] = rg1;
      if (tid < 128) dst[tid + 1024] = rg2;
    }
    __syncthreads();
    if (ch + 1 < SEQ / 16) load_chunk(ch + 1);
    if (ch > 0) {
      const float* ybp = ybuf + ((ch - 1) & 1) * 512;
      const int st = tid >> 5, r = tid & 31;
      Y[(size_t)(b * SEQ + (ch - 1) * 16 + st) * 256 + h * 64 + half * 32 + r] = ybp[tid];
    }
    if (compute) {
      float* yd = ydst0 + (leader ? (ch & 1) * 512 : 0);
      const char* sp = cb;
      float4 wa = *reinterpret_cast<const float4*>(sp + ks * 4), wb = *reinterpret_cast<const float4*>(sp + ks * 4 + 16);
      float4 ka = *reinterpret_cast<const float4*>(sp + 256 + ks * 4), kb = *reinterpret_cast<const float4*>(sp + 256 + ks * 4 + 16);
      float4 ba = *reinterpret_cast<const float4*>(sp + 512 + ks * 4), bbv = *reinterpret_cast<const float4*>(sp + 512 + ks * 4 + 16);
      uint4 kq = *reinterpret_cast<const uint4*>(sp + 768 + ks * 2);
      uint4 rq = *reinterpret_cast<const uint4*>(sp + 896 + ks * 2);
      unsigned vq = *reinterpret_cast<const u16*>(sp + 1024 + row * 2);
#pragma unroll
      for (int st = 0; st < 16; ++st) {
        float4 wan, wbn, kan, kbn, ban, bbn; uint4 kqn, rqn; unsigned vqn;
        if (st < 15) {
          const char* sn = cb + (st + 1) * 1152;
          wan = *reinterpret_cast<const float4*>(sn + ks * 4); wbn = *reinterpret_cast<const float4*>(sn + ks * 4 + 16);
          kan = *reinterpret_cast<const float4*>(sn + 256 + ks * 4); kbn = *reinterpret_cast<const float4*>(sn + 256 + ks * 4 + 16);
          ban = *reinterpret_cast<const float4*>(sn + 512 + ks * 4); bbn = *reinterpret_cast<const float4*>(sn + 512 + ks * 4 + 16);
          kqn = *reinterpret_cast<const uint4*>(sn + 768 + ks * 2);
          rqn = *reinterpret_cast<const uint4*>(sn + 896 + ks * 2);
          vqn = *reinterpret_cast<const u16*>(sn + 1024 + row * 2);
        }
        const float v = __uint_as_float(vq << 16);
        const f32v2 vv = {v, v};
        const f32v2 kk01 = {ka.x, ka.y}, kk23 = {ka.z, ka.w}, kk45 = {kb.x, kb.y}, kk67 = {kb.z, kb.w};
        f32v2 sa2 = S01 * kk01 + S23 * kk23;
        f32v2 sb2 = S45 * kk45 + S67 * kk67;
        sa2 += sb2;
        float sa = row8_sum(sa2.x + sa2.y);
        const f32v2 sav = {sa, sa};
        S01 = S01 * f32v2{wa.x, wa.y} - sav * f32v2{ba.x, ba.y} + vv * bfpair(kq.x);
        S23 = S23 * f32v2{wa.z, wa.w} - sav * f32v2{ba.z, ba.w} + vv * bfpair(kq.y);
        S45 = S45 * f32v2{wb.x, wb.y} - sav * f32v2{bbv.x, bbv.y} + vv * bfpair(kq.z);
        S67 = S67 * f32v2{wb.z, wb.w} - sav * f32v2{bbv.z, bbv.w} + vv * bfpair(kq.w);
        f32v2 ya = S01 * bfpair(rq.x) + S23 * bfpair(rq.y);
        f32v2 yb2 = S45 * bfpair(rq.z) + S67 * bfpair(rq.w);
        ya += yb2;
        float y = row8_sum(ya.x + ya.y);
        yd[st * ystride] = y;
        if (st < 15) { wa = wan; wb = wbn; ka = kan; kb = kbn; ba = ban; bbv = bbn; kq = kqn; rq = rqn; vq = vqn; }
      }
    }
  }
  __syncthreads();
  {
    const int ch = SEQ / 16 - 1;
    const float* ybp = ybuf + (ch & 1) * 512;
    const int st = tid >> 5, r = tid & 31;
    Y[(size_t)(b * SEQ + ch * 16 + st) * 256 + h * 64 + half * 32 + r] = ybp[tid];
  }
  __syncthreads();
}

DI float gelu_tanh(float x) {
  float u = 0.7978845608028654f * (x + 0.044715f * x * x * x);
  return 0.5f * x * (1.f + tanhf(u));
}
DI void s5_item(const PRef& p, int l, int b, int g) {
  extern __shared__ __attribute__((aligned(16))) u16 shm[];
  float* uL = reinterpret_cast<float*>(shm);
  float* fin = uL + 8 * 256;
  float* xL = fin + 8 * 128;
  const u16* s5 = (const u16*)(p.ws + OFF_S5);
  u16* Z = (u16*)(p.ws + OFF_Z);
  const int tid = ltid(), w = tid >> 6, lane = tid & 63;
  const float Are = ((const float*)p.in[I_SARE])[(l * 16 + g) * 64 + lane];
  const float Aim = ((const float*)p.in[I_SAIM])[(l * 16 + g) * 64 + lane];
  const float delta = expf(((const float*)p.in[I_SLOG])[l * 16 + g]);
  float cr, ci;
  {
    float er = expf(delta * Are); float sn, cs; sincosf(delta * Aim, &sn, &cs);
    cr = er * cs; ci = er * sn;
  }
  float Bre[16], Bim[16];
  {
    const float x = cr - 1.f, y = ci, den = 1.f / (Are * Are + Aim * Aim);
    const float qre = (x * Are + y * Aim) * den, qim = (y * Are - x * Aim) * den;
    const float* bre = (const float*)p.in[I_SBRE] + ((size_t)(l * 16 + g) * 64 + lane) * 16;
    const float* bim = (const float*)p.in[I_SBIM] + ((size_t)(l * 16 + g) * 64 + lane) * 16;
#pragma unroll
    for (int hh = 0; hh < 16; ++hh) { float br = bre[hh], bi = bim[hh]; Bre[hh] = qre * br - qim * bi; Bim[hh] = qre * bi + qim * br; }
  }
  __syncthreads();
  bf16x8 cf[4];
  {
    const int hq = lane & 15, q4 = lane >> 4;
    const float* cre = (const float*)p.in[I_SCRE] + ((size_t)(l * 16 + g) * 16 + hq) * 64;
    const float* cim = (const float*)p.in[I_SCIM] + ((size_t)(l * 16 + g) * 16 + hq) * 64;
#pragma unroll
    for (int s4 = 0; s4 < 4; ++s4) {
      const float4 re = *reinterpret_cast<const float4*>(cre + 16 * s4 + 4 * q4);
      const float4 im = *reinterpret_cast<const float4*>(cim + 16 * s4 + 4 * q4);
      cf[s4] = __builtin_bit_cast(bf16x8, (u32x4{pack2(re.x, -im.x), pack2(re.y, -im.y), pack2(re.z, -im.z), pack2(re.w, -im.w)}));
    }
  }
  const int tbase = b * SEQ + w * 512;
  float* uw = uL + w * 256;
  auto load_u = [&](int ch) {
    const int tt = lane >> 2, c4 = (lane & 3) * 4;
    uint2 raw = *reinterpret_cast<const uint2*>(s5 + (size_t)(tbase + ch * 16 + tt) * 256 + g * 16 + c4);
    float4 f; f.x = __uint_as_float(raw.x << 16); f.y = __uint_as_float(raw.x & 0xffff0000u);
    f.z = __uint_as_float(raw.y << 16); f.w = __uint_as_float(raw.y & 0xffff0000u);
    *reinterpret_cast<float4*>(uw + tt * 16 + c4) = f;
  };
  float xr = 0.f, xi = 0.f;
  for (int ch = 0; ch < 32; ++ch) {
    __syncthreads();
    load_u(ch);
    __syncthreads();
#pragma unroll 4
    for (int tt = 0; tt < 16; ++tt) {
      float bur = 0.f, bui = 0.f;
#pragma unroll
      for (int h4 = 0; h4 < 4; ++h4) {
        float4 u = *reinterpret_cast<const float4*>(uw + tt * 16 + h4 * 4);
        bur += Bre[h4 * 4] * u.x + Bre[h4 * 4 + 1] * u.y + Bre[h4 * 4 + 2] * u.z + Bre[h4 * 4 + 3] * u.w;
        bui += Bim[h4 * 4] * u.x + Bim[h4 * 4 + 1] * u.y + Bim[h4 * 4 + 2] * u.z + Bim[h4 * 4 + 3] * u.w;
      }
      float nr = cr * xr - ci * xi + bur, ni = cr * xi + ci * xr + bui;
      xr = nr; xi = ni;
    }
  }
  fin[(w * 64 + lane) * 2] = xr; fin[(w * 64 + lane) * 2 + 1] = xi;
  __syncthreads();
  {
    float pr = cr, pi = ci;
    for (int i = 0; i < 9; ++i) { float nr = pr * pr - pi * pi, ni = 2.f * pr * pi; pr = nr; pi = ni; }
    float vr = 0.f, vi = 0.f;
    for (int ww = 0; ww < w; ++ww) {
      float fr_ = fin[(ww * 64 + lane) * 2], fi_ = fin[(ww * 64 + lane) * 2 + 1];
      float nr = pr * vr - pi * vi + fr_, ni = pr * vi + pi * vr + fi_;
      vr = nr; vi = ni;
    }
    xr = vr; xi = vi;
  }
  float* xw = xL + w * (16 * 66 * 2);
  const int ot = lane & 15, oh = (lane >> 4) * 4;
  const float* dsk = (const float*)p.in[I_SD] + l * 256 + g * 16 + oh;
  const float d0 = dsk[0], d1 = dsk[1], d2 = dsk[2], d3 = dsk[3];
  for (int ch = 0; ch < 32; ++ch) {
    __syncthreads();
    load_u(ch);
    __syncthreads();
#pragma unroll 4
    for (int tt = 0; tt < 16; ++tt) {
      float bur = 0.f, bui = 0.f;
#pragma unroll
      for (int h4 = 0; h4 < 4; ++h4) {
        float4 u = *reinterpret_cast<const float4*>(uw + tt * 16 + h4 * 4);
        bur += Bre[h4 * 4] * u.x + Bre[h4 * 4 + 1] * u.y + Bre[h4 * 4 + 2] * u.z + Bre[h4 * 4 + 3] * u.w;
        bui += Bim[h4 * 4] * u.x + Bim[h4 * 4 + 1] * u.y + Bim[h4 * 4 + 2] * u.z + Bim[h4 * 4 + 3] * u.w;
      }
      float nr = cr * xr - ci * xi + bur, ni = cr * xi + ci * xr + bui;
      xr = nr; xi = ni;
      *reinterpret_cast<float2*>(xw + (tt * 66 + lane) * 2) = make_float2(xr, xi);
    }
    __syncthreads();
    f32x4 yacc = f32x4{0.f, 0.f, 0.f, 0.f};
#pragma unroll
    for (int s4 = 0; s4 < 4; ++s4) {
      const float* xp = xw + (ot * 66 + 16 * s4 + oh) * 2;
      const float4 f0 = *reinterpret_cast<const float4*>(xp), f1 = *reinterpret_cast<const float4*>(xp + 4);
      const bf16x8 xf = __builtin_bit_cast(bf16x8, (u32x4{pack2(f0.x, f0.y), pack2(f0.z, f0.w), pack2(f1.x, f1.y), pack2(f1.z, f1.w)}));
      yacc = __builtin_amdgcn_mfma_f32_16x16x32_bf16(cf[s4], xf, yacc, 0, 0, 0);
    }
    float a0 = yacc[0], a1 = yacc[1], a2 = yacc[2], a3 = yacc[3];
    float4 u = *reinterpret_cast<const float4*>(uw + ot * 16 + oh);
    a0 = gelu_tanh(a0 + d0 * u.x); a1 = gelu_tanh(a1 + d1 * u.y); a2 = gelu_tanh(a2 + d2 * u.z); a3 = gelu_tanh(a3 + d3 * u.w);
    uint2 ov; ov.x = pack2(a0, a1); ov.y = pack2(a2, a3);
    *reinterpret_cast<uint2*>(Z + (size_t)(tbase + ch * 16 + ot) * 256 + g * 16 + oh) = ov;
  }
  __syncthreads();
}

DI void phase_mixers(const PRef& p, int lc) {
  __shared__ int s_item;
  unsigned* cnt = (unsigned*)(p.ws + OFF_CNT) + lc;
  const int l = lc & 7;
  const int total = 64 + 128 + 1024;
  while (true) {
    __syncthreads();
    if (ltid() == 0) s_item = (int)atomicAdd(cnt, 1u);
    __syncthreads();
    const int item = s_item;
    if (item >= total) break;
    kaptr_t ka2 = p.in.ka; asm volatile("" : "+s"(ka2)); const PRef q(ka2);
    const int cls = (lc >= 8) ? (PROBE_DUP >> 4) : 7;
    if (item < 64) { if (cls & 1) rwkv_scan_item(q, item >> 3, (item >> 1) & 3, item & 1); }
    else if (item < 192) { int i = item - 64; if (cls & 2) s5_item(q, l, i >> 4, i & 15); }
    else { int i = item - 192; int qt = 31 - (i >> 5); int bh = i & 31; if (cls & 4) diff_attn_item(q, l, bh >> 2, bh & 3, qt); }
  }
}

DI void phase_post(const PRef& p, int l) {
  const float* Y = (const float*)(p.ws + OFF_Y);
  const u16* gbuf = (const u16*)(p.ws + OFF_G);
  const u16* Z = (const u16*)(p.ws + OFF_Z);
  const float* bonus = (const float*)(p.ws + OFF_BONUS);
  const char* rec = p.ws + OFF_REC;
  u16* hcat = (u16*)(p.ws + OFF_HCAT);
  const u16* glut = (const u16*)(p.ws + OFF_WT + WT_GLU);
  const float* lng = (const float*)p.in[I_LNXG] + l * 256;
  const float* lnb = (const float*)p.in[I_LNXB] + l * 256;
  const float* glub = (const float*)p.in[I_GLUB] + l * 256;
  const float* outg = (const float*)p.in[I_SOUTG] + l * 256;
  const int tid = ltid(), w = tid >> 6, lane = tid & 63, fr = lane & 15, fq = lane >> 4;
  extern __shared__ __attribute__((aligned(16))) u16 shm[];
  {
    const uint4* g4 = reinterpret_cast<const uint4*>(glut);
    uint4* l4 = reinterpret_cast<uint4*>(shm);
#pragma unroll 4
    for (int i = 0; i < 16; ++i) {
      const int idx = tid + i * 512, row = idx >> 5, ch = idx & 31;
      l4[row * 32 + (ch ^ (row & 15))] = g4[idx];
    }
  }
  __syncthreads();
  for (int item = blockIdx.x; item < NTOK / 128; item += gridDim.x) {
    const int tk0 = item * 128;
    {
      const int c = tid & 255, half = tid >> 8, h = c >> 6, cc = c & 63;
      const float gw = lng[c], gb = lnb[c];
      for (int i0 = 0; i0 < 64; i0 += 8) {
        float yv[8], vv[8], gq[8], bo[8];
#pragma unroll
        for (int u = 0; u < 8; ++u) {
          const int tok = tk0 + half * 64 + i0 + u;
          const int b = tok >> 12, t = tok & (SEQ - 1);
          const char* rp = rec + ((size_t)((b * 4 + h) * SEQ + t)) * 1152;
          yv[u] = Y[(size_t)tok * 256 + c];
          vv[u] = bf2f(reinterpret_cast<const u16*>(rp + 1024)[cc]);
          gq[u] = bf2f(gbuf[(size_t)tok * 256 + c]);
          bo[u] = bonus[(size_t)tok * 4 + h];
        }
        float mean[8], var[8];
#pragma unroll
        for (int u = 0; u < 8; ++u) { float t = row16_sum(yv[u]); t += __shfl_xor(t, 16); t += __shfl_xor(t, 32); mean[u] = t * (1.f / 64.f); }
#pragma unroll
        for (int u = 0; u < 8; ++u) { float d = yv[u] - mean[u]; float t = row16_sum(d * d); t += __shfl_xor(t, 16); t += __shfl_xor(t, 32); var[u] = t * (1.f / 64.f); }
#pragma unroll
        for (int u = 0; u < 8; ++u) {
          const int tok = tk0 + half * 64 + i0 + u;
          float out = (yv[u] - mean[u]) * rsqrtf(var[u] + 64e-5f) * gw + gb + bo[u] * vv[u];
          out *= gq[u];
          hcat[(size_t)tok * 1024 + 512 + c] = f2bf(out);
        }
      }
    }
    {
      const int tokw = tk0 + w * 16;
      bf16x8 zf[8];
#pragma unroll
      for (int s = 0; s < 8; ++s) zf[s] = *reinterpret_cast<const bf16x8*>(Z + (size_t)(tokw + fr) * 256 + s * 32 + fq * 8);
      float ss = 0.f, rms = 0.f;
      for (int pass = 0; pass < 2; ++pass) {
#pragma unroll 2
        for (int nb = 0; nb < 16; ++nb) {
          f32x4 acc = f32x4{0.f, 0.f, 0.f, 0.f};
#pragma unroll
          for (int s = 0; s < 8; ++s) {
            bf16x8 wf = *reinterpret_cast<const bf16x8*>(shm + ((nb * 16 + fr) * 32 + ((s * 4 + fq) ^ fr)) * 8);
            acc = __builtin_amdgcn_mfma_f32_16x16x32_bf16(wf, zf[s], acc, 0, 0, 0);
          }
          const int col = nb * 16 + fq * 4;
          uint2 zr = *reinterpret_cast<const uint2*>(Z + (size_t)(tokw + fr) * 256 + col);
          float z0 = __uint_as_float(zr.x << 16), z1 = __uint_as_float(zr.x & 0xffff0000u);
          float z2 = __uint_as_float(zr.y << 16), z3 = __uint_as_float(zr.y & 0xffff0000u);
          float o0 = z0 * sigmoidf_(acc[0] + glub[col]), o1 = z1 * sigmoidf_(acc[1] + glub[col + 1]);
          float o2 = z2 * sigmoidf_(acc[2] + glub[col + 2]), o3 = z3 * sigmoidf_(acc[3] + glub[col + 3]);
          if (pass == 0) ss += o0 * o0 + o1 * o1 + o2 * o2 + o3 * o3;
          else {
            uint2 ov;
            ov.x = pack2(o0 * rms * outg[col], o1 * rms * outg[col + 1]);
            ov.y = pack2(o2 * rms * outg[col + 2], o3 * rms * outg[col + 3]);
            *reinterpret_cast<uint2*>(hcat + (size_t)(tokw + fr) * 1024 + 768 + col) = ov;
          }
        }
        if (pass == 0) { ss += __shfl_xor(ss, 16); ss += __shfl_xor(ss, 32); rms = rsqrtf(ss * (1.f / 256.f) + 1e-6f); }
      }
    }
  }
}

DI void phase_ln(const PRef& p, const float* g, const float* bta) {
  float* xs = p.xs; u16* xb = (u16*)(p.ws + OFF_XB);
  const int w = ltid() >> 6, lane = ltid() & 63;
  for (int tok = blockIdx.x * 8 + w; tok < NTOK; tok += gridDim.x * 8) {
    float4* row = reinterpret_cast<float4*>(xs + (size_t)tok * DM);
    float4 v[4]; float s = 0.f;
    for (int i = 0; i < 4; ++i) { v[i] = row[lane + i * 64]; s += v[i].x + v[i].y + v[i].z + v[i].w; }
    const float mean = wave_sum(s) * (1.f / 1024.f);
    float q = 0.f;
    for (int i = 0; i < 4; ++i) { float a = v[i].x - mean, b = v[i].y - mean, c = v[i].z - mean, d = v[i].w - mean; q += a * a + b * b + c * c + d * d; }
    const float rstd = rsqrtf(wave_sum(q) * (1.f / 1024.f) + 1e-5f);
    for (int i = 0; i < 4; ++i) {
      const int col = (lane + i * 64) * 4;
      float4 gg = *reinterpret_cast<const float4*>(g + col), bb = *reinterpret_cast<const float4*>(bta + col);
      float4 o;
      o.x = (v[i].x - mean) * rstd * gg.x + bb.x; o.y = (v[i].y - mean) * rstd * gg.y + bb.y;
      o.z = (v[i].z - mean) * rstd * gg.z + bb.z; o.w = (v[i].w - mean) * rstd * gg.w + bb.w;
      row[lane + i * 64] = o;
      uint2 ob; ob.x = pack2(o.x, o.y); ob.y = pack2(o.z, o.w);
      *reinterpret_cast<uint2*>(xb + (size_t)tok * DM + col) = ob;
    }
  }
}

DI void phase_conv(const PRef& p, int l) {
  char* ws = p.ws;
  u16* hmid = (u16*)(ws + OFF_AG);
  const float* af = (const float*)(ws + OFF_AF); const float* gf = (const float*)(ws + OFF_GF); const float* al = (const float*)(ws + OFF_AL);
  const float* cw = (const float*)p.in[I_CONVW] + (size_t)l * 3 * DFF;
  const float* cb = (const float*)p.in[I_CONVB] + (size_t)l * DFF;
  for (int it = blockIdx.x * 512 + ltid(); it < 128 * DFF; it += gridDim.x * 512) {
    const int pm = it / DFF, c = it % DFF;
    const float a0 = af[(size_t)(pm * 2) * DFF + c], a1 = af[(size_t)(pm * 2 + 1) * DFF + c];
    const float g0 = gf[(size_t)(pm * 2) * DFF + c], g1 = gf[(size_t)(pm * 2 + 1) * DFF + c];
    float l0 = 0.f, l1 = 0.f;
    if ((pm & 15) != 0) { l0 = al[(size_t)((pm - 1) * 2) * DFF + c]; l1 = al[(size_t)((pm - 1) * 2 + 1) * DFF + c]; }
    const float w0 = cw[c], w1 = cw[DFF + c], w2 = cw[2 * DFF + c], bs = cb[c];
    const float cv0 = bs + w0 * l0 + w1 * l1 + w2 * a0;
    const float cv1 = bs + w0 * l1 + w1 * a0 + w2 * a1;
    hmid[(size_t)(pm * 256) * DFF + c] = f2bf(cv0 * sigmoidf_(cv0) * g0);
    hmid[(size_t)(pm * 256 + 1) * DFF + c] = f2bf(cv1 * sigmoidf_(cv1) * g1);
  }
}

DI void phase_gemm(const PRef& p, int kind, int l) {
  int nN = 4, K = 1024, lda = 1024, ldb = 1024;
  if (kind == 0) nN = 9;
  if (kind == 10) nN = 22;
  if (kind == 12) { lda = 2816; ldb = 2816; K = 2816; }
  const int ntile = 128 * nN;
  const bool remap = (gridDim.x & 7) == 0;
  const int per = remap ? (ntile >> 3) : ntile, xcd = blockIdx.x & 7;
  const int slot = remap ? (int)(blockIdx.x >> 3) : (int)blockIdx.x, nslot = remap ? (int)(gridDim.x >> 3) : (int)gridDim.x;
  const int n_main = (slot < per) ? (per - slot + nslot - 1) / nslot : 0;
  const int t0x = remap ? (int)((((blockIdx.x >> 3) + 16) & 31) * 8 + (blockIdx.x & 7)) : (int)blockIdx.x;
  const int n_extra = (kind == 0 && t0x < 320) ? (320 - t0x + (int)gridDim.x - 1) / (int)gridDim.x : 0;
  const kaptr_t ka = p.in.ka;
  auto tile_fn = [&](int idx) -> TileDesc {
    const PRef q(ka);
    char* ws = q.ws; char* wt = ws + OFF_WT;
    const u16* xb = (const u16*)(ws + OFF_XB);
    TileDesc d; d.sub = 0; d.A = xb;
    if (idx < n_main) {
      const int jj = slot + idx * nslot;
      const int t = remap ? xcd * per + jj : jj;
      int pm = t / nN, pn = t % nN;
      if (kind == 0) { d.B = (const u16*)(wt + WT_IN); pn = (pn < 4) ? pn : pn + 2; }
      else if (kind == 4) { d.A = (const u16*)(ws + OFF_HCAT); d.B = (const u16*)(wt + WT_OUT); }
      else if (kind == 6) d.B = (const u16*)(wt + WT_Q);
      else if (kind == 8) { d.A = (const u16*)(ws + OFF_OC); d.B = (const u16*)(wt + WT_O); }
      else if (kind == 10) d.B = (const u16*)(wt + WT_UP);
      else { d.A = (const u16*)(ws + OFF_AG); d.B = (const u16*)(wt + WT_DOWN); }
      d.brow = pm * 256; d.bcol = pn * 256;
    } else {
      const int t = t0x + (idx - n_main) * (int)gridDim.x;
      const u16* wint = (const u16*)(wt + WT_IN); const u16* wkvt = (const u16*)(wt + WT_KV); const u16* memb = (const u16*)(ws + OFF_MEMB);
      int pm, pn;
      if (t < 256) { pn = t >> 1; pm = t & 1; d.A = wint + (size_t)1024 * 1024; d.B = xb; d.sub = 1; }
      else if (t < 288) { int i = t - 256; pm = i >> 2; pn = i & 3; d.A = memb; d.B = wkvt; d.sub = 2; }
      else { int i = t - 288; pm = i >> 3; pn = i & 7; d.A = wkvt + (size_t)1024 * 1024; d.B = memb; d.sub = 3; }
      d.brow = pm * 256; d.bcol = pn * 256;
    }
    return d;
  };
  EpiGen e; e.kind = kind; e.lay = l; e.ka = ka;
  gemm_stream(n_main + n_extra, lda, ldb, K, tile_fn, e);
}
DI void phase_cross(const PRef& p) {
  for (int it = blockIdx.x; it < 1024; it += gridDim.x) cross_attn_item(p, it >> 2, it & 3);
}

constexpr int PH_PER_LAYER = 14, N_PHASES = 1 + DEPTH * PH_PER_LAYER;

DI void run_phase(const PRef& p, int ph) {
  if (ph == 0) { phase_init(p); phase_transposes(p, 0); return; }
  const int l = (ph - 1) / PH_PER_LAYER, s = (ph - 1) % PH_PER_LAYER;
  if (s == 0 || s == 4 || s == 6 || s == 8 || s == 10 || s == 12) {
    phase_gemm(p, s, l);
    if ((PROBE_DUP & 1) && (s == 0 || s == 6 || s == 10)) phase_gemm(p, s, l);
    return;
  }
  switch (s) {
    case 1: phase_prep(p, l); break;
    case 2: phase_mixers(p, l); if (PROBE_DUP & 2) phase_mixers(p, l + 8); break;
    case 3: phase_post(p, l); if (PROBE_DUP & 8) phase_post(p, l); break;
    case 5: phase_ln(p, (const float*)p.in[I_LN1G] + l * DM, (const float*)p.in[I_LN1B] + l * DM); break;
    case 7: phase_cross(p); if (PROBE_DUP & 4) phase_cross(p); break;
    case 9: phase_ln(p, (const float*)p.in[I_LN2G] + l * DM, (const float*)p.in[I_LN2B] + l * DM); break;
    case 11: phase_conv(p, l); break;
    case 13:
      phase_ln(p, (const float*)p.in[I_LN3G] + l * DM, (const float*)p.in[I_LN3B] + l * DM);
      if (l + 1 < DEPTH) phase_transposes(p, l + 1);
      break;
  }
}

template <int S>
__global__ void __launch_bounds__(512) ph_kernel(Params p_unused, int l) {
  kaptr_t ka = (kaptr_t)__builtin_amdgcn_kernarg_segment_ptr();
  const PRef p(ka);
  if (S < 0) { phase_init(p); phase_transposes(p, 0); return; }
  if (S == 0 || S == 4 || S == 6 || S == 8 || S == 10 || S == 12) { phase_gemm(p, S, l); return; }
  if (S == 1) phase_prep(p, l);
  if (S == 2) phase_mixers(p, l);
  if (S == 3) phase_post(p, l);
  if (S == 5) phase_ln(p, (const float*)p.in[I_LN1G] + l * DM, (const float*)p.in[I_LN1B] + l * DM);
  if (S == 7) phase_cross(p);
  if (S == 9) phase_ln(p, (const float*)p.in[I_LN2G] + l * DM, (const float*)p.in[I_LN2B] + l * DM);
  if (S == 11) phase_conv(p, l);
  if (S == 13) {
    phase_ln(p, (const float*)p.in[I_LN3G] + l * DM, (const float*)p.in[I_LN3B] + l * DM);
    if (l + 1 < DEPTH) phase_transposes(p, l + 1);
  }
}

#if !MULTI_LAUNCH
__device__ unsigned g_bar = 0;
#ifndef USE_COOP
#define USE_COOP 1
#endif

__global__ void __launch_bounds__(512) fwd_kernel(Params p_unused, int ph_begin_arg, int ph_end_arg) {
  constexpr int ph_begin = 0, ph_end = N_PHASES;
#if USE_COOP
  cg::this_grid().sync();
#endif
  __shared__ unsigned s_base;
  for (int ph = ph_begin; ph < ph_end; ++ph) {
    kaptr_t ka = (kaptr_t)__builtin_amdgcn_kernarg_segment_ptr();
    asm volatile("" : "+s"(ka));
    const PRef p(ka);
    run_phase(p, ph);
    if (ph + 1 < ph_end) {
      asm volatile("s_waitcnt vmcnt(0) lgkmcnt(0)" ::: "memory");
      __syncthreads();
      if (threadIdx.x == 0) {
        __builtin_amdgcn_fence(__ATOMIC_RELEASE, "agent");
        asm volatile("s_waitcnt vmcnt(0)" ::: "memory");
        const unsigned nbar = (unsigned)(ph - ph_begin + 1);
        unsigned old = __hip_atomic_fetch_add(&g_bar, 1u, __ATOMIC_RELAXED, __HIP_MEMORY_SCOPE_AGENT);
        if (nbar == 1) { const unsigned per_launch = (unsigned)(ph_end - ph_begin - 1) * gridDim.x; s_base = old - (old % per_launch); }
        const unsigned target = s_base + nbar * gridDim.x;
        while ((int)(__hip_atomic_load(&g_bar, __ATOMIC_RELAXED, __HIP_MEMORY_SCOPE_AGENT) - target) < 0) __builtin_amdgcn_s_sleep(4);
        __builtin_amdgcn_fence(__ATOMIC_ACQUIRE, "agent");
        asm volatile("s_waitcnt vmcnt(0)" ::: "memory");
      }
      __syncthreads();
    }
  }
}
#endif

constexpr size_t kDynLds = 131072 + 4096;

template <int S> static void launch_ph(const Params& p, int l, int grid, hipStream_t stream) {
  static bool attr_done = false;
  if (!attr_done) { (void)hipFuncSetAttribute((const void*)ph_kernel<S>, hipFuncAttributeMaxDynamicSharedMemorySize, (int)kDynLds); attr_done = true; }
  hipLaunchKernelGGL(ph_kernel<S>, dim3(grid), dim3(512), kDynLds, stream, p, l);
}

extern "C" void kernel_launch(void* const* d_in, const int* in_sizes, int n_in, void* d_out, int out_size, void* d_ws, size_t ws_size,
                              hipStream_t stream) {
  Params p;
  memset(&p, 0, sizeof(p));
  for (int i = 0; i < N_IN && i < n_in; ++i) p.in[i] = d_in[i];
  p.xs = (float*)d_out;
  p.ws = (char*)d_ws;
  for (int l = 0; l < 4; ++l) p.lam_init[l] = (float)(0.8 - 0.6 * exp(-0.3 * (double)l));
#if MULTI_LAUNCH
  const int grid = 256;
  launch_ph<-1>(p, 0, grid, stream);
  for (int l = 0; l < DEPTH; ++l) {
    launch_ph<0>(p, l, grid, stream); launch_ph<1>(p, l, grid, stream); launch_ph<2>(p, l, grid, stream); launch_ph<3>(p, l, grid, stream);
    launch_ph<4>(p, l, grid, stream); launch_ph<5>(p, l, grid, stream); launch_ph<6>(p, l, grid, stream); launch_ph<7>(p, l, grid, stream);
    launch_ph<8>(p, l, grid, stream); launch_ph<9>(p, l, grid, stream); launch_ph<10>(p, l, grid, stream); launch_ph<11>(p, l, grid, stream);
    launch_ph<12>(p, l, grid, stream); launch_ph<13>(p, l, grid, stream);
  }
#else
  static int grid_blocks = 0;
  if (!grid_blocks) {
    (void)hipFuncSetAttribute((const void*)fwd_kernel, hipFuncAttributeMaxDynamicSharedMemorySize, (int)kDynLds);
    int dev = 0, cus = 0, per_cu = 0;
    (void)hipGetDevice(&dev);
    (void)hipDeviceGetAttribute(&cus, hipDeviceAttributeMultiprocessorCount, dev);
    (void)hipOccupancyMaxActiveBlocksPerMultiprocessor(&per_cu, fwd_kernel, 512, kDynLds);
    if (per_cu < 1) per_cu = 1;
    grid_blocks = cus * per_cu;
    if (grid_blocks <= 0) grid_blocks = 256;
    if (per_cu > 1) grid_blocks = cus;
  }
  int b = 0, e = N_PHASES;
#if USE_COOP
  void* args[] = {&p, &b, &e};
  hipError_t err = hipLaunchCooperativeKernel((void*)fwd_kernel, dim3(grid_blocks), dim3(512), args, kDynLds, stream);
  if (err != hipSuccess) fprintf(stderr, "cooperative launch failed: %s (grid %d)\n", hipGetErrorString(err), grid_blocks);
#else
#ifdef BISECT_PER_PHASE
  for (int ph = 0; ph < N_PHASES; ++ph) hipLaunchKernelGGL(fwd_kernel, dim3(grid_blocks), dim3(512), kDynLds, stream, p, ph, ph + 1);
#else
  hipLaunchKernelGGL(fwd_kernel, dim3(grid_blocks), dim3(512), kDynLds, stream, p, b, e);
#endif
#endif
#endif
}
```

```cpp
#include <hip/hip_runtime.h>
#include <hip/hip_bf16.h>
#include <hip/hip_cooperative_groups.h>
#include <cstdio>
#include <cstring>
#include <cmath>
#include <cstddef>
namespace cg = cooperative_groups;

#ifndef PROBE_DUP
#define PROBE_DUP 0
#endif
#ifndef MULTI_LAUNCH
#define MULTI_LAUNCH 0
#endif

typedef unsigned short u16;
using bf16x8 = __attribute__((ext_vector_type(8))) short;
using f32x4 = __attribute__((ext_vector_type(4))) float;
using u32x4 = __attribute__((ext_vector_type(4))) unsigned;
#define DI __device__ __forceinline__

constexpr int NTOK = 32768, DM = 1024, SEQ = 4096, NBATCH = 8, DEPTH = 4;
constexpr int INW = 2688, DFF = 2816;
constexpr float ALPHA = 1.681792830507429f;
constexpr float LOG2E = 1.4426950408889634f;

enum { I_X = 0, I_MEM, I_POS, I_WIN, I_LQ1, I_LK1, I_LQ2, I_LK2, I_SUBLN, I_MU, I_W0, I_W2, I_A0, I_A2, I_G2, I_KK, I_KA, I_RK,
       I_LNXG, I_LNXB, I_SARE, I_SAIM, I_SBRE, I_SBIM, I_SCRE, I_SCIM, I_SD, I_SLOG, I_GLUW, I_GLUB, I_SOUTG, I_WOUT, I_LN1G, I_LN1B,
       I_WQ, I_WKV, I_WO, I_LN2G, I_LN2B, I_WUP, I_CONVW, I_CONVB, I_WDOWN, I_LN3G, I_LN3B, N_IN };

constexpr size_t MiB = 1024 * 1024;
constexpr size_t OFF_XB = 0;
constexpr size_t OFF_Y = 0, OFF_G = 32 * MiB, OFF_Z = 48 * MiB;
constexpr size_t OFF_WT = 64 * MiB;
constexpr size_t WT_IN = 0, WT_OUT = WT_IN + 2816ul * 1024 * 2, WT_Q = WT_OUT + 2 * MiB, WT_KV = WT_Q + 2 * MiB, WT_O = WT_KV + 4 * MiB,
                 WT_UP = WT_O + 2 * MiB, WT_DOWN = WT_UP + 11 * MiB, WT_GLU = WT_DOWN + 2816ul * 1024 * 2,
                 WT_W2T = WT_GLU + 131072, WT_A2T = WT_W2T + 16384, WT_G2T = WT_A2T + 16384;
constexpr size_t OFF_KMEM = 97 * MiB;
constexpr size_t OFF_VMEMT = 101 * MiB;
constexpr size_t OFF_MEMB = 105 * MiB;
constexpr size_t OFF_ROPE = 109 * MiB;
constexpr size_t OFF_CNT = 117 * MiB;
constexpr size_t OFF_BONUS = 118 * MiB;
constexpr size_t OFF_DR = 120 * MiB;
constexpr size_t OFF_QK = OFF_DR;
constexpr size_t OFF_RW = OFF_DR + 64 * MiB;
constexpr size_t OFF_S5 = OFF_DR + 120 * MiB;
constexpr size_t OFF_VT = OFF_DR + 136 * MiB;
constexpr size_t OFF_HCAT = OFF_DR + 168 * MiB;
constexpr size_t OFF_REC = OFF_DR + 232 * MiB;
constexpr size_t OFF_QC = OFF_DR;
constexpr size_t OFF_OC = OFF_DR + 64 * MiB;
constexpr size_t OFF_AG = OFF_DR;
constexpr size_t OFF_AF = OFF_DR + 200 * MiB;
constexpr size_t OFF_GF = OFF_AF + 3 * MiB;
constexpr size_t OFF_AL = OFF_GF + 3 * MiB;

struct Params {
  const void* in[48];
  float* xs;
  char* ws;
  float lam_init[4];
  int pad[4];
};

typedef const char __attribute__((address_space(4)))* kaptr_t;
struct PRef {
  struct In { kaptr_t ka; DI const void* operator[](int i) const { return *(const void* const __attribute__((address_space(4)))*)(ka + i * 8); } } in;
  struct Xs { kaptr_t ka; DI operator float*() const { return *(float* const __attribute__((address_space(4)))*)(ka + 384); } } xs;
  struct Ws { kaptr_t ka; DI operator char*() const { return *(char* const __attribute__((address_space(4)))*)(ka + 392); } } ws;
  struct Lam { kaptr_t ka; DI float operator[](int i) const { return *(const float __attribute__((address_space(4)))*)(ka + 400 + i * 4); } } lam_init;
  DI explicit PRef(kaptr_t k) : in{k}, xs{k}, ws{k}, lam_init{k} {}
};
static_assert(offsetof(Params, xs) == 384 && offsetof(Params, ws) == 392 && offsetof(Params, lam_init) == 400, "layout");

DI int ltid() { int t = threadIdx.x; asm volatile("" : "+v"(t)); return t; }
typedef __bf16 bf16v2 __attribute__((ext_vector_type(2)));
typedef float f32v2 __attribute__((ext_vector_type(2)));
DI unsigned pack2(float a, float b) { f32v2 v = {a, b}; return __builtin_bit_cast(unsigned, __builtin_convertvector(v, bf16v2)); }
DI u16 f2bf(float x) { return (u16)(pack2(x, 0.f) & 0xffffu); }
DI float bf2f(u16 h) { return __uint_as_float(((unsigned)h) << 16); }
DI float sigmoidf_(float x) { return 1.f / (1.f + __expf(-x)); }
DI float wave_sum_slow(float v) {
  for (int o = 32; o > 0; o >>= 1) v += __shfl_xor(v, o);
  return v;
}
template <int CTRL> DI float dpp_f(float x) {
  return __int_as_float(__builtin_amdgcn_mov_dpp(__float_as_int(x), CTRL, 0xF, 0xF, true));
}
DI float row16_sum(float x) {
  x += dpp_f<0xB1>(x);
  x += dpp_f<0x4E>(x);
  x += dpp_f<0x141>(x);
  x += dpp_f<0x140>(x);
  return x;
}
DI float wave_sum(float v) {
  const int t = __float_as_int(row16_sum(v));
  const float a = __int_as_float(__builtin_amdgcn_readlane(t, 0)), b = __int_as_float(__builtin_amdgcn_readlane(t, 16));
  const float c = __int_as_float(__builtin_amdgcn_readlane(t, 32)), d = __int_as_float(__builtin_amdgcn_readlane(t, 48));
  return (a + b) + (c + d);
}

constexpr int BM = 256, BK = 64, HALF = 128, HT = HALF * BK;

DI int lds_byte(int r, int c) {
  int st = (r >> 4) * 2 + (c >> 5), rr = r & 15, cc = c & 31, ob = rr * 64 + cc * 2;
  return st * 1024 + (ob ^ (((ob >> 9) & 1) << 5));
}
DI void stage_rc(int b, int& R, int& C) {
  int st = b / 1024, sb = b % 1024, swz = sb ^ (((sb >> 9) & 1) << 5);
  R = (st >> 1) * 16 + swz / 64; C = (st & 1) * 32 + (swz % 64) / 2;
}

struct TileDesc { const u16* A; const u16* B; int brow, bcol, sub; };
DI void rope_epilogue(const PRef& p, const f32x4 (&acc)[2][2][4][2], int brow, int bcol, int wr, int wc, int fr, int fq);
template <class TileFn, class Epi>
DI void gemm_stream(int ntiles, int lda, int ldb, int K, TileFn tile_fn, Epi epi) {
  extern __shared__ __attribute__((aligned(16))) u16 shm[];
  if (ntiles <= 0) return;
#define SA(b, h) (shm + ((b) * 2 + (h)) * HT)
#define SB(b, h) (shm + (4 + (b) * 2 + (h)) * HT)
#define STAGE(P, PTR, V, S64, HH, KREL) do { \
    const char* _p = (PTR) + ((KREL) * 128 + (size_t)(2 * (HH)) * (S64)); asm volatile("" : "+s"(_p)); \
    __builtin_amdgcn_global_load_lds((const unsigned*)(_p + (size_t)(V)), (unsigned*)((char*)(P) + tid * 16), 16, 0, 0); \
    const char* _q = (PTR) + ((KREL) * 128 + (size_t)(2 * (HH) + 1) * (S64)); asm volatile("" : "+s"(_q)); \
    __builtin_amdgcn_global_load_lds((const unsigned*)(_q + (size_t)(V)), (unsigned*)((char*)(P) + tid * 16 + 8192), 16, 0, 0); } while (0)
#define LDA(dst, b, h) for (int m = 0; m < 4; ++m) for (int k = 0; k < 2; ++k) \
    dst[m][k] = *reinterpret_cast<const bf16x8*>((char*)SA(b, h) + lda_base + m * 2048 + k * 1024)
#define LDB(dst, b, h) for (int n = 0; n < 2; ++n) for (int k = 0; k < 2; ++k) \
    dst[n][k] = *reinterpret_cast<const bf16x8*>((char*)SB(b, h) + ldb_base + n * 256 + k * 1024)
#define MMA(ai, bj, At_, Bt_) do { __builtin_amdgcn_s_setprio(1); \
    for (int m = 0; m < 4; ++m) for (int n = 0; n < 2; ++n) for (int k = 0; k < 2; ++k) \
      acc[ai][bj][m][n] = __builtin_amdgcn_mfma_f32_16x16x32_bf16(Bt_[n][k], At_[m][k], acc[ai][bj][m][n], 0, 0, 0); \
    __builtin_amdgcn_s_setprio(0); } while (0)
#define WAIT_V(n) asm volatile("s_waitcnt vmcnt(" #n ")" ::: "memory")
#define WAIT_L(n) asm volatile("s_waitcnt lgkmcnt(" #n ")" ::: "memory")
#define BAR __builtin_amdgcn_s_barrier()
#define SCHED __builtin_amdgcn_sched_barrier(0)
#define SA0(P_, K) STAGE(SA(0, 0), P_, vA, sA64, 0, K)
#define SA0H(P_, K) STAGE(SA(0, 1), P_, vA, sA64, 1, K)
#define SA1(P_, K) STAGE(SA(1, 0), P_, vA, sA64, 0, K)
#define SA1H(P_, K) STAGE(SA(1, 1), P_, vA, sA64, 1, K)
#define SB0(P_, K) STAGE(SB(0, 0), P_, vB, sB64, 0, K)
#define SB0H(P_, K) STAGE(SB(0, 1), P_, vB, sB64, 1, K)
#define SB1(P_, K) STAGE(SB(1, 0), P_, vB, sB64, 0, K)
#define SB1H(P_, K) STAGE(SB(1, 1), P_, vB, sB64, 1, K)

  const int tid = ltid();
  const int wid = tid >> 6, lane = tid & 63, wr = wid >> 2, wc = wid & 3, fr = lane & 15, fq = lane >> 4;
  unsigned vA, vB;
  { int r0, c0; stage_rc(tid * 16, r0, c0); vA = (unsigned)(r0 * lda + c0) * 2u; vB = (unsigned)(r0 * ldb + c0) * 2u; }
  const unsigned sA64 = (unsigned)lda * 128u, sB64 = (unsigned)ldb * 128u;
  const int nt = K / BK;
  const int lda_base = lds_byte(wr * 64 + fr, fq * 8);
  const int ldb_base = lds_byte(wc * 32 + (fr >> 2) * 8 + (fr & 3), fq * 8);
  TileDesc cur = tile_fn(0);
  const char* pA = (const char*)(cur.A + (long)cur.brow * lda);
  const char* pB = (const char*)(cur.B + (long)cur.bcol * ldb);
  SB0(pB, 0); SA0(pA, 0); SB0H(pB, 0); SA0H(pA, 0);
  if (wr == 1) BAR;
  WAIT_V(4); BAR;
  SB1(pB, 1); SA1(pA, 1); SB1H(pB, 1);
  WAIT_V(6); BAR;
  for (int ti = 0; ti < ntiles; ++ti) {
    const TileDesc nxt = tile_fn(ti + 1 < ntiles ? ti + 1 : ti);
    const char* pAn = (const char*)(nxt.A + (long)nxt.brow * lda);
    const char* pBn = (const char*)(nxt.B + (long)nxt.bcol * ldb);
    f32x4 acc[2][2][4][2];
    for (int a = 0; a < 2; ++a) for (int b = 0; b < 2; ++b) for (int m = 0; m < 4; ++m) for (int n = 0; n < 2; ++n) acc[a][b][m][n] = f32x4{0.f, 0.f, 0.f, 0.f};
    bf16x8 At[4][2], B0[2][2], B1[2][2];
    for (int t = 0; t < nt; t += 2) {
      const bool last = (t == nt - 2);
      const char* pA2 = last ? pAn - 256 : pA;
      const char* pB2 = last ? pBn - 256 : pB;
      LDB(B0, 0, 0); SCHED; LDA(At, 0, 0); SA1H(pA, 1);
      WAIT_L(8); BAR; WAIT_L(0); MMA(0, 0, At, B0); BAR; SCHED;
      LDB(B1, 0, 1); SB0(pB2, 2);
      BAR; WAIT_L(0); MMA(0, 1, At, B1); BAR;
      LDA(At, 0, 1); SA0(pA2, 2);
      BAR; WAIT_L(0); MMA(1, 0, At, B0); BAR; SCHED;
      SB0H(pB2, 2);
      WAIT_V(6); BAR; MMA(1, 1, At, B1); BAR;
      LDB(B0, 1, 0); SCHED; LDA(At, 1, 0); SA0H(pA2, 2);
      WAIT_L(8); BAR; WAIT_L(0); MMA(0, 0, At, B0); BAR; SCHED;
      LDB(B1, 1, 1); SB1(pB2, 3);
      BAR; WAIT_L(0); MMA(0, 1, At, B1); BAR;
      LDA(At, 1, 1); SA1(pA2, 3);
      BAR; WAIT_L(0); MMA(1, 0, At, B0); BAR; SCHED;
      SB1H(pB2, 3);
      WAIT_V(6); BAR; MMA(1, 1, At, B1); BAR;
      pA += 256; pB += 256;
    }
    if (wr == 0) BAR;
    if (epi.kind == 0 && cur.sub == 0 && cur.bcol < 1024) {
      const PRef pe(epi.ka);
      rope_epilogue(pe, acc, cur.brow, cur.bcol, wr, wc, fr, fq);
    } else if (epi.kind == 10) {
      const PRef pe(epi.ka);
      up_epilogue(pe, epi.lay, acc, cur.brow, cur.bcol, wr, wc, fr, fq, reinterpret_cast<float*>(reinterpret_cast<char*>(shm) + 131072));
    } else {
#pragma unroll
      for (int ai = 0; ai < 2; ++ai)
#pragma unroll
        for (int bj = 0; bj < 2; ++bj)
#pragma unroll
          for (int m = 0; m < 4; ++m)
            epi(cur.sub, cur.brow + ai * HALF + wr * 64 + m * 16 + fr, cur.bcol + bj * HALF + wc * 32 + fq * 8, acc[ai][bj][m][0], acc[ai][bj][m][1]);
    }
    WAIT_V(0);
    cur = nxt; pA = pAn; pB = pBn;
    if (wr == 1 && ti + 1 < ntiles) BAR;
  }
  __syncthreads();
#undef SA
#undef SB
}

template <int CTRL> DI float dppz(float x) {
  return __int_as_float(__builtin_amdgcn_update_dpp(0, __float_as_int(x), CTRL, 0xF, 0xF, true));
}
DI void up_epilogue(const PRef& p, int l, const f32x4 (&acc)[2][2][4][2], int brow, int bcol, int wr, int wc, int fr, int fq, float* exch) {
  char* ws = p.ws;
  u16* hmid = (u16*)(ws + OFF_AG);
  const int pm = brow >> 8, pn = bcol >> 8;
  const int tc0 = wc * 32 + fq * 8;
  const int cw0 = pn * 128 + tc0;
  const float* cwp = (const float*)p.in[I_CONVW] + (size_t)l * 3 * DFF;
  const float* cbp = (const float*)p.in[I_CONVB] + (size_t)l * DFF;
#pragma unroll
  for (int ai = 0; ai < 2; ++ai)
#pragma unroll
    for (int n = 0; n < 2; ++n) {
      if (fr >= 14) {
        const f32x4 v = acc[ai][0][3][n];
        *reinterpret_cast<float4*>(exch + (((ai * 2 + wr) * 2 + (fr - 14)) * 128 + tc0 + n * 4)) = make_float4(v[0], v[1], v[2], v[3]);
        if (ai == 1 && wr == 1)
          *reinterpret_cast<float4*>((float*)(ws + OFF_AL) + ((size_t)(pm * 2 + (fr - 14)) * DFF + cw0 + n * 4)) = make_float4(v[0], v[1], v[2], v[3]);
      }
      if (ai == 0 && wr == 0 && fr < 2) {
        const f32x4 va = acc[0][0][0][n], vg = acc[0][1][0][n];
        *reinterpret_cast<float4*>((float*)(ws + OFF_AF) + ((size_t)(pm * 2 + fr) * DFF + cw0 + n * 4)) = make_float4(va[0], va[1], va[2], va[3]);
        *reinterpret_cast<float4*>((float*)(ws + OFF_GF) + ((size_t)(pm * 2 + fr) * DFF + cw0 + n * 4)) = make_float4(vg[0], vg[1], vg[2], vg[3]);
      }
    }
  __syncthreads();
#pragma unroll
  for (int ai = 0; ai < 2; ++ai) {
    const int sp = ai * 2 + wr;
#pragma unroll
    for (int m = 0; m < 4; ++m) {
      float o[8];
#pragma unroll
      for (int n = 0; n < 2; ++n) {
        const int c = cw0 + n * 4;
        const float4 w0 = *reinterpret_cast<const float4*>(cwp + c), w1 = *reinterpret_cast<const float4*>(cwp + DFF + c);
        const float4 w2 = *reinterpret_cast<const float4*>(cwp + 2 * DFF + c), bs = *reinterpret_cast<const float4*>(cbp + c);
        const float w0a[4] = {w0.x, w0.y, w0.z, w0.w}, w1a[4] = {w1.x, w1.y, w1.z, w1.w}, w2a[4] = {w2.x, w2.y, w2.z, w2.w}, bsa[4] = {bs.x, bs.y, bs.z, bs.w};
        float p62a[4] = {0.f, 0.f, 0.f, 0.f}, p63a[4] = {0.f, 0.f, 0.f, 0.f};
        if (m == 0 && sp > 0) {
          const float4 p62 = *reinterpret_cast<const float4*>(exch + (((sp - 1) * 2 + 0) * 128 + tc0 + n * 4));
          const float4 p63 = *reinterpret_cast<const float4*>(exch + (((sp - 1) * 2 + 1) * 128 + tc0 + n * 4));
          p62a[0] = p62.x; p62a[1] = p62.y; p62a[2] = p62.z; p62a[3] = p62.w;
          p63a[0] = p63.x; p63a[1] = p63.y; p63a[2] = p63.z; p63a[3] = p63.w;
        }
#pragma unroll
        for (int j = 0; j < 4; ++j) {
          const float a = acc[ai][0][m][n][j], g = acc[ai][1][m][n][j];
          float pr1 = dppz<0x111>(a), pr2 = dppz<0x112>(a);
          if (m == 0) {
            if (fr == 0) { pr1 = p63a[j]; pr2 = p62a[j]; }
            if (fr == 1) { pr2 = p63a[j]; }
          } else {
            const float am = acc[ai][0][m > 0 ? m - 1 : 0][n][j];
            const float mir = dppz<0x140>(am);
            const float swp = dppz<0xB1>(mir);
            if (fr == 0) { pr1 = mir; }
            if (fr < 2) { pr2 = swp; }
          }
          const float cv = bsa[j] + w0a[j] * pr2 + w1a[j] * pr1 + w2a[j] * a;
          o[n * 4 + j] = cv * sigmoidf_(cv) * g;
        }
      }
      uint4 ov; ov.x = pack2(o[0], o[1]); ov.y = pack2(o[2], o[3]); ov.z = pack2(o[4], o[5]); ov.w = pack2(o[6], o[7]);
      *reinterpret_cast<uint4*>(hmid + (size_t)(brow + ai * HALF + wr * 64 + m * 16 + fr) * DFF + cw0) = ov;
    }
  }
  __syncthreads();
}

DI void rope_epilogue(const PRef& p, const f32x4 (&acc)[2][2][4][2], int brow, int bcol, int wr, int wc, int fr, int fq) {
  char* ws = p.ws;
  u16* qk = (u16*)(ws + OFF_QK);
  const float* rc = (const float*)(ws + OFF_ROPE); const float* rs = rc + (size_t)NTOK * 32;
  const int d0 = (wc & 1) * 16 + fq * 4;
#pragma unroll
  for (int ai = 0; ai < 2; ++ai)
#pragma unroll
    for (int m = 0; m < 4; ++m) {
      const int tok = brow + ai * HALF + wr * 64 + m * 16 + fr;
      const float4 c4 = *reinterpret_cast<const float4*>(rc + (size_t)tok * 32 + d0);
      const float4 s4 = *reinterpret_cast<const float4*>(rs + (size_t)tok * 32 + d0);
      const float ca[4] = {c4.x, c4.y, c4.z, c4.w}, sa[4] = {s4.x, s4.y, s4.z, s4.w};
#pragma unroll
      for (int bj = 0; bj < 2; ++bj) {
        const int hh = (bcol >> 6) + bj * 2 + (wc >> 1);
        const float sc = (hh < 8) ? 0.125f * LOG2E : 1.f;
        float o0[4], o1[4];
#pragma unroll
        for (int j = 0; j < 4; ++j) {
          const float t0 = acc[ai][bj][m][0][j], t1 = acc[ai][bj][m][1][j];
          o0[j] = (t0 * ca[j] - t1 * sa[j]) * sc;
          o1[j] = (t1 * ca[j] + t0 * sa[j]) * sc;
        }
        uint4 v; v.x = pack2(o0[0], o0[1]); v.y = pack2(o0[2], o0[3]); v.z = pack2(o1[0], o1[1]); v.w = pack2(o1[2], o1[3]);
        *reinterpret_cast<uint4*>(qk + (size_t)tok * 1024 + bcol + bj * HALF + wc * 32 + fq * 8) = v;
      }
    }
}

struct EpiGen {
  int kind, lay; kaptr_t ka;
  DI void operator()(int sub, int row, int col, f32x4 v, f32x4 w) const {
    const PRef p(ka);
    if (kind == 4 || kind == 8 || kind == 12) {
      float* X = p.xs;
      float4* q = reinterpret_cast<float4*>(X + (size_t)row * DM + col);
      const float4* qi = (kind == 4 && lay == 0) ? reinterpret_cast<const float4*>((const float*)p.in[I_X] + (size_t)row * DM + col) : q;
      float4 x = qi[0], y = qi[1];
      x.x = ALPHA * x.x + v[0]; x.y = ALPHA * x.y + v[1]; x.z = ALPHA * x.z + v[2]; x.w = ALPHA * x.w + v[3];
      y.x = ALPHA * y.x + w[0]; y.y = ALPHA * y.y + w[1]; y.z = ALPHA * y.z + w[2]; y.w = ALPHA * y.w + w[3];
      q[0] = x; q[1] = y;
      return;
    }
    char* ws = p.ws;
    const float scale = (kind == 6) ? 0.0625f * LOG2E : 1.f;
    uint4 o; o.x = pack2(v[0] * scale, v[1] * scale); o.y = pack2(v[2] * scale, v[3] * scale);
    o.z = pack2(w[0] * scale, w[1] * scale); o.w = pack2(w[2] * scale, w[3] * scale);
    u16* dst;
    if (kind == 6) dst = (u16*)(ws + OFF_QC) + (size_t)row * 1024 + col;
    else if (sub == 1) dst = (u16*)(ws + OFF_VT) + (size_t)row * NTOK + col;
    else if (sub == 2) dst = (u16*)(ws + OFF_KMEM) + (size_t)row * 1024 + col;
    else if (sub == 3) dst = (u16*)(ws + OFF_VMEMT) + (size_t)row * 2048 + col;
    else if (col < 1024) dst = (u16*)(ws + OFF_QK) + (size_t)row * 1024 + col;
    else if (col < 2432) dst = (u16*)(ws + OFF_RW) + (size_t)row * 896 + (col - 1536);
    else if (col < 2688) dst = (u16*)(ws + OFF_S5) + (size_t)row * 256 + (col - 2432);
    else return;
    *reinterpret_cast<uint4*>(dst) = o;
  }
};

DI void transpose_tiles(const float* __restrict__ src, int K, int N, int Npad, u16* __restrict__ dst, int& tbase, int tile_begin, int tile_stride, bool upmap = false, int rope_rows = 0) {
  extern __shared__ __attribute__((aligned(16))) u16 shm[];
  float* tile = reinterpret_cast<float*>(shm);
  const int nkt = K / 64, nnt = Npad / 64, total = nkt * nnt;
  int first = tile_begin;
  if (first < tbase) { int d = tbase - first; first += ((d + tile_stride - 1) / tile_stride) * tile_stride; }
  for (int g = first; g < tbase + total; g += tile_stride) {
    int t = g - tbase; int kt = t % nkt, ntile = t / nkt; int k0 = kt * 64, n0 = ntile * 64;
    __syncthreads();
    const int tid = ltid();
#pragma unroll
    for (int r = 0; r < 2; ++r) {
      const int e = tid + r * 512, i = e >> 4, j4 = (e & 15) * 4;
      float4 v = make_float4(0.f, 0.f, 0.f, 0.f);
      const int sn0 = upmap ? ((n0 & 255) >> 7) * DFF + (n0 >> 8) * 128 + (n0 & 127) : n0;
      if (n0 + j4 < N) v = *reinterpret_cast<const float4*>(src + (size_t)(k0 + i) * N + sn0 + j4);
      tile[i * 65 + j4] = v.x; tile[i * 65 + j4 + 1] = v.y; tile[i * 65 + j4 + 2] = v.z; tile[i * 65 + j4 + 3] = v.w;
    }
    __syncthreads();
    {
      const int jn = tid >> 3, seg = tid & 7;
      const float* tp = tile + (seg * 8) * 65 + jn;
      uint4 o;
      o.x = pack2(tp[0], tp[65]); o.y = pack2(tp[2 * 65], tp[3 * 65]); o.z = pack2(tp[4 * 65], tp[5 * 65]); o.w = pack2(tp[6 * 65], tp[7 * 65]);
      const int jd = (n0 < rope_rows) ? (((jn >> 4) & 1) * 32 + ((jn & 15) >> 2) * 8 + (jn >> 5) * 4 + (jn & 3)) : jn;
      *reinterpret_cast<uint4*>(dst + (size_t)(n0 + jd) * K + k0 + seg * 8) = o;
    }
  }
  tbase += total;
}

DI void phase_transposes(const PRef& p, int l) {
  char* wt = p.ws + OFF_WT;
  int tbase = 0; const int tb = blockIdx.x, ts = gridDim.x;
  transpose_tiles((const float*)p.in[I_WIN] + (size_t)l * 1024 * INW, 1024, INW, 2816, (u16*)(wt + WT_IN), tbase, tb, ts, false, 1024);
  transpose_tiles((const float*)p.in[I_WOUT] + (size_t)l * 1024 * 1024, 1024, 1024, 1024, (u16*)(wt + WT_OUT), tbase, tb, ts);
  transpose_tiles((const float*)p.in[I_WQ] + (size_t)l * 1024 * 1024, 1024, 1024, 1024, (u16*)(wt + WT_Q), tbase, tb, ts);
  transpose_tiles((const float*)p.in[I_WKV] + (size_t)l * 1024 * 2048, 1024, 2048, 2048, (u16*)(wt + WT_KV), tbase, tb, ts);
  transpose_tiles((const float*)p.in[I_WO] + (size_t)l * 1024 * 1024, 1024, 1024, 1024, (u16*)(wt + WT_O), tbase, tb, ts);
  transpose_tiles((const float*)p.in[I_WUP] + (size_t)l * 1024 * 5632, 1024, 5632, 5632, (u16*)(wt + WT_UP), tbase, tb, ts, true);
  transpose_tiles((const float*)p.in[I_WDOWN] + (size_t)l * 2816 * 1024, 2816, 1024, 1024, (u16*)(wt + WT_DOWN), tbase, tb, ts);
  transpose_tiles((const float*)p.in[I_GLUW] + (size_t)l * 256 * 256, 256, 256, 256, (u16*)(wt + WT_GLU), tbase, tb, ts);
  __syncthreads();
  {
    const float* w2 = (const float*)p.in[I_W2] + l * 32 * 256;
    const float* a2 = (const float*)p.in[I_A2] + l * 32 * 256;
    const float* g2 = (const float*)p.in[I_G2] + l * 64 * 256;
    u16* w2t = (u16*)(wt + WT_W2T); u16* a2t = (u16*)(wt + WT_A2T); u16* g2t = (u16*)(wt + WT_G2T);
    for (int e = blockIdx.x * 512 + ltid(); e < 256 * 128; e += gridDim.x * 512) {
      const int n = e & 255, kk = e >> 8;
      if (kk < 32) w2t[n * 32 + kk] = f2bf(w2[kk * 256 + n]);
      else if (kk < 64) a2t[n * 32 + (kk - 32)] = f2bf(a2[(kk - 32) * 256 + n]);
      else g2t[n * 64 + (kk - 64)] = f2bf(g2[(kk - 64) * 256 + n]);
    }
  }
}

DI void phase_init(const PRef& p) {
  const size_t gtid = (size_t)blockIdx.x * 512 + ltid(), gsz = (size_t)gridDim.x * 512;
  const float4* x4 = (const float4*)p.in[I_X];
  uint2* xb2 = (uint2*)(p.ws + OFF_XB);
  for (size_t i = gtid; i < (size_t)NTOK * DM / 4; i += gsz) {
    float4 v = x4[i];
    uint2 o; o.x = pack2(v.x, v.y); o.y = pack2(v.z, v.w); xb2[i] = o;
  }
  const float4* m4 = (const float4*)p.in[I_MEM];
  uint2* mb2 = (uint2*)(p.ws + OFF_MEMB);
  for (size_t i = gtid; i < (size_t)2048 * 1024 / 4; i += gsz) {
    float4 v = m4[i]; uint2 o; o.x = pack2(v.x, v.y); o.y = pack2(v.z, v.w); mb2[i] = o;
  }
  const int* pos = (const int*)p.in[I_POS];
  float* rc = (float*)(p.ws + OFF_ROPE); float* rs = rc + (size_t)NTOK * 32;
  for (size_t i = gtid; i < (size_t)NTOK * 32; i += gsz) {
    int tok = (int)(i >> 5), d = (int)(i & 31);
    float invf = exp2f(-(float)d * (13.287712379549449f / 32.f));
    float angf = (float)pos[tok] * invf;
    double rev = (double)angf * 0.15915494309189535;
    float xr = (float)((rev - rint(rev)) * 6.283185307179586);
    float sv = __sinf(xr), cv = __cosf(xr);
    rc[i] = cv; rs[i] = sv;
  }
  if (blockIdx.x == 0 && ltid() < 64) ((unsigned*)(p.ws + OFF_CNT))[ltid()] = 0u;
}

DI void phase_prep(const PRef& p, int l) {
  extern __shared__ __attribute__((aligned(16))) u16 shm[];
  float* act = reinterpret_cast<float*>(shm);
  u16* qk = (u16*)(p.ws + OFF_QK);
  const u16* rw = (const u16*)(p.ws + OFF_RW);
  const float* rc = (const float*)(p.ws + OFF_ROPE); const float* rs = rc + (size_t)NTOK * 32;
  const float* mu = (const float*)p.in[I_MU] + l * 896;
  const float* w0 = (const float*)p.in[I_W0] + l * 256;
  const float* w2 = (const float*)p.in[I_W2] + l * 32 * 256;
  const float* a0 = (const float*)p.in[I_A0] + l * 256;
  const float* a2 = (const float*)p.in[I_A2] + l * 32 * 256;
  const float* g2 = (const float*)p.in[I_G2] + l * 64 * 256;
  const float* k_k = (const float*)p.in[I_KK] + l * 256;
  const float* k_a = (const float*)p.in[I_KA] + l * 256;
  const float* r_k = (const float*)p.in[I_RK] + l * 256;
  char* rec = p.ws + OFF_REC;
  u16* gbuf = (u16*)(p.ws + OFF_G);
  float* bonus = (float*)(p.ws + OFF_BONUS);
  const int tid = ltid();
  for (int item = blockIdx.x; item < NTOK / 32; item += gridDim.x) {
    const int tk0 = item * 32;
    __syncthreads();
    for (int idx = tid; idx < 32 * 128; idx += 512) {
      const int i = idx >> 7, j = idx & 127, tok = tk0 + i, col = 768 + j;
      float pv = bf2f(rw[(size_t)tok * 896 + col]);
      float pp = ((tok & (SEQ - 1)) != 0) ? bf2f(rw[(size_t)(tok - 1) * 896 + col]) : 0.f;
      float ps = pv + (pp - pv) * mu[col];
      float a = (j < 32) ? tanhf(ps) : (j < 64) ? ps : sigmoidf_(ps);
      act[i * 128 + j] = a;
    }
    __syncthreads();
    const int c = tid & 255, half = tid >> 8, h = c >> 6;
    {
      float* lora = act + 32 * 128;
      const int w8 = tid >> 6, ln = tid & 63, fr = ln & 15, fq = ln >> 4;
      const u16* w2t = (const u16*)(p.ws + OFF_WT + WT_W2T);
      const u16* a2t = (const u16*)(p.ws + OFF_WT + WT_A2T);
      const u16* g2t = (const u16*)(p.ws + OFF_WT + WT_G2T);
#pragma unroll
      for (int nbi = 0; nbi < 2; ++nbi) {
        const int col0 = (w8 * 2 + nbi) * 16;
        const bf16x8 bw = *reinterpret_cast<const bf16x8*>(w2t + (size_t)(col0 + fr) * 32 + fq * 8);
        const bf16x8 ba = *reinterpret_cast<const bf16x8*>(a2t + (size_t)(col0 + fr) * 32 + fq * 8);
        const bf16x8 bg0 = *reinterpret_cast<const bf16x8*>(g2t + (size_t)(col0 + fr) * 64 + fq * 8);
        const bf16x8 bg1 = *reinterpret_cast<const bf16x8*>(g2t + (size_t)(col0 + fr) * 64 + 32 + fq * 8);
#pragma unroll
        for (int mb = 0; mb < 2; ++mb) {
          const float* ap = act + (mb * 16 + fr) * 128 + fq * 8;
          bf16x8 af[4];
#pragma unroll
          for (int ks = 0; ks < 4; ++ks) {
            const float4 f0 = *reinterpret_cast<const float4*>(ap + ks * 32), f1 = *reinterpret_cast<const float4*>(ap + ks * 32 + 4);
            af[ks] = __builtin_bit_cast(bf16x8, (u32x4{pack2(f0.x, f0.y), pack2(f0.z, f0.w), pack2(f1.x, f1.y), pack2(f1.z, f1.w)}));
          }
          const f32x4 z4 = f32x4{0.f, 0.f, 0.f, 0.f};
          f32x4 dw = __builtin_amdgcn_mfma_f32_16x16x32_bf16(bw, af[0], z4, 0, 0, 0);
          f32x4 da = __builtin_amdgcn_mfma_f32_16x16x32_bf16(ba, af[1], z4, 0, 0, 0);
          f32x4 dg = __builtin_amdgcn_mfma_f32_16x16x32_bf16(bg0, af[2], z4, 0, 0, 0);
          dg = __builtin_amdgcn_mfma_f32_16x16x32_bf16(bg1, af[3], dg, 0, 0, 0);
          float* lp = lora + (mb * 16 + fr) * 256 + col0 + fq * 4;
          *reinterpret_cast<float4*>(lp) = make_float4(dw[0], dw[1], dw[2], dw[3]);
          *reinterpret_cast<float4*>(lp + 32 * 256) = make_float4(da[0], da[1], da[2], da[3]);
          *reinterpret_cast<float4*>(lp + 2 * 32 * 256) = make_float4(dg[0], dg[1], dg[2], dg[3]);
        }
      }
    }
    __syncthreads();
    float accw[16], acca[16], accg[16];
#pragma unroll
    for (int i = 0; i < 16; ++i) {
      const float* lp = act + 32 * 128 + (half * 16 + i) * 256 + c;
      accw[i] = lp[0]; acca[i] = lp[32 * 256]; accg[i] = lp[2 * 32 * 256];
    }
    const float mur = mu[c], muk = mu[256 + c], muv = mu[512 + c];
    const float w0c = w0[c], a0c = a0[c], kkc = k_k[c], kac = k_a[c], rkc = r_k[c];
#pragma unroll
    for (int i = 0; i < 16; ++i) {
      const int tok = tk0 + half * 16 + i;
      const bool has_prev = (tok & (SEQ - 1)) != 0;
      const u16* pr_ = rw + (size_t)tok * 896;
      float r0 = bf2f(pr_[c]), k0 = bf2f(pr_[256 + c]), v0 = bf2f(pr_[512 + c]);
      float r1 = 0.f, k1 = 0.f, v1 = 0.f;
      if (has_prev) { r1 = bf2f(pr_[c - 896]); k1 = bf2f(pr_[256 + c - 896]); v1 = bf2f(pr_[512 + c - 896]); }
      float r = r0 + (r1 - r0) * mur, k = k0 + (k1 - k0) * muk, v = v0 + (v1 - v0) * muv;
      float w = __expf(-0.6065306597126334f * sigmoidf_(w0c + accw[i]));
      float a = sigmoidf_(a0c + acca[i]);
      float kk = k * kkc;
      float ss = wave_sum(kk * kk);
      kk *= rsqrtf(fmaxf(ss, 1e-24f));
      float kp = k * (1.f + (a - 1.f) * kac);
      float bb = kk * a;
      float bo = wave_sum(r * kp * rkc);
      const int b = tok >> 12, t = tok & (SEQ - 1);
      char* rp = rec + ((size_t)((b * 4 + h) * SEQ + t)) * 1152;
      const int cc = c & 63;
      reinterpret_cast<float*>(rp)[cc] = w;
      reinterpret_cast<float*>(rp + 256)[cc] = kk;
      reinterpret_cast<float*>(rp + 512)[cc] = bb;
      reinterpret_cast<u16*>(rp + 768)[cc] = f2bf(kp);
      reinterpret_cast<u16*>(rp + 896)[cc] = f2bf(r);
      reinterpret_cast<u16*>(rp + 1024)[cc] = f2bf(v);
      gbuf[(size_t)tok * 256 + c] = f2bf(accg[i]);
      if (cc == 0) bonus[(size_t)tok * 4 + h] = bo;
    }
    __syncthreads();
  }
}

template <int DK, int DV, int NQB>
struct FlashWave {
  bf16x8 qf[NQB][DK / 32];
  f32x4 o[NQB][DV / 16];
  float m[NQB], l[NQB];
  DI void init() {
#pragma unroll
    for (int qb = 0; qb < NQB; ++qb) { m[qb] = -INFINITY; l[qb] = 0.f;
#pragma unroll
      for (int d = 0; d < DV / 16; ++d) o[qb][d] = f32x4{0.f, 0.f, 0.f, 0.f}; }
  }
  DI void tile(const u16* Ks, const u16* Vts) {
    constexpr int KSTR = DK + 8, VSTR = 72;
    const int lane = ltid() & 63, fr = lane & 15, fq = lane >> 4;
    float base[NQB];
#pragma unroll
    for (int qb = 0; qb < NQB; ++qb) base[qb] = (m[qb] == -INFINITY) ? 0.f : m[qb];
    f32x4 s[4][NQB];
    __builtin_amdgcn_s_setprio(1);
#pragma unroll
    for (int kb = 0; kb < 4; ++kb) {
#pragma unroll
      for (int qb = 0; qb < NQB; ++qb) s[kb][qb] = f32x4{-base[qb], -base[qb], -base[qb], -base[qb]};
#pragma unroll
      for (int ks = 0; ks < DK / 32; ++ks) {
        bf16x8 kf = *reinterpret_cast<const bf16x8*>(Ks + (kb * 16 + fr) * KSTR + ks * 32 + fq * 8);
#pragma unroll
        for (int qb = 0; qb < NQB; ++qb) s[kb][qb] = __builtin_amdgcn_mfma_f32_16x16x32_bf16(kf, qf[qb][ks], s[kb][qb], 0, 0, 0);
      }
    }
    __builtin_amdgcn_s_setprio(0);
    bf16x8 pf[NQB][2];
#pragma unroll
    for (int qb = 0; qb < NQB; ++qb) {
      float mx = -INFINITY;
#pragma unroll
      for (int kb = 0; kb < 4; ++kb) {
#pragma unroll
        for (int j = 0; j < 4; ++j) mx = fmaxf(mx, s[kb][qb][j]); }
      mx = fmaxf(mx, __shfl_xor(mx, 16));
      mx = fmaxf(mx, __shfl_xor(mx, 32));
      const float mn = fmaxf(m[qb], base[qb] + mx);
      const bool changed = __any(mn > m[qb]);
      float sum = 0.f;
      if (changed) {
        const float delta = mn - base[qb];
        const float alpha = __builtin_amdgcn_exp2f(m[qb] - mn);
#pragma unroll
        for (int kb = 0; kb < 4; ++kb) {
#pragma unroll
          for (int j = 0; j < 4; ++j) { float e = __builtin_amdgcn_exp2f(s[kb][qb][j] - delta); s[kb][qb][j] = e; sum += e; } }
        l[qb] = l[qb] * alpha + sum;
#pragma unroll
        for (int d = 0; d < DV / 16; ++d) { o[qb][d][0] *= alpha; o[qb][d][1] *= alpha; o[qb][d][2] *= alpha; o[qb][d][3] *= alpha; }
      } else {
#pragma unroll
        for (int kb = 0; kb < 4; ++kb) {
#pragma unroll
          for (int j = 0; j < 4; ++j) { float e = __builtin_amdgcn_exp2f(s[kb][qb][j]); s[kb][qb][j] = e; sum += e; } }
        l[qb] += sum;
      }
      m[qb] = mn;
#pragma unroll
      for (int k2 = 0; k2 < 2; ++k2) {
        u32x4 pk;
        pk[0] = pack2(s[2 * k2][qb][0], s[2 * k2][qb][1]); pk[1] = pack2(s[2 * k2][qb][2], s[2 * k2][qb][3]);
        pk[2] = pack2(s[2 * k2 + 1][qb][0], s[2 * k2 + 1][qb][1]); pk[3] = pack2(s[2 * k2 + 1][qb][2], s[2 * k2 + 1][qb][3]);
        pf[qb][k2] = __builtin_bit_cast(bf16x8, pk);
      }
    }
    __builtin_amdgcn_s_setprio(1);
#pragma unroll
    for (int k2 = 0; k2 < 2; ++k2) {
#pragma unroll
      for (int d = 0; d < DV / 16; ++d) {
        const u16* vp = Vts + (d * 16 + fr) * VSTR + k2 * 32 + fq * 4;
        const uint2 h0 = *reinterpret_cast<const uint2*>(vp);
        const uint2 h1 = *reinterpret_cast<const uint2*>(vp + 16);
        const bf16x8 vfv = __builtin_bit_cast(bf16x8, (u32x4{h0.x, h0.y, h1.x, h1.y}));
#pragma unroll
        for (int qb = 0; qb < NQB; ++qb) o[qb][d] = __builtin_amdgcn_mfma_f32_16x16x32_bf16(vfv, pf[qb][k2], o[qb][d], 0, 0, 0);
      }
    }
    __builtin_amdgcn_s_setprio(0);
  }
  DI float lsum(int qb) { float t = l[qb]; t += __shfl_xor(t, 16); t += __shfl_xor(t, 32); return t; }
};

DI void diff_attn_item(const PRef& p, int l, int b, int h, int qt) {
  extern __shared__ __attribute__((aligned(16))) u16 shm[];
  u16* Ks = shm;
  u16* Vts = shm + 2 * 64 * 72;
  float* comb = reinterpret_cast<float*>(shm + 2 * 64 * 72 + 128 * 72);
  const u16* qk = (const u16*)(p.ws + OFF_QK);
  const u16* vt = (const u16*)(p.ws + OFF_VT);
  u16* hcat = (u16*)(p.ws + OFF_HCAT);
  const int tid = ltid(), w = tid >> 6, lane = tid & 63, fr = lane & 15, fq = lane >> 4;
  const int n = w >> 2, qsub = w & 3;
  const int tok0 = b * SEQ + qt * 128;
  float lam;
  {
    float a1 = ((const float*)p.in[I_LQ1])[l * 64 + lane] * ((const float*)p.in[I_LK1])[l * 64 + lane];
    float a2 = ((const float*)p.in[I_LQ2])[l * 64 + lane] * ((const float*)p.in[I_LK2])[l * 64 + lane];
    a1 = wave_sum(a1); a2 = wave_sum(a2);
    lam = __expf(a1) - __expf(a2) + p.lam_init[l];
  }
  FlashWave<64, 128, 2> fw;
  fw.init();
#pragma unroll
  for (int qb = 0; qb < 2; ++qb)
#pragma unroll
    for (int ks = 0; ks < 2; ++ks)
    fw.qf[qb][ks] = *reinterpret_cast<const bf16x8*>(qk + (size_t)(tok0 + qsub * 32 + qb * 16 + fr) * 1024 + h * 128 + n * 64 + ks * 32 + fq * 8);
  const int nkt = 2 * qt + 2;
  const int my_last = 2 * qt + (qsub >> 1);
  uint4 kreg0, kreg1, vreg0, vreg1;
  const int seg0 = tid, seg1 = tid + 512;
  const u16* kbase0 = qk + (size_t)(b * SEQ + ((seg0 >> 3) & 63)) * 1024 + 512 + h * 128 + (seg0 >> 9) * 64 + (seg0 & 7) * 8;
  const u16* kbase1 = qk + (size_t)(b * SEQ + ((seg1 >> 3) & 63)) * 1024 + 512 + h * 128 + (seg1 >> 9) * 64 + (seg1 & 7) * 8;
  const u16* vbase0 = vt + (size_t)(h * 128 + (seg0 >> 3)) * NTOK + b * SEQ + (seg0 & 7) * 8;
  const u16* vbase1 = vt + (size_t)(h * 128 + (seg1 >> 3)) * NTOK + b * SEQ + (seg1 & 7) * 8;
  u16* kdst0 = Ks + ((seg0 >> 9) * 64 + ((seg0 >> 3) & 63)) * 72 + (seg0 & 7) * 8;
  u16* kdst1 = Ks + ((seg1 >> 9) * 64 + ((seg1 >> 3) & 63)) * 72 + (seg1 & 7) * 8;
  u16* vdst0 = Vts + (seg0 >> 3) * 72 + (seg0 & 7) * 8;
  u16* vdst1 = Vts + (seg1 >> 3) * 72 + (seg1 & 7) * 8;
#define load_tile(kt) do { \
    kreg0 = *reinterpret_cast<const uint4*>(kbase0 + (size_t)(kt) * 64 * 1024); \
    kreg1 = *reinterpret_cast<const uint4*>(kbase1 + (size_t)(kt) * 64 * 1024); \
    vreg0 = *reinterpret_cast<const uint4*>(vbase0 + (kt) * 64); \
    vreg1 = *reinterpret_cast<const uint4*>(vbase1 + (kt) * 64); } while (0)
#define store_tile() do { \
    *reinterpret_cast<uint4*>(kdst0) = kreg0; *reinterpret_cast<uint4*>(kdst1) = kreg1; \
    *reinterpret_cast<uint4*>(vdst0) = vreg0; *reinterpret_cast<uint4*>(vdst1) = vreg1; } while (0)
  load_tile(0);
  for (int kt = 0; kt < nkt; ++kt) {
    __syncthreads();
    store_tile();
    __syncthreads();
    if (kt + 1 < nkt) load_tile(kt + 1);
    if (kt <= my_last) fw.tile(Ks + n * 64 * 72, Vts);
  }
  float inv[2];
#pragma unroll
  for (int qb = 0; qb < 2; ++qb) inv[qb] = 1.f / fw.lsum(qb);
  __syncthreads();
  if (n == 1) {
#pragma unroll
    for (int qb = 0; qb < 2; ++qb)
#pragma unroll
      for (int d = 0; d < 8; ++d) {
      float4 v; v.x = fw.o[qb][d][0] * inv[qb]; v.y = fw.o[qb][d][1] * inv[qb]; v.z = fw.o[qb][d][2] * inv[qb]; v.w = fw.o[qb][d][3] * inv[qb];
      *reinterpret_cast<float4*>(&comb[(qsub * 32 + qb * 16 + fr) * 132 + d * 16 + fq * 4]) = v;
    }
  }
  __syncthreads();
  if (n == 0) {
    const float* sg = (const float*)p.in[I_SUBLN] + l * 128;
    const float post = 1.f - p.lam_init[l];
#pragma unroll
    for (int qb = 0; qb < 2; ++qb) {
      float ss = 0.f;
#pragma unroll
      for (int d = 0; d < 8; ++d) {
        float4 c2 = *reinterpret_cast<const float4*>(&comb[(qsub * 32 + qb * 16 + fr) * 132 + d * 16 + fq * 4]);
        fw.o[qb][d][0] = fw.o[qb][d][0] * inv[qb] - lam * c2.x;
        fw.o[qb][d][1] = fw.o[qb][d][1] * inv[qb] - lam * c2.y;
        fw.o[qb][d][2] = fw.o[qb][d][2] * inv[qb] - lam * c2.z;
        fw.o[qb][d][3] = fw.o[qb][d][3] * inv[qb] - lam * c2.w;
        for (int j = 0; j < 4; ++j) ss += fw.o[qb][d][j] * fw.o[qb][d][j];
      }
      ss += __shfl_xor(ss, 16); ss += __shfl_xor(ss, 32);
      const float rms = rsqrtf(ss * (1.f / 128.f) + 1e-6f) * post;
      u16* op = hcat + (size_t)(tok0 + qsub * 32 + qb * 16 + fr) * 1024 + h * 128;
#pragma unroll
      for (int d = 0; d < 8; ++d) {
        const int dv = d * 16 + fq * 4;
        uint2 ov;
        ov.x = pack2(fw.o[qb][d][0] * rms * sg[dv], fw.o[qb][d][1] * rms * sg[dv + 1]);
        ov.y = pack2(fw.o[qb][d][2] * rms * sg[dv + 2], fw.o[qb][d][3] * rms * sg[dv + 3]);
        *reinterpret_cast<uint2*>(op + dv) = ov;
      }
    }
  }
  __syncthreads();
}

#undef load_tile
#undef store_tile
DI void cross_attn_item(const PRef& p, int tokblk, int h) {
  extern __shared__ __attribute__((aligned(16))) u16 shm[];
  u16* Ks = shm;
  u16* Vts = shm + 64 * 264;
  const u16* qc = (const u16*)(p.ws + OFF_QC);
  const u16* km = (const u16*)(p.ws + OFF_KMEM);
  const u16* vm = (const u16*)(p.ws + OFF_VMEMT);
  u16* oc = (u16*)(p.ws + OFF_OC);
  const int tid = ltid(), w = tid >> 6, lane = tid & 63, fr = lane & 15, fq = lane >> 4;
  const int tok0 = tokblk * 128, b = tok0 >> 12;
  FlashWave<256, 256, 1> fw;
  fw.init();
#pragma unroll
  for (int ks = 0; ks < 8; ++ks)
    fw.qf[0][ks] = *reinterpret_cast<const bf16x8*>(qc + (size_t)(tok0 + w * 16 + fr) * 1024 + h * 256 + ks * 32 + fq * 8);
  uint4 kreg0, kreg1, kreg2, kreg3, vreg0, vreg1, vreg2, vreg3;
  const u16* kbase = km + (size_t)(b * 256 + (tid >> 5)) * 1024 + h * 256 + (tid & 31) * 8;
  const u16* vbase = vm + (size_t)(h * 256 + (tid >> 3)) * 2048 + b * 256 + (tid & 7) * 8;
  u16* kdst = Ks + (tid >> 5) * 264 + (tid & 31) * 8;
  u16* vdst = Vts + (tid >> 3) * 72 + (tid & 7) * 8;
#define load_tile(kt) do { \
    kreg0 = *reinterpret_cast<const uint4*>(kbase + (size_t)((kt) * 64 + 0) * 1024); \
    kreg1 = *reinterpret_cast<const uint4*>(kbase + (size_t)((kt) * 64 + 16) * 1024); \
    kreg2 = *reinterpret_cast<const uint4*>(kbase + (size_t)((kt) * 64 + 32) * 1024); \
    kreg3 = *reinterpret_cast<const uint4*>(kbase + (size_t)((kt) * 64 + 48) * 1024); \
    vreg0 = *reinterpret_cast<const uint4*>(vbase + (size_t)0 * 2048 + (kt) * 64); \
    vreg1 = *reinterpret_cast<const uint4*>(vbase + (size_t)64 * 2048 + (kt) * 64); \
    vreg2 = *reinterpret_cast<const uint4*>(vbase + (size_t)128 * 2048 + (kt) * 64); \
    vreg3 = *reinterpret_cast<const uint4*>(vbase + (size_t)192 * 2048 + (kt) * 64); } while (0)
#define store_tile() do { \
    *reinterpret_cast<uint4*>(kdst) = kreg0; *reinterpret_cast<uint4*>(kdst + 16 * 264) = kreg1; \
    *reinterpret_cast<uint4*>(kdst + 32 * 264) = kreg2; *reinterpret_cast<uint4*>(kdst + 48 * 264) = kreg3; \
    *reinterpret_cast<uint4*>(vdst) = vreg0; *reinterpret_cast<uint4*>(vdst + 64 * 72) = vreg1; \
    *reinterpret_cast<uint4*>(vdst + 128 * 72) = vreg2; *reinterpret_cast<uint4*>(vdst + 192 * 72) = vreg3; } while (0)
  load_tile(0);
  for (int kt = 0; kt < 4; ++kt) {
    __syncthreads();
    store_tile();
    __syncthreads();
    if (kt + 1 < 4) load_tile(kt + 1);
    fw.tile(Ks, Vts);
  }
  const float inv = 1.f / fw.lsum(0);
  u16* op = oc + (size_t)(tok0 + w * 16 + fr) * 1024 + h * 256;
#pragma unroll
  for (int d = 0; d < 16; ++d) {
    uint2 ov;
    ov.x = pack2(fw.o[0][d][0] * inv, fw.o[0][d][1] * inv);
    ov.y = pack2(fw.o[0][d][2] * inv, fw.o[0][d][3] * inv);
    *reinterpret_cast<uint2*>(op + d * 16 + fq * 4) = ov;
  }
  __syncthreads();
}

#undef load_tile
#undef store_tile
DI float row8_sum(float x) {
  x += dpp_f<0xB1>(x);
  x += dpp_f<0x4E>(x);
  x += dpp_f<0x141>(x);
  return x;
}
DI f32v2 bfpair(unsigned q) { f32v2 r; r.x = __uint_as_float(q << 16); r.y = __uint_as_float(q & 0xffff0000u); return r; }

DI void rwkv_scan_item(const PRef& p, int b, int h, int half) {
  extern __shared__ __attribute__((aligned(16))) u16 shm[];
  char* buf = reinterpret_cast<char*>(shm);
  float* ybuf = reinterpret_cast<float*>(buf + 2 * 16 * 1152);
  float* dummy = ybuf + 1024;
  const char* rec = p.ws + OFF_REC + (size_t)((b * 4 + h) * SEQ) * 1152;
  float* Y = (float*)(p.ws + OFF_Y);
  const int tid = ltid(), w = tid >> 6, lane = tid & 63;
  const int rl = (w & 3) * 8 + (lane >> 3);
  const int row = half * 32 + rl;
  const int ks = (lane & 7) * 8;
  const bool compute = w < 4;
  const bool leader = (lane & 7) == 0;
  float* ydst0 = leader ? (ybuf + rl) : (dummy + (tid & 255));
  const int ystride = leader ? 32 : 0;
  f32v2 S01 = {0.f, 0.f}, S23 = {0.f, 0.f}, S45 = {0.f, 0.f}, S67 = {0.f, 0.f};
  uint4 rg0, rg1, rg2 = make_uint4(0, 0, 0, 0);
  auto load_chunk = [&](int ch) {
    const uint4* src = reinterpret_cast<const uint4*>(rec + (size_t)ch * 16 * 1152);
    rg0 = src[tid]; rg1 = src[tid + 512];
    if (tid < 128) rg2 = src[tid + 1024];
  };
  load_chunk(0);
  __syncthreads();
  for (int ch = 0; ch < SEQ / 16; ++ch) {
    char* cb = buf + (ch & 1) * 16 * 1152;
    {
      uint4* dst = reinterpret_cast<uint4*>(cb);
      dst[tid] = rg0; dst[tid + 512] = rg1;
      if (tid < 128) dst[tid + 1024] = rg2;
    }
    __syncthreads();
    if (ch + 1 < SEQ / 16) load_chunk(ch + 1);
    if (ch > 0) {
      const float* ybp = ybuf + ((ch - 1) & 1) * 512;
      const int st = tid >> 5, r = tid & 31;
      Y[(size_t)(b * SEQ + (ch - 1) * 16 + st) * 256 + h * 64 + half * 32 + r] = ybp[tid];
    }
    if (compute) {
      float* yd = ydst0 + (leader ? (ch & 1) * 512 : 0);
      const char* sp = cb;
      float4 wa = *reinterpret_cast<const float4*>(sp + ks * 4), wb = *reinterpret_cast<const float4*>(sp + ks * 4 + 16);
      float4 ka = *reinterpret_cast<const float4*>(sp + 256 + ks * 4), kb = *reinterpret_cast<const float4*>(sp + 256 + ks * 4 + 16);
      float4 ba = *reinterpret_cast<const float4*>(sp + 512 + ks * 4), bbv = *reinterpret_cast<const float4*>(sp + 512 + ks * 4 + 16);
      uint4 kq = *reinterpret_cast<const uint4*>(sp + 768 + ks * 2);
      uint4 rq = *reinterpret_cast<const uint4*>(sp + 896 + ks * 2);
      unsigned vq = *reinterpret_cast<const u16*>(sp + 1024 + row * 2);
#pragma unroll
      for (int st = 0; st < 16; ++st) {
        float4 wan, wbn, kan, kbn, ban, bbn; uint4 kqn, rqn; unsigned vqn;
        if (st < 15) {
          const char* sn = cb + (st + 1) * 1152;
          wan = *reinterpret_cast<const float4*>(sn + ks * 4); wbn = *reinterpret_cast<const float4*>(sn + ks * 4 + 16);
          kan = *reinterpret_cast<const float4*>(sn + 256 + ks * 4); kbn = *reinterpret_cast<const float4*>(sn + 256 + ks * 4 + 16);
          ban = *reinterpret_cast<const float4*>(sn + 512 + ks * 4); bbn = *reinterpret_cast<const float4*>(sn + 512 + ks * 4 + 16);
          kqn = *reinterpret_cast<const uint4*>(sn + 768 + ks * 2);
          rqn = *reinterpret_cast<const uint4*>(sn + 896 + ks * 2);
          vqn = *reinterpret_cast<const u16*>(sn + 1024 + row * 2);
        }
        const float v = __uint_as_float(vq << 16);
        const f32v2 vv = {v, v};
        const f32v2 kk01 = {ka.x, ka.y}, kk23 = {ka.z, ka.w}, kk45 = {kb.x, kb.y}, kk67 = {kb.z, kb.w};
        f32v2 sa2 = S01 * kk01 + S23 * kk23;
        f32v2 sb2 = S45 * kk45 + S67 * kk67;
        sa2 += sb2;
        float sa = row8_sum(sa2.x + sa2.y);
        const f32v2 sav = {sa, sa};
        S01 = S01 * f32v2{wa.x, wa.y} - sav * f32v2{ba.x, ba.y} + vv * bfpair(kq.x);
        S23 = S23 * f32v2{wa.z, wa.w} - sav * f32v2{ba.z, ba.w} + vv * bfpair(kq.y);
        S45 = S45 * f32v2{wb.x, wb.y} - sav * f32v2{bbv.x, bbv.y} + vv * bfpair(kq.z);
        S67 = S67 * f32v2{wb.z, wb.w} - sav * f32v2{bbv.z, bbv.w} + vv * bfpair(kq.w);
        f32v2 ya = S01 * bfpair(rq.x) + S23 * bfpair(rq.y);
        f32v2 yb2 = S45 * bfpair(rq.z) + S67 * bfpair(rq.w);
        ya += yb2;
        float y = row8_sum(ya.x + ya.y);
        yd[st * ystride] = y;
        if (st < 15) { wa = wan; wb = wbn; ka = kan; kb = kbn; ba = ban; bbv = bbn; kq = kqn; rq = rqn; vq = vqn; }
      }
    }
  }
  __syncthreads();
  {
    const int ch = SEQ / 16 - 1;
    const float* ybp = ybuf + (ch & 1) * 512;
    const int st = tid >> 5, r = tid & 31;
    Y[(size_t)(b * SEQ + ch * 16 + st) * 256 + h * 64 + half * 32 + r] = ybp[tid];
  }
  __syncthreads();
}

DI float gelu_tanh(float x) {
  float u = 0.7978845608028654f * (x + 0.044715f * x * x * x);
  return 0.5f * x * (1.f + tanhf(u));
}
DI void s5_item(const PRef& p, int l, int b, int g) {
  extern __shared__ __attribute__((aligned(16))) u16 shm[];
  float* uL = reinterpret_cast<float*>(shm);
  float* fin = uL + 8 * 256;
  float* xL = fin + 8 * 128;
  const u16* s5 = (const u16*)(p.ws + OFF_S5);
  u16* Z = (u16*)(p.ws + OFF_Z);
  const int tid = ltid(), w = tid >> 6, lane = tid & 63;
  const float Are = ((const float*)p.in[I_SARE])[(l * 16 + g) * 64 + lane];
  const float Aim = ((const float*)p.in[I_SAIM])[(l * 16 + g) * 64 + lane];
  const float delta = expf(((const float*)p.in[I_SLOG])[l * 16 + g]);
  float cr, ci;
  {
    float er = expf(delta * Are); float sn, cs; sincosf(delta * Aim, &sn, &cs);
    cr = er * cs; ci = er * sn;
  }
  float Bre[16], Bim[16];
  {
    const float x = cr - 1.f, y = ci, den = 1.f / (Are * Are + Aim * Aim);
    const float qre = (x * Are + y * Aim) * den, qim = (y * Are - x * Aim) * den;
    const float* bre = (const float*)p.in[I_SBRE] + ((size_t)(l * 16 + g) * 64 + lane) * 16;
    const float* bim = (const float*)p.in[I_SBIM] + ((size_t)(l * 16 + g) * 64 + lane) * 16;
#pragma unroll
    for (int hh = 0; hh < 16; ++hh) { float br = bre[hh], bi = bim[hh]; Bre[hh] = qre * br - qim * bi; Bim[hh] = qre * bi + qim * br; }
  }
  __syncthreads();
  bf16x8 cf[4];
  {
    const int hq = lane & 15, q4 = lane >> 4;
    const float* cre = (const float*)p.in[I_SCRE] + ((size_t)(l * 16 + g) * 16 + hq) * 64;
    const float* cim = (const float*)p.in[I_SCIM] + ((size_t)(l * 16 + g) * 16 + hq) * 64;
#pragma unroll
    for (int s4 = 0; s4 < 4; ++s4) {
      const float4 re = *reinterpret_cast<const float4*>(cre + 16 * s4 + 4 * q4);
      const float4 im = *reinterpret_cast<const float4*>(cim + 16 * s4 + 4 * q4);
      cf[s4] = __builtin_bit_cast(bf16x8, (u32x4{pack2(re.x, -im.x), pack2(re.y, -im.y), pack2(re.z, -im.z), pack2(re.w, -im.w)}));
    }
  }
  const int tbase = b * SEQ + w * 512;
  float* uw = uL + w * 256;
  auto load_u = [&](int ch) {
    const int tt = lane >> 2, c4 = (lane & 3) * 4;
    uint2 raw = *reinterpret_cast<const uint2*>(s5 + (size_t)(tbase + ch * 16 + tt) * 256 + g * 16 + c4);
    float4 f; f.x = __uint_as_float(raw.x << 16); f.y = __uint_as_float(raw.x & 0xffff0000u);
    f.z = __uint_as_float(raw.y << 16); f.w = __uint_as_float(raw.y & 0xffff0000u);
    *reinterpret_cast<float4*>(uw + tt * 16 + c4) = f;
  };
  float xr = 0.f, xi = 0.f;
  for (int ch = 0; ch < 32; ++ch) {
    __syncthreads();
    load_u(ch);
    __syncthreads();
#pragma unroll 4
    for (int tt = 0; tt < 16; ++tt) {
      float bur = 0.f, bui = 0.f;
#pragma unroll
      for (int h4 = 0; h4 < 4; ++h4) {
        float4 u = *reinterpret_cast<const float4*>(uw + tt * 16 + h4 * 4);
        bur += Bre[h4 * 4] * u.x + Bre[h4 * 4 + 1] * u.y + Bre[h4 * 4 + 2] * u.z + Bre[h4 * 4 + 3] * u.w;
        bui += Bim[h4 * 4] * u.x + Bim[h4 * 4 + 1] * u.y + Bim[h4 * 4 + 2] * u.z + Bim[h4 * 4 + 3] * u.w;
      }
      float nr = cr * xr - ci * xi + bur, ni = cr * xi + ci * xr + bui;
      xr = nr; xi = ni;
    }
  }
  fin[(w * 64 + lane) * 2] = xr; fin[(w * 64 + lane) * 2 + 1] = xi;
  __syncthreads();
  {
    float pr = cr, pi = ci;
    for (int i = 0; i < 9; ++i) { float nr = pr * pr - pi * pi, ni = 2.f * pr * pi; pr = nr; pi = ni; }
    float vr = 0.f, vi = 0.f;
    for (int ww = 0; ww < w; ++ww) {
      float fr_ = fin[(ww * 64 + lane) * 2], fi_ = fin[(ww * 64 + lane) * 2 + 1];
      float nr = pr * vr - pi * vi + fr_, ni = pr * vi + pi * vr + fi_;
      vr = nr; vi = ni;
    }
    xr = vr; xi = vi;
  }
  float* xw = xL + w * (16 * 66 * 2);
  const int ot = lane & 15, oh = (lane >> 4) * 4;
  const float* dsk = (const float*)p.in[I_SD] + l * 256 + g * 16 + oh;
  const float d0 = dsk[0], d1 = dsk[1], d2 = dsk[2], d3 = dsk[3];
  for (int ch = 0; ch < 32; ++ch) {
    __syncthreads();
    load_u(ch);
    __syncthreads();
#pragma unroll 4
    for (int tt = 0; tt < 16; ++tt) {
      float bur = 0.f, bui = 0.f;
#pragma unroll
      for (int h4 = 0; h4 < 4; ++h4) {
        float4 u = *reinterpret_cast<const float4*>(uw + tt * 16 + h4 * 4);
        bur += Bre[h4 * 4] * u.x + Bre[h4 * 4 + 1] * u.y + Bre[h4 * 4 + 2] * u.z + Bre[h4 * 4 + 3] * u.w;
        bui += Bim[h4 * 4] * u.x + Bim[h4 * 4 + 1] * u.y + Bim[h4 * 4 + 2] * u.z + Bim[h4 * 4 + 3] * u.w;
      }
      float nr = cr * xr - ci * xi + bur, ni = cr * xi + ci * xr + bui;
      xr = nr; xi = ni;
      *reinterpret_cast<float2*>(xw + (tt * 66 + lane) * 2) = make_float2(xr, xi);
    }
    __syncthreads();
    f32x4 yacc = f32x4{0.f, 0.f, 0.f, 0.f};
#pragma unroll
    for (int s4 = 0; s4 < 4; ++s4) {
      const float* xp = xw + (ot * 66 + 16 * s4 + oh) * 2;
      const float4 f0 = *reinterpret_cast<const float4*>(xp), f1 = *reinterpret_cast<const float4*>(xp + 4);
      const bf16x8 xf = __builtin_bit_cast(bf16x8, (u32x4{pack2(f0.x, f0.y), pack2(f0.z, f0.w), pack2(f1.x, f1.y), pack2(f1.z, f1.w)}));
      yacc = __builtin_amdgcn_mfma_f32_16x16x32_bf16(cf[s4], xf, yacc, 0, 0, 0);
    }
    float a0 = yacc[0], a1 = yacc[1], a2 = yacc[2], a3 = yacc[3];
    float4 u = *reinterpret_cast<const float4*>(uw + ot * 16 + oh);
    a0 = gelu_tanh(a0 + d0 * u.x); a1 = gelu_tanh(a1 + d1 * u.y); a2 = gelu_tanh(a2 + d2 * u.z); a3 = gelu_tanh(a3 + d3 * u.w);
    uint2 ov; ov.x = pack2(a0, a1); ov.y = pack2(a2, a3);
    *reinterpret_cast<uint2*>(Z + (size_t)(tbase + ch * 16 + ot) * 256 + g * 16 + oh) = ov;
  }
  __syncthreads();
}

DI void phase_mixers(const PRef& p, int lc) {
  __shared__ int s_item;
  unsigned* cnt = (unsigned*)(p.ws + OFF_CNT) + lc;
  const int l = lc & 7;
  const int total = 64 + 128 + 1024;
  while (true) {
    __syncthreads();
    if (ltid() == 0) s_item = (int)atomicAdd(cnt, 1u);
    __syncthreads();
    const int item = s_item;
    if (item >= total) break;
    kaptr_t ka2 = p.in.ka; asm volatile("" : "+s"(ka2)); const PRef q(ka2);
    const int cls = (lc >= 8) ? (PROBE_DUP >> 4) : 7;
    if (item < 64) { if (cls & 1) rwkv_scan_item(q, item >> 3, (item >> 1) & 3, item & 1); }
    else if (item < 192) { int i = item - 64; if (cls & 2) s5_item(q, l, i >> 4, i & 15); }
    else { int i = item - 192; int qt = 31 - (i >> 5); int bh = i & 31; if (cls & 4) diff_attn_item(q, l, bh >> 2, bh & 3, qt); }
  }
}

DI void phase_post(const PRef& p, int l) {
  const float* Y = (const float*)(p.ws + OFF_Y);
  const u16* gbuf = (const u16*)(p.ws + OFF_G);
  const u16* Z = (const u16*)(p.ws + OFF_Z);
  const float* bonus = (const float*)(p.ws + OFF_BONUS);
  const char* rec = p.ws + OFF_REC;
  u16* hcat = (u16*)(p.ws + OFF_HCAT);
  const u16* glut = (const u16*)(p.ws + OFF_WT + WT_GLU);
  const float* lng = (const float*)p.in[I_LNXG] + l * 256;
  const float* lnb = (const float*)p.in[I_LNXB] + l * 256;
  const float* glub = (const float*)p.in[I_GLUB] + l * 256;
  const float* outg = (const float*)p.in[I_SOUTG] + l * 256;
  const int tid = ltid(), w = tid >> 6, lane = tid & 63, fr = lane & 15, fq = lane >> 4;
  extern __shared__ __attribute__((aligned(16))) u16 shm[];
  {
    const uint4* g4 = reinterpret_cast<const uint4*>(glut);
    uint4* l4 = reinterpret_cast<uint4*>(shm);
#pragma unroll 4
    for (int i = 0; i < 16; ++i) {
      const int idx = tid + i * 512, row = idx >> 5, ch = idx & 31;
      l4[row * 32 + (ch ^ (row & 15))] = g4[idx];
    }
  }
  __syncthreads();
  for (int item = blockIdx.x; item < NTOK / 128; item += gridDim.x) {
    const int tk0 = item * 128;
    {
      const int c = tid & 255, half = tid >> 8, h = c >> 6, cc = c & 63;
      const float gw = lng[c], gb = lnb[c];
      for (int i0 = 0; i0 < 64; i0 += 8) {
        float yv[8], vv[8], gq[8], bo[8];
#pragma unroll
        for (int u = 0; u < 8; ++u) {
          const int tok = tk0 + half * 64 + i0 + u;
          const int b = tok >> 12, t = tok & (SEQ - 1);
          const char* rp = rec + ((size_t)((b * 4 + h) * SEQ + t)) * 1152;
          yv[u] = Y[(size_t)tok * 256 + c];
          vv[u] = bf2f(reinterpret_cast<const u16*>(rp + 1024)[cc]);
          gq[u] = bf2f(gbuf[(size_t)tok * 256 + c]);
          bo[u] = bonus[(size_t)tok * 4 + h];
        }
        float mean[8], var[8];
#pragma unroll
        for (int u = 0; u < 8; ++u) { mean[u] = wave_sum(yv[u]) * (1.f / 64.f); }
#pragma unroll
        for (int u = 0; u < 8; ++u) { float d = yv[u] - mean[u]; var[u] = wave_sum(d * d) * (1.f / 64.f); }
#pragma unroll
        for (int u = 0; u < 8; ++u) {
          const int tok = tk0 + half * 64 + i0 + u;
          float out = (yv[u] - mean[u]) * rsqrtf(var[u] + 64e-5f) * gw + gb + bo[u] * vv[u];
          out *= gq[u];
          hcat[(size_t)tok * 1024 + 512 + c] = f2bf(out);
        }
      }
    }
    {
      const int tokw = tk0 + w * 16;
      bf16x8 zf[8];
#pragma unroll
      for (int s = 0; s < 8; ++s) zf[s] = *reinterpret_cast<const bf16x8*>(Z + (size_t)(tokw + fr) * 256 + s * 32 + fq * 8);
      float ss = 0.f, rms = 0.f;
      for (int pass = 0; pass < 2; ++pass) {
#pragma unroll 2
        for (int nb = 0; nb < 16; ++nb) {
          f32x4 acc = f32x4{0.f, 0.f, 0.f, 0.f};
#pragma unroll
          for (int s = 0; s < 8; ++s) {
            bf16x8 wf = *reinterpret_cast<const bf16x8*>(shm + ((nb * 16 + fr) * 32 + ((s * 4 + fq) ^ fr)) * 8);
            acc = __builtin_amdgcn_mfma_f32_16x16x32_bf16(wf, zf[s], acc, 0, 0, 0);
          }
          const int col = nb * 16 + fq * 4;
          uint2 zr = *reinterpret_cast<const uint2*>(Z + (size_t)(tokw + fr) * 256 + col);
          float z0 = __uint_as_float(zr.x << 16), z1 = __uint_as_float(zr.x & 0xffff0000u);
          float z2 = __uint_as_float(zr.y << 16), z3 = __uint_as_float(zr.y & 0xffff0000u);
          float o0 = z0 * sigmoidf_(acc[0] + glub[col]), o1 = z1 * sigmoidf_(acc[1] + glub[col + 1]);
          float o2 = z2 * sigmoidf_(acc[2] + glub[col + 2]), o3 = z3 * sigmoidf_(acc[3] + glub[col + 3]);
          if (pass == 0) ss += o0 * o0 + o1 * o1 + o2 * o2 + o3 * o3;
          else {
            uint2 ov;
            ov.x = pack2(o0 * rms * outg[col], o1 * rms * outg[col + 1]);
            ov.y = pack2(o2 * rms * outg[col + 2], o3 * rms * outg[col + 3]);
            *reinterpret_cast<uint2*>(hcat + (size_t)(tokw + fr) * 1024 + 768 + col) = ov;
          }
        }
        if (pass == 0) { ss += __shfl_xor(ss, 16); ss += __shfl_xor(ss, 32); rms = rsqrtf(ss * (1.f / 256.f) + 1e-6f); }
      }
    }
  }
}

DI void phase_ln(const PRef& p, const float* g, const float* bta) {
  float* xs = p.xs; u16* xb = (u16*)(p.ws + OFF_XB);
  const int w = ltid() >> 6, lane = ltid() & 63;
  for (int tok = blockIdx.x * 8 + w; tok < NTOK; tok += gridDim.x * 8) {
    float4* row = reinterpret_cast<float4*>(xs + (size_t)tok * DM);
    float4 v[4]; float s = 0.f;
    for (int i = 0; i < 4; ++i) { v[i] = row[lane + i * 64]; s += v[i].x + v[i].y + v[i].z + v[i].w; }
    const float mean = wave_sum(s) * (1.f / 1024.f);
    float q = 0.f;
    for (int i = 0; i < 4; ++i) { float a = v[i].x - mean, b = v[i].y - mean, c = v[i].z - mean, d = v[i].w - mean; q += a * a + b * b + c * c + d * d; }
    const float rstd = rsqrtf(wave_sum(q) * (1.f / 1024.f) + 1e-5f);
    for (int i = 0; i < 4; ++i) {
      const int col = (lane + i * 64) * 4;
      float4 gg = *reinterpret_cast<const float4*>(g + col), bb = *reinterpret_cast<const float4*>(bta + col);
      float4 o;
      o.x = (v[i].x - mean) * rstd * gg.x + bb.x; o.y = (v[i].y - mean) * rstd * gg.y + bb.y;
      o.z = (v[i].z - mean) * rstd * gg.z + bb.z; o.w = (v[i].w - mean) * rstd * gg.w + bb.w;
      row[lane + i * 64] = o;
      uint2 ob; ob.x = pack2(o.x, o.y); ob.y = pack2(o.z, o.w);
      *reinterpret_cast<uint2*>(xb + (size_t)tok * DM + col) = ob;
    }
  }
}

DI void phase_conv(const PRef& p, int l) {
  char* ws = p.ws;
  u16* hmid = (u16*)(ws + OFF_AG);
  const float* af = (const float*)(ws + OFF_AF); const float* gf = (const float*)(ws + OFF_GF); const float* al = (const float*)(ws + OFF_AL);
  const float* cw = (const float*)p.in[I_CONVW] + (size_t)l * 3 * DFF;
  const float* cb = (const float*)p.in[I_CONVB] + (size_t)l * DFF;
  for (int it = blockIdx.x * 512 + ltid(); it < 128 * DFF; it += gridDim.x * 512) {
    const int pm = it / DFF, c = it % DFF;
    const float a0 = af[(size_t)(pm * 2) * DFF + c], a1 = af[(size_t)(pm * 2 + 1) * DFF + c];
    const float g0 = gf[(size_t)(pm * 2) * DFF + c], g1 = gf[(size_t)(pm * 2 + 1) * DFF + c];
    float l0 = 0.f, l1 = 0.f;
    if ((pm & 15) != 0) { l0 = al[(size_t)((pm - 1) * 2) * DFF + c]; l1 = al[(size_t)((pm - 1) * 2 + 1) * DFF + c]; }
    const float w0 = cw[c], w1 = cw[DFF + c], w2 = cw[2 * DFF + c], bs = cb[c];
    const float cv0 = bs + w0 * l0 + w1 * l1 + w2 * a0;
    const float cv1 = bs + w0 * l1 + w1 * a0 + w2 * a1;
    hmid[(size_t)(pm * 256) * DFF + c] = f2bf(cv0 * sigmoidf_(cv0) * g0);
    hmid[(size_t)(pm * 256 + 1) * DFF + c] = f2bf(cv1 * sigmoidf_(cv1) * g1);
  }
}

DI void phase_gemm(const PRef& p, int kind, int l) {
  int nN = 4, K = 1024, lda = 1024, ldb = 1024;
  if (kind == 0) nN = 9;
  if (kind == 10) nN = 22;
  if (kind == 12) { lda = 2816; ldb = 2816; K = 2816; }
  const int ntile = 128 * nN;
  const bool remap = (gridDim.x & 7) == 0;
  const int per = remap ? (ntile >> 3) : ntile, xcd = blockIdx.x & 7;
  const int slot = remap ? (int)(blockIdx.x >> 3) : (int)blockIdx.x, nslot = remap ? (int)(gridDim.x >> 3) : (int)gridDim.x;
  const int n_main = (slot < per) ? (per - slot + nslot - 1) / nslot : 0;
  const int t0x = remap ? (int)((((blockIdx.x >> 3) + 16) & 31) * 8 + (blockIdx.x & 7)) : (int)blockIdx.x;
  const int n_extra = (kind == 0 && t0x < 320) ? (320 - t0x + (int)gridDim.x - 1) / (int)gridDim.x : 0;
  const kaptr_t ka = p.in.ka;
  auto tile_fn = [&](int idx) -> TileDesc {
    const PRef q(ka);
    char* ws = q.ws; char* wt = ws + OFF_WT;
    const u16* xb = (const u16*)(ws + OFF_XB);
    TileDesc d; d.sub = 0; d.A = xb;
    if (idx < n_main) {
      const int jj = slot + idx * nslot;
      const int t = remap ? xcd * per + jj : jj;
      int pm = t / nN, pn = t % nN;
      if (kind == 0) { d.B = (const u16*)(wt + WT_IN); pn = (pn < 4) ? pn : pn + 2; }
      else if (kind == 4) { d.A = (const u16*)(ws + OFF_HCAT); d.B = (const u16*)(wt + WT_OUT); }
      else if (kind == 6) d.B = (const u16*)(wt + WT_Q);
      else if (kind == 8) { d.A = (const u16*)(ws + OFF_OC); d.B = (const u16*)(wt + WT_O); }
      else if (kind == 10) d.B = (const u16*)(wt + WT_UP);
      else { d.A = (const u16*)(ws + OFF_AG); d.B = (const u16*)(wt + WT_DOWN); }
      d.brow = pm * 256; d.bcol = pn * 256;
    } else {
      const int t = t0x + (idx - n_main) * (int)gridDim.x;
      const u16* wint = (const u16*)(wt + WT_IN); const u16* wkvt = (const u16*)(wt + WT_KV); const u16* memb = (const u16*)(ws + OFF_MEMB);
      int pm, pn;
      if (t < 256) { pn = t >> 1; pm = t & 1; d.A = wint + (size_t)1024 * 1024; d.B = xb; d.sub = 1; }
      else if (t < 288) { int i = t - 256; pm = i >> 2; pn = i & 3; d.A = memb; d.B = wkvt; d.sub = 2; }
      else { int i = t - 288; pm = i >> 3; pn = i & 7; d.A = wkvt + (size_t)1024 * 1024; d.B = memb; d.sub = 3; }
      d.brow = pm * 256; d.bcol = pn * 256;
    }
    return d;
  };
  EpiGen e; e.kind = kind; e.lay = l; e.ka = ka;
  gemm_stream(n_main + n_extra, lda, ldb, K, tile_fn, e);
}
DI void phase_cross(const PRef& p) {
  for (int it = blockIdx.x; it < 1024; it += gridDim.x) cross_attn_item(p, it >> 2, it & 3);
}

constexpr int PH_PER_LAYER = 14, N_PHASES = 1 + DEPTH * PH_PER_LAYER;

DI void run_phase(const PRef& p, int ph) {
  if (ph == 0) { phase_init(p); phase_transposes(p, 0); return; }
  const int l = (ph - 1) / PH_PER_LAYER, s = (ph - 1) % PH_PER_LAYER;
  if (s == 0 || s == 4 || s == 6 || s == 8 || s == 10 || s == 12) {
    phase_gemm(p, s, l);
    if ((PROBE_DUP & 1) && (s == 0 || s == 6 || s == 10)) phase_gemm(p, s, l);
    return;
  }
  switch (s) {
    case 1: phase_prep(p, l); break;
    case 2: phase_mixers(p, l); if (PROBE_DUP & 2) phase_mixers(p, l + 8); break;
    case 3: phase_post(p, l); if (PROBE_DUP & 8) phase_post(p, l); break;
    case 5: phase_ln(p, (const float*)p.in[I_LN1G] + l * DM, (const float*)p.in[I_LN1B] + l * DM); break;
    case 7: phase_cross(p); if (PROBE_DUP & 4) phase_cross(p); break;
    case 9: phase_ln(p, (const float*)p.in[I_LN2G] + l * DM, (const float*)p.in[I_LN2B] + l * DM); break;
    case 11: phase_conv(p, l); break;
    case 13:
      phase_ln(p, (const float*)p.in[I_LN3G] + l * DM, (const float*)p.in[I_LN3B] + l * DM);
      if (l + 1 < DEPTH) phase_transposes(p, l + 1);
      break;
  }
}

template <int S>
__global__ void __launch_bounds__(512) ph_kernel(Params p_unused, int l) {
  kaptr_t ka = (kaptr_t)__builtin_amdgcn_kernarg_segment_ptr();
  const PRef p(ka);
  if (S < 0) { phase_init(p); phase_transposes(p, 0); return; }
  if (S == 0 || S == 4 || S == 6 || S == 8 || S == 10 || S == 12) { phase_gemm(p, S, l); return; }
  if (S == 1) phase_prep(p, l);
  if (S == 2) phase_mixers(p, l);
  if (S == 3) phase_post(p, l);
  if (S == 5) phase_ln(p, (const float*)p.in[I_LN1G] + l * DM, (const float*)p.in[I_LN1B] + l * DM);
  if (S == 7) phase_cross(p);
  if (S == 9) phase_ln(p, (const float*)p.in[I_LN2G] + l * DM, (const float*)p.in[I_LN2B] + l * DM);
  if (S == 11) phase_conv(p, l);
  if (S == 13) {
    phase_ln(p, (const float*)p.in[I_LN3G] + l * DM, (const float*)p.in[I_LN3B] + l * DM);
    if (l + 1 < DEPTH) phase_transposes(p, l + 1);
  }
}

#if !MULTI_LAUNCH
__device__ unsigned g_bar = 0;
#ifndef USE_COOP
#define USE_COOP 1
#endif

__global__ void __launch_bounds__(512) fwd_kernel(Params p_unused, int ph_begin_arg, int ph_end_arg) {
  constexpr int ph_begin = 0, ph_end = N_PHASES;
#if USE_COOP
  cg::this_grid().sync();
#endif
  __shared__ unsigned s_base;
  for (int ph = ph_begin; ph < ph_end; ++ph) {
    kaptr_t ka = (kaptr_t)__builtin_amdgcn_kernarg_segment_ptr();
    asm volatile("" : "+s"(ka));
    const PRef p(ka);
    run_phase(p, ph);
    if (ph + 1 < ph_end) {
      asm volatile("s_waitcnt vmcnt(0) lgkmcnt(0)" ::: "memory");
      __syncthreads();
      if (threadIdx.x == 0) {
        __builtin_amdgcn_fence(__ATOMIC_RELEASE, "agent");
        asm volatile("s_waitcnt vmcnt(0)" ::: "memory");
        const unsigned nbar = (unsigned)(ph - ph_begin + 1);
        unsigned old = __hip_atomic_fetch_add(&g_bar, 1u, __ATOMIC_RELAXED, __HIP_MEMORY_SCOPE_AGENT);
        if (nbar == 1) { const unsigned per_launch = (unsigned)(ph_end - ph_begin - 1) * gridDim.x; s_base = old - (old % per_launch); }
        const unsigned target = s_base + nbar * gridDim.x;
        while ((int)(__hip_atomic_load(&g_bar, __ATOMIC_RELAXED, __HIP_MEMORY_SCOPE_AGENT) - target) < 0) __builtin_amdgcn_s_sleep(4);
        __builtin_amdgcn_fence(__ATOMIC_ACQUIRE, "agent");
        asm volatile("s_waitcnt vmcnt(0)" ::: "memory");
      }
      __syncthreads();
    }
  }
}
#endif

constexpr size_t kDynLds = 131072 + 4096;

template <int S> static void launch_ph(const Params& p, int l, int grid, hipStream_t stream) {
  static bool attr_done = false;
  if (!attr_done) { (void)hipFuncSetAttribute((const void*)ph_kernel<S>, hipFuncAttributeMaxDynamicSharedMemorySize, (int)kDynLds); attr_done = true; }
  hipLaunchKernelGGL(ph_kernel<S>, dim3(grid), dim3(512), kDynLds, stream, p, l);
}

extern "C" void kernel_launch(void* const* d_in, const int* in_sizes, int n_in, void* d_out, int out_size, void* d_ws, size_t ws_size,
                              hipStream_t stream) {
  Params p;
  memset(&p, 0, sizeof(p));
  for (int i = 0; i < N_IN && i < n_in; ++i) p.in[i] = d_in[i];
  p.xs = (float*)d_out;
  p.ws = (char*)d_ws;
  for (int l = 0; l < 4; ++l) p.lam_init[l] = (float)(0.8 - 0.6 * exp(-0.3 * (double)l));
#if MULTI_LAUNCH
  const int grid = 256;
  launch_ph<-1>(p, 0, grid, stream);
  for (int l = 0; l < DEPTH; ++l) {
    launch_ph<0>(p, l, grid, stream); launch_ph<1>(p, l, grid, stream); launch_ph<2>(p, l, grid, stream); launch_ph<3>(p, l, grid, stream);
    launch_ph<4>(p, l, grid, stream); launch_ph<5>(p, l, grid, stream); launch_ph<6>(p, l, grid, stream); launch_ph<7>(p, l, grid, stream);
    launch_ph<8>(p, l, grid, stream); launch_ph<9>(p, l, grid, stream); launch_ph<10>(p, l, grid, stream); launch_ph<11>(p, l, grid, stream);
    launch_ph<12>(p, l, grid, stream); launch_ph<13>(p, l, grid, stream);
  }
#else
  static int grid_blocks = 0;
  if (!grid_blocks) {
    (void)hipFuncSetAttribute((const void*)fwd_kernel, hipFuncAttributeMaxDynamicSharedMemorySize, (int)kDynLds);
    int dev = 0, cus = 0, per_cu = 0;
    (void)hipGetDevice(&dev);
    (void)hipDeviceGetAttribute(&cus, hipDeviceAttributeMultiprocessorCount, dev);
    (void)hipOccupancyMaxActiveBlocksPerMultiprocessor(&per_cu, fwd_kernel, 512, kDynLds);
    if (per_cu < 1) per_cu = 1;
    grid_blocks = cus * per_cu;
    if (grid_blocks <= 0) grid_blocks = 256;
    if (per_cu > 1) grid_blocks = cus;
  }
  int b = 0, e = N_PHASES;
#if USE_COOP
  void* args[] = {&p, &b, &e};
  hipError_t err = hipLaunchCooperativeKernel((void*)fwd_kernel, dim3(grid_blocks), dim3(512), args, kDynLds, stream);
  if (err != hipSuccess) fprintf(stderr, "cooperative launch failed: %s (grid %d)\n", hipGetErrorString(err), grid_blocks);
#else
#ifdef BISECT_PER_PHASE
  for (int ph = 0; ph < N_PHASES; ++ph) hipLaunchKernelGGL(fwd_kernel, dim3(grid_blocks), dim3(512), kDynLds, stream, p, ph, ph + 1);
#else
  hipLaunchKernelGGL(fwd_kernel, dim3(grid_blocks), dim3(512), kDynLds, stream, p, b, e);
#endif
#endif
#endif
}
```

```cpp
#include <hip/hip_runtime.h>
#include <hip/hip_bf16.h>
#include <hip/hip_cooperative_groups.h>
#include <cstdio>
#include <cstring>
#include <cmath>
#include <cstddef>
namespace cg = cooperative_groups;

#ifndef PROBE_DUP
#define PROBE_DUP 0
#endif
#ifndef MULTI_LAUNCH
#define MULTI_LAUNCH 0
#endif

typedef unsigned short u16;
using bf16x8 = __attribute__((ext_vector_type(8))) short;
using f32x4 = __attribute__((ext_vector_type(4))) float;
using u32x4 = __attribute__((ext_vector_type(4))) unsigned;
#define DI __device__ __forceinline__

constexpr int NTOK = 32768, DM = 1024, SEQ = 4096, NBATCH = 8, DEPTH = 4;
constexpr int INW = 2688, DFF = 2816;
constexpr float ALPHA = 1.681792830507429f;
constexpr float LOG2E = 1.4426950408889634f;

enum { I_X = 0, I_MEM, I_POS, I_WIN, I_LQ1, I_LK1, I_LQ2, I_LK2, I_SUBLN, I_MU, I_W0, I_W2, I_A0, I_A2, I_G2, I_KK, I_KA, I_RK,
       I_LNXG, I_LNXB, I_SARE, I_SAIM, I_SBRE, I_SBIM, I_SCRE, I_SCIM, I_SD, I_SLOG, I_GLUW, I_GLUB, I_SOUTG, I_WOUT, I_LN1G, I_LN1B,
       I_WQ, I_WKV, I_WO, I_LN2G, I_LN2B, I_WUP, I_CONVW, I_CONVB, I_WDOWN, I_LN3G, I_LN3B, N_IN };

constexpr size_t MiB = 1024 * 1024;
constexpr size_t OFF_XB = 0;
constexpr size_t OFF_Y = 0, OFF_G = 32 * MiB, OFF_Z = 48 * MiB;
constexpr size_t OFF_WT = 64 * MiB;
constexpr size_t WT_IN = 0, WT_OUT = WT_IN + 2816ul * 1024 * 2, WT_Q = WT_OUT + 2 * MiB, WT_KV = WT_Q + 2 * MiB, WT_O = WT_KV + 4 * MiB,
                 WT_UP = WT_O + 2 * MiB, WT_DOWN = WT_UP + 11 * MiB, WT_GLU = WT_DOWN + 2816ul * 1024 * 2,
                 WT_W2T = WT_GLU + 131072, WT_A2T = WT_W2T + 16384, WT_G2T = WT_A2T + 16384;
constexpr size_t OFF_KMEM = 97 * MiB;
constexpr size_t OFF_VMEMT = 101 * MiB;
constexpr size_t OFF_MEMB = 105 * MiB;
constexpr size_t OFF_ROPE = 109 * MiB;
constexpr size_t OFF_CNT = 117 * MiB;
constexpr size_t OFF_BONUS = 118 * MiB;
constexpr size_t OFF_DR = 120 * MiB;
constexpr size_t OFF_QK = OFF_DR;
constexpr size_t OFF_RW = OFF_DR + 64 * MiB;
constexpr size_t OFF_S5 = OFF_DR + 120 * MiB;
constexpr size_t OFF_VT = OFF_DR + 136 * MiB;
constexpr size_t OFF_HCAT = OFF_DR + 168 * MiB;
constexpr size_t OFF_REC = OFF_DR + 232 * MiB;
constexpr size_t OFF_QC = OFF_DR;
constexpr size_t OFF_OC = OFF_DR + 64 * MiB;
constexpr size_t OFF_AG = OFF_DR;
constexpr size_t OFF_AF = OFF_DR + 200 * MiB;
constexpr size_t OFF_GF = OFF_AF + 3 * MiB;
constexpr size_t OFF_AL = OFF_GF + 3 * MiB;

struct Params {
  const void* in[48];
  float* xs;
  char* ws;
  float lam_init[4];
  int pad[4];
};

typedef const char __attribute__((address_space(4)))* kaptr_t;
struct PRef {
  struct In { kaptr_t ka; DI const void* operator[](int i) const { return *(const void* const __attribute__((address_space(4)))*)(ka + i * 8); } } in;
  struct Xs { kaptr_t ka; DI operator float*() const { return *(float* const __attribute__((address_space(4)))*)(ka + 384); } } xs;
  struct Ws { kaptr_t ka; DI operator char*() const { return *(char* const __attribute__((address_space(4)))*)(ka + 392); } } ws;
  struct Lam { kaptr_t ka; DI float operator[](int i) const { return *(const float __attribute__((address_space(4)))*)(ka + 400 + i * 4); } } lam_init;
  DI explicit PRef(kaptr_t k) : in{k}, xs{k}, ws{k}, lam_init{k} {}
};
static_assert(offsetof(Params, xs) == 384 && offsetof(Params, ws) == 392 && offsetof(Params, lam_init) == 400, "layout");

DI int ltid() { int t = threadIdx.x; asm volatile("" : "+v"(t)); return t; }
typedef __bf16 bf16v2 __attribute__((ext_vector_type(2)));
typedef float f32v2 __attribute__((ext_vector_type(2)));
DI unsigned pack2(float a, float b) { f32v2 v = {a, b}; return __builtin_bit_cast(unsigned, __builtin_convertvector(v, bf16v2)); }
DI u16 f2bf(float x) { return (u16)(pack2(x, 0.f) & 0xffffu); }
DI float bf2f(u16 h) { return __uint_as_float(((unsigned)h) << 16); }
DI float sigmoidf_(float x) { return 1.f / (1.f + __expf(-x)); }
DI float wave_sum_slow(float v) {
  for (int o = 32; o > 0; o >>= 1) v += __shfl_xor(v, o);
  return v;
}
template <int CTRL> DI float dpp_f(float x) {
  return __int_as_float(__builtin_amdgcn_mov_dpp(__float_as_int(x), CTRL, 0xF, 0xF, true));
}
DI float row16_sum(float x) {
  x += dpp_f<0xB1>(x);
  x += dpp_f<0x4E>(x);
  x += dpp_f<0x141>(x);
  x += dpp_f<0x140>(x);
  return x;
}
DI float wave_sum(float v) {
  const int t = __float_as_int(row16_sum(v));
  const float a = __int_as_float(__builtin_amdgcn_readlane(t, 0)), b = __int_as_float(__builtin_amdgcn_readlane(t, 16));
  const float c = __int_as_float(__builtin_amdgcn_readlane(t, 32)), d = __int_as_float(__builtin_amdgcn_readlane(t, 48));
  return (a + b) + (c + d);
}

constexpr int BM = 256, BK = 64, HALF = 128, HT = HALF * BK;

DI int lds_byte(int r, int c) {
  int st = (r >> 4) * 2 + (c >> 5), rr = r & 15, cc = c & 31, ob = rr * 64 + cc * 2;
  return st * 1024 + (ob ^ (((ob >> 9) & 1) << 5));
}
DI void stage_rc(int b, int& R, int& C) {
  int st = b / 1024, sb = b % 1024, swz = sb ^ (((sb >> 9) & 1) << 5);
  R = (st >> 1) * 16 + swz / 64; C = (st & 1) * 32 + (swz % 64) / 2;
}

struct TileDesc { const u16* A; const u16* B; int brow, bcol, sub; };
DI void rope_epilogue(const PRef& p, const f32x4 (&acc)[2][2][4][2], int brow, int bcol, int wr, int wc, int fr, int fq);
template <class TileFn, class Epi>
DI void gemm_stream(int ntiles, int lda, int ldb, int K, TileFn tile_fn, Epi epi) {
  extern __shared__ __attribute__((aligned(16))) u16 shm[];
  if (ntiles <= 0) return;
#define SA(b, h) (shm + ((b) * 2 + (h)) * HT)
#define SB(b, h) (shm + (4 + (b) * 2 + (h)) * HT)
#define STAGE(P, PTR, V, S64, HH, KREL) do { \
    const char* _p = (PTR) + ((KREL) * 128 + (size_t)(2 * (HH)) * (S64)); asm volatile("" : "+s"(_p)); \
    __builtin_amdgcn_global_load_lds((const unsigned*)(_p + (size_t)(V)), (unsigned*)((char*)(P) + tid0 * 16), 16, 0, 0); \
    const char* _q = (PTR) + ((KREL) * 128 + (size_t)(2 * (HH) + 1) * (S64)); asm volatile("" : "+s"(_q)); \
    __builtin_amdgcn_global_load_lds((const unsigned*)(_q + (size_t)(V)), (unsigned*)((char*)(P) + tid0 * 16 + 8192), 16, 0, 0); } while (0)
#define LDA(dst, b, h) for (int m = 0; m < 4; ++m) for (int k = 0; k < 2; ++k) \
    dst[m][k] = *reinterpret_cast<const bf16x8*>((char*)SA(b, h) + lda_base + m * 2048 + k * 1024)
#define LDB(dst, b, h) for (int n = 0; n < 2; ++n) for (int k = 0; k < 2; ++k) \
    dst[n][k] = *reinterpret_cast<const bf16x8*>((char*)SB(b, h) + ldb_base + n * 256 + k * 1024)
#define MMA(ai, bj, At_, Bt_) do { __builtin_amdgcn_s_setprio(1); \
    for (int m = 0; m < 4; ++m) for (int n = 0; n < 2; ++n) for (int k = 0; k < 2; ++k) \
      acc[ai][bj][m][n] = __builtin_amdgcn_mfma_f32_16x16x32_bf16(Bt_[n][k], At_[m][k], acc[ai][bj][m][n], 0, 0, 0); \
    __builtin_amdgcn_s_setprio(0); } while (0)
#define WAIT_V(n) asm volatile("s_waitcnt vmcnt(" #n ")" ::: "memory")
#define WAIT_L(n) asm volatile("s_waitcnt lgkmcnt(" #n ")" ::: "memory")
#define BAR __builtin_amdgcn_s_barrier()
#define SCHED __builtin_amdgcn_sched_barrier(0)
#define SA0(P_, K) STAGE(SA(0, 0), P_, vA, sA64, 0, K)
#define SA0H(P_, K) STAGE(SA(0, 1), P_, vA, sA64, 1, K)
#define SA1(P_, K) STAGE(SA(1, 0), P_, vA, sA64, 0, K)
#define SA1H(P_, K) STAGE(SA(1, 1), P_, vA, sA64, 1, K)
#define SB0(P_, K) STAGE(SB(0, 0), P_, vB, sB64, 0, K)
#define SB0H(P_, K) STAGE(SB(0, 1), P_, vB, sB64, 1, K)
#define SB1(P_, K) STAGE(SB(1, 0), P_, vB, sB64, 0, K)
#define SB1H(P_, K) STAGE(SB(1, 1), P_, vB, sB64, 1, K)

  const int tid = ltid();
  const int tid0 = __builtin_amdgcn_readfirstlane(tid);
  const int wid = tid >> 6, lane = tid & 63, wr = wid >> 2, wc = wid & 3, fr = lane & 15, fq = lane >> 4;
  unsigned vA, vB;
  { int r0, c0; stage_rc(tid * 16, r0, c0); vA = (unsigned)(r0 * lda + c0) * 2u; vB = (unsigned)(r0 * ldb + c0) * 2u; }
  const unsigned sA64 = (unsigned)lda * 128u, sB64 = (unsigned)ldb * 128u;
  const int nt = K / BK;
  const int lda_base = lds_byte(wr * 64 + fr, fq * 8);
  const int ldb_base = lds_byte(wc * 32 + (fr >> 2) * 8 + (fr & 3), fq * 8);
  TileDesc cur = tile_fn(0);
  const char* pA = (const char*)(cur.A + (long)cur.brow * lda);
  const char* pB = (const char*)(cur.B + (long)cur.bcol * ldb);
  SB0(pB, 0); SA0(pA, 0); SB0H(pB, 0); SA0H(pA, 0);
  if (wr == 1) BAR;
  WAIT_V(4); BAR;
  SB1(pB, 1); SA1(pA, 1); SB1H(pB, 1);
  WAIT_V(6); BAR;
  for (int ti = 0; ti < ntiles; ++ti) {
    const TileDesc nxt = tile_fn(ti + 1 < ntiles ? ti + 1 : ti);
    const char* pAn = (const char*)(nxt.A + (long)nxt.brow * lda);
    const char* pBn = (const char*)(nxt.B + (long)nxt.bcol * ldb);
    f32x4 acc[2][2][4][2];
    for (int a = 0; a < 2; ++a) for (int b = 0; b < 2; ++b) for (int m = 0; m < 4; ++m) for (int n = 0; n < 2; ++n) acc[a][b][m][n] = f32x4{0.f, 0.f, 0.f, 0.f};
    bf16x8 At[4][2], B0[2][2], B1[2][2];
    for (int t = 0; t < nt; t += 2) {
      const bool last = (t == nt - 2);
      const char* pA2 = last ? pAn - 256 : pA;
      const char* pB2 = last ? pBn - 256 : pB;
      LDB(B0, 0, 0); SCHED; LDA(At, 0, 0); SA1H(pA, 1);
      WAIT_L(8); BAR; WAIT_L(0); MMA(0, 0, At, B0); BAR; SCHED;
      LDB(B1, 0, 1); SB0(pB2, 2);
      BAR; WAIT_L(0); MMA(0, 1, At, B1); BAR;
      LDA(At, 0, 1); SA0(pA2, 2);
      BAR; WAIT_L(0); MMA(1, 0, At, B0); BAR; SCHED;
      SB0H(pB2, 2);
      WAIT_V(6); BAR; MMA(1, 1, At, B1); BAR;
      LDB(B0, 1, 0); SCHED; LDA(At, 1, 0); SA0H(pA2, 2);
      WAIT_L(8); BAR; WAIT_L(0); MMA(0, 0, At, B0); BAR; SCHED;
      LDB(B1, 1, 1); SB1(pB2, 3);
      BAR; WAIT_L(0); MMA(0, 1, At, B1); BAR;
      LDA(At, 1, 1); SA1(pA2, 3);
      BAR; WAIT_L(0); MMA(1, 0, At, B0); BAR; SCHED;
      SB1H(pB2, 3);
      WAIT_V(6); BAR; MMA(1, 1, At, B1); BAR;
      pA += 256; pB += 256;
    }
    if (wr == 0) BAR;
    if (epi.kind == 0 && cur.sub == 0 && cur.bcol < 1024) {
      const PRef pe(epi.ka);
      rope_epilogue(pe, acc, cur.brow, cur.bcol, wr, wc, fr, fq);
    } else if (epi.kind == 10) {
      const PRef pe(epi.ka);
      up_epilogue(pe, epi.lay, acc, cur.brow, cur.bcol, wr, wc, fr, fq, reinterpret_cast<float*>(reinterpret_cast<char*>(shm) + 131072));
    } else {
#pragma unroll
      for (int ai = 0; ai < 2; ++ai)
#pragma unroll
        for (int bj = 0; bj < 2; ++bj)
#pragma unroll
          for (int m = 0; m < 4; ++m)
            epi(cur.sub, cur.brow + ai * HALF + wr * 64 + m * 16 + fr, cur.bcol + bj * HALF + wc * 32 + fq * 8, acc[ai][bj][m][0], acc[ai][bj][m][1]);
    }
    WAIT_V(0);
    cur = nxt; pA = pAn; pB = pBn;
    if (wr == 1 && ti + 1 < ntiles) BAR;
  }
  __syncthreads();
#undef SA
#undef SB
}

template <int CTRL> DI float dppz(float x) {
  return __int_as_float(__builtin_amdgcn_update_dpp(0, __float_as_int(x), CTRL, 0xF, 0xF, true));
}
DI void up_epilogue(const PRef& p, int l, const f32x4 (&acc)[2][2][4][2], int brow, int bcol, int wr, int wc, int fr, int fq, float* exch) {
  char* ws = p.ws;
  u16* hmid = (u16*)(ws + OFF_AG);
  const int pm = brow >> 8, pn = bcol >> 8;
  const int tc0 = wc * 32 + fq * 8;
  const int cw0 = pn * 128 + tc0;
  const float* cwp = (const float*)p.in[I_CONVW] + (size_t)l * 3 * DFF;
  const float* cbp = (const float*)p.in[I_CONVB] + (size_t)l * DFF;
#pragma unroll
  for (int ai = 0; ai < 2; ++ai)
#pragma unroll
    for (int n = 0; n < 2; ++n) {
      if (fr >= 14) {
        const f32x4 v = acc[ai][0][3][n];
        *reinterpret_cast<float4*>(exch + (((ai * 2 + wr) * 2 + (fr - 14)) * 128 + tc0 + n * 4)) = make_float4(v[0], v[1], v[2], v[3]);
        if (ai == 1 && wr == 1)
          *reinterpret_cast<float4*>((float*)(ws + OFF_AL) + ((size_t)(pm * 2 + (fr - 14)) * DFF + cw0 + n * 4)) = make_float4(v[0], v[1], v[2], v[3]);
      }
      if (ai == 0 && wr == 0 && fr < 2) {
        const f32x4 va = acc[0][0][0][n], vg = acc[0][1][0][n];
        *reinterpret_cast<float4*>((float*)(ws + OFF_AF) + ((size_t)(pm * 2 + fr) * DFF + cw0 + n * 4)) = make_float4(va[0], va[1], va[2], va[3]);
        *reinterpret_cast<float4*>((float*)(ws + OFF_GF) + ((size_t)(pm * 2 + fr) * DFF + cw0 + n * 4)) = make_float4(vg[0], vg[1], vg[2], vg[3]);
      }
    }
  __syncthreads();
#pragma unroll
  for (int ai = 0; ai < 2; ++ai) {
    const int sp = ai * 2 + wr;
#pragma unroll
    for (int m = 0; m < 4; ++m) {
      float o[8];
#pragma unroll
      for (int n = 0; n < 2; ++n) {
        const int c = cw0 + n * 4;
        const float4 w0 = *reinterpret_cast<const float4*>(cwp + c), w1 = *reinterpret_cast<const float4*>(cwp + DFF + c);
        const float4 w2 = *reinterpret_cast<const float4*>(cwp + 2 * DFF + c), bs = *reinterpret_cast<const float4*>(cbp + c);
        const float w0a[4] = {w0.x, w0.y, w0.z, w0.w}, w1a[4] = {w1.x, w1.y, w1.z, w1.w}, w2a[4] = {w2.x, w2.y, w2.z, w2.w}, bsa[4] = {bs.x, bs.y, bs.z, bs.w};
        float p62a[4] = {0.f, 0.f, 0.f, 0.f}, p63a[4] = {0.f, 0.f, 0.f, 0.f};
        if (m == 0 && sp > 0) {
          const float4 p62 = *reinterpret_cast<const float4*>(exch + (((sp - 1) * 2 + 0) * 128 + tc0 + n * 4));
          const float4 p63 = *reinterpret_cast<const float4*>(exch + (((sp - 1) * 2 + 1) * 128 + tc0 + n * 4));
          p62a[0] = p62.x; p62a[1] = p62.y; p62a[2] = p62.z; p62a[3] = p62.w;
          p63a[0] = p63.x; p63a[1] = p63.y; p63a[2] = p63.z; p63a[3] = p63.w;
        }
#pragma unroll
        for (int j = 0; j < 4; ++j) {
          const float a = acc[ai][0][m][n][j], g = acc[ai][1][m][n][j];
          float pr1 = dppz<0x111>(a), pr2 = dppz<0x112>(a);
          if (m == 0) {
            if (fr == 0) { pr1 = p63a[j]; pr2 = p62a[j]; }
            if (fr == 1) { pr2 = p63a[j]; }
          } else {
            const float am = acc[ai][0][m > 0 ? m - 1 : 0][n][j];
            const float mir = dppz<0x140>(am);
            const float swp = dppz<0xB1>(mir);
            if (fr == 0) { pr1 = mir; }
            if (fr < 2) { pr2 = swp; }
          }
          const float cv = bsa[j] + w0a[j] * pr2 + w1a[j] * pr1 + w2a[j] * a;
          o[n * 4 + j] = cv * sigmoidf_(cv) * g;
        }
      }
      uint4 ov; ov.x = pack2(o[0], o[1]); ov.y = pack2(o[2], o[3]); ov.z = pack2(o[4], o[5]); ov.w = pack2(o[6], o[7]);
      *reinterpret_cast<uint4*>(hmid + (size_t)(brow + ai * HALF + wr * 64 + m * 16 + fr) * DFF + cw0) = ov;
    }
  }
  __syncthreads();
}

DI void rope_epilogue(const PRef& p, const f32x4 (&acc)[2][2][4][2], int brow, int bcol, int wr, int wc, int fr, int fq) {
  char* ws = p.ws;
  u16* qk = (u16*)(ws + OFF_QK);
  const float* rc = (const float*)(ws + OFF_ROPE); const float* rs = rc + (size_t)NTOK * 32;
  const int d0 = (wc & 1) * 16 + fq * 4;
#pragma unroll
  for (int ai = 0; ai < 2; ++ai)
#pragma unroll
    for (int m = 0; m < 4; ++m) {
      const int tok = brow + ai * HALF + wr * 64 + m * 16 + fr;
      const float4 c4 = *reinterpret_cast<const float4*>(rc + (size_t)tok * 32 + d0);
      const float4 s4 = *reinterpret_cast<const float4*>(rs + (size_t)tok * 32 + d0);
      const float ca[4] = {c4.x, c4.y, c4.z, c4.w}, sa[4] = {s4.x, s4.y, s4.z, s4.w};
#pragma unroll
      for (int bj = 0; bj < 2; ++bj) {
        const int hh = (bcol >> 6) + bj * 2 + (wc >> 1);
        const float sc = (hh < 8) ? 0.125f * LOG2E : 1.f;
        float o0[4], o1[4];
#pragma unroll
        for (int j = 0; j < 4; ++j) {
          const float t0 = acc[ai][bj][m][0][j], t1 = acc[ai][bj][m][1][j];
          o0[j] = (t0 * ca[j] - t1 * sa[j]) * sc;
          o1[j] = (t1 * ca[j] + t0 * sa[j]) * sc;
        }
        uint4 v; v.x = pack2(o0[0], o0[1]); v.y = pack2(o0[2], o0[3]); v.z = pack2(o1[0], o1[1]); v.w = pack2(o1[2], o1[3]);
        *reinterpret_cast<uint4*>(qk + (size_t)tok * 1024 + bcol + bj * HALF + wc * 32 + fq * 8) = v;
      }
    }
}

struct EpiGen {
  int kind, lay; kaptr_t ka;
  DI void operator()(int sub, int row, int col, f32x4 v, f32x4 w) const {
    const PRef p(ka);
    if (kind == 4 || kind == 8 || kind == 12) {
      float* X = p.xs;
      float4* q = reinterpret_cast<float4*>(X + (size_t)row * DM + col);
      const float4* qi = (kind == 4 && lay == 0) ? reinterpret_cast<const float4*>((const float*)p.in[I_X] + (size_t)row * DM + col) : q;
      float4 x = qi[0], y = qi[1];
      x.x = ALPHA * x.x + v[0]; x.y = ALPHA * x.y + v[1]; x.z = ALPHA * x.z + v[2]; x.w = ALPHA * x.w + v[3];
      y.x = ALPHA * y.x + w[0]; y.y = ALPHA * y.y + w[1]; y.z = ALPHA * y.z + w[2]; y.w = ALPHA * y.w + w[3];
      q[0] = x; q[1] = y;
      return;
    }
    char* ws = p.ws;
    const float scale = (kind == 6) ? 0.0625f * LOG2E : 1.f;
    uint4 o; o.x = pack2(v[0] * scale, v[1] * scale); o.y = pack2(v[2] * scale, v[3] * scale);
    o.z = pack2(w[0] * scale, w[1] * scale); o.w = pack2(w[2] * scale, w[3] * scale);
    u16* dst;
    if (kind == 6) dst = (u16*)(ws + OFF_QC) + (size_t)row * 1024 + col;
    else if (sub == 1) dst = (u16*)(ws + OFF_VT) + (size_t)row * NTOK + col;
    else if (sub == 2) dst = (u16*)(ws + OFF_KMEM) + (size_t)row * 1024 + col;
    else if (sub == 3) dst = (u16*)(ws + OFF_VMEMT) + (size_t)row * 2048 + col;
    else if (col < 1024) dst = (u16*)(ws + OFF_QK) + (size_t)row * 1024 + col;
    else if (col < 2432) dst = (u16*)(ws + OFF_RW) + (size_t)row * 896 + (col - 1536);
    else if (col < 2688) dst = (u16*)(ws + OFF_S5) + (size_t)row * 256 + (col - 2432);
    else return;
    *reinterpret_cast<uint4*>(dst) = o;
  }
};

DI void transpose_tiles(const float* __restrict__ src, int K, int N, int Npad, u16* __restrict__ dst, int& tbase, int tile_begin, int tile_stride, bool upmap = false, int rope_rows = 0) {
  extern __shared__ __attribute__((aligned(16))) u16 shm[];
  float* tile = reinterpret_cast<float*>(shm);
  const int nkt = K / 64, nnt = Npad / 64, total = nkt * nnt;
  int first = tile_begin;
  if (first < tbase) { int d = tbase - first; first += ((d + tile_stride - 1) / tile_stride) * tile_stride; }
  for (int g = first; g < tbase + total; g += tile_stride) {
    int t = g - tbase; int kt = t % nkt, ntile = t / nkt; int k0 = kt * 64, n0 = ntile * 64;
    __syncthreads();
    const int tid = ltid();
#pragma unroll
    for (int r = 0; r < 2; ++r) {
      const int e = tid + r * 512, i = e >> 4, j4 = (e & 15) * 4;
      float4 v = make_float4(0.f, 0.f, 0.f, 0.f);
      const int sn0 = upmap ? ((n0 & 255) >> 7) * DFF + (n0 >> 8) * 128 + (n0 & 127) : n0;
      if (n0 + j4 < N) v = *reinterpret_cast<const float4*>(src + (size_t)(k0 + i) * N + sn0 + j4);
      tile[i * 65 + j4] = v.x; tile[i * 65 + j4 + 1] = v.y; tile[i * 65 + j4 + 2] = v.z; tile[i * 65 + j4 + 3] = v.w;
    }
    __syncthreads();
    {
      const int jn = tid >> 3, seg = tid & 7;
      const float* tp = tile + (seg * 8) * 65 + jn;
      uint4 o;
      o.x = pack2(tp[0], tp[65]); o.y = pack2(tp[2 * 65], tp[3 * 65]); o.z = pack2(tp[4 * 65], tp[5 * 65]); o.w = pack2(tp[6 * 65], tp[7 * 65]);
      const int jd = (n0 < rope_rows) ? (((jn >> 4) & 1) * 32 + ((jn & 15) >> 2) * 8 + (jn >> 5) * 4 + (jn & 3)) : jn;
      *reinterpret_cast<uint4*>(dst + (size_t)(n0 + jd) * K + k0 + seg * 8) = o;
    }
  }
  tbase += total;
}

DI void phase_transposes(const PRef& p, int l) {
  char* wt = p.ws + OFF_WT;
  int tbase = 0; const int tb = blockIdx.x, ts = gridDim.x;
  transpose_tiles((const float*)p.in[I_WIN] + (size_t)l * 1024 * INW, 1024, INW, 2816, (u16*)(wt + WT_IN), tbase, tb, ts, false, 1024);
  transpose_tiles((const float*)p.in[I_WOUT] + (size_t)l * 1024 * 1024, 1024, 1024, 1024, (u16*)(wt + WT_OUT), tbase, tb, ts);
  transpose_tiles((const float*)p.in[I_WQ] + (size_t)l * 1024 * 1024, 1024, 1024, 1024, (u16*)(wt + WT_Q), tbase, tb, ts);
  transpose_tiles((const float*)p.in[I_WKV] + (size_t)l * 1024 * 2048, 1024, 2048, 2048, (u16*)(wt + WT_KV), tbase, tb, ts);
  transpose_tiles((const float*)p.in[I_WO] + (size_t)l * 1024 * 1024, 1024, 1024, 1024, (u16*)(wt + WT_O), tbase, tb, ts);
  transpose_tiles((const float*)p.in[I_WUP] + (size_t)l * 1024 * 5632, 1024, 5632, 5632, (u16*)(wt + WT_UP), tbase, tb, ts, true);
  transpose_tiles((const float*)p.in[I_WDOWN] + (size_t)l * 2816 * 1024, 2816, 1024, 1024, (u16*)(wt + WT_DOWN), tbase, tb, ts);
  transpose_tiles((const float*)p.in[I_GLUW] + (size_t)l * 256 * 256, 256, 256, 256, (u16*)(wt + WT_GLU), tbase, tb, ts);
  __syncthreads();
  {
    const float* w2 = (const float*)p.in[I_W2] + l * 32 * 256;
    const float* a2 = (const float*)p.in[I_A2] + l * 32 * 256;
    const float* g2 = (const float*)p.in[I_G2] + l * 64 * 256;
    u16* w2t = (u16*)(wt + WT_W2T); u16* a2t = (u16*)(wt + WT_A2T); u16* g2t = (u16*)(wt + WT_G2T);
    for (int e = blockIdx.x * 512 + ltid(); e < 256 * 128; e += gridDim.x * 512) {
      const int n = e & 255, kk = e >> 8;
      if (kk < 32) w2t[n * 32 + kk] = f2bf(w2[kk * 256 + n]);
      else if (kk < 64) a2t[n * 32 + (kk - 32)] = f2bf(a2[(kk - 32) * 256 + n]);
      else g2t[n * 64 + (kk - 64)] = f2bf(g2[(kk - 64) * 256 + n]);
    }
  }
}

DI void phase_init(const PRef& p) {
  const size_t gtid = (size_t)blockIdx.x * 512 + ltid(), gsz = (size_t)gridDim.x * 512;
  const float4* x4 = (const float4*)p.in[I_X];
  uint2* xb2 = (uint2*)(p.ws + OFF_XB);
  for (size_t i = gtid; i < (size_t)NTOK * DM / 4; i += gsz) {
    float4 v = x4[i];
    uint2 o; o.x = pack2(v.x, v.y); o.y = pack2(v.z, v.w); xb2[i] = o;
  }
  const float4* m4 = (const float4*)p.in[I_MEM];
  uint2* mb2 = (uint2*)(p.ws + OFF_MEMB);
  for (size_t i = gtid; i < (size_t)2048 * 1024 / 4; i += gsz) {
    float4 v = m4[i]; uint2 o; o.x = pack2(v.x, v.y); o.y = pack2(v.z, v.w); mb2[i] = o;
  }
  const int* pos = (const int*)p.in[I_POS];
  float* rc = (float*)(p.ws + OFF_ROPE); float* rs = rc + (size_t)NTOK * 32;
  for (size_t i = gtid; i < (size_t)NTOK * 32; i += gsz) {
    int tok = (int)(i >> 5), d = (int)(i & 31);
    float invf = exp2f(-(float)d * (13.287712379549449f / 32.f));
    float angf = (float)pos[tok] * invf;
    double rev = (double)angf * 0.15915494309189535;
    float xr = (float)((rev - rint(rev)) * 6.283185307179586);
    float sv = __sinf(xr), cv = __cosf(xr);
    rc[i] = cv; rs[i] = sv;
  }
  if (blockIdx.x == 0 && ltid() < 64) ((unsigned*)(p.ws + OFF_CNT))[ltid()] = 0u;
}

DI void phase_prep(const PRef& p, int l) {
  extern __shared__ __attribute__((aligned(16))) u16 shm[];
  float* act = reinterpret_cast<float*>(shm);
  u16* qk = (u16*)(p.ws + OFF_QK);
  const u16* rw = (const u16*)(p.ws + OFF_RW);
  const float* rc = (const float*)(p.ws + OFF_ROPE); const float* rs = rc + (size_t)NTOK * 32;
  const float* mu = (const float*)p.in[I_MU] + l * 896;
  const float* w0 = (const float*)p.in[I_W0] + l * 256;
  const float* w2 = (const float*)p.in[I_W2] + l * 32 * 256;
  const float* a0 = (const float*)p.in[I_A0] + l * 256;
  const float* a2 = (const float*)p.in[I_A2] + l * 32 * 256;
  const float* g2 = (const float*)p.in[I_G2] + l * 64 * 256;
  const float* k_k = (const float*)p.in[I_KK] + l * 256;
  const float* k_a = (const float*)p.in[I_KA] + l * 256;
  const float* r_k = (const float*)p.in[I_RK] + l * 256;
  char* rec = p.ws + OFF_REC;
  u16* gbuf = (u16*)(p.ws + OFF_G);
  float* bonus = (float*)(p.ws + OFF_BONUS);
  const int tid = ltid();
  for (int item = blockIdx.x; item < NTOK / 32; item += gridDim.x) {
    const int tk0 = item * 32;
    __syncthreads();
    for (int idx = tid; idx < 32 * 128; idx += 512) {
      const int i = idx >> 7, j = idx & 127, tok = tk0 + i, col = 768 + j;
      float pv = bf2f(rw[(size_t)tok * 896 + col]);
      float pp = ((tok & (SEQ - 1)) != 0) ? bf2f(rw[(size_t)(tok - 1) * 896 + col]) : 0.f;
      float ps = pv + (pp - pv) * mu[col];
      float a = (j < 32) ? tanhf(ps) : (j < 64) ? ps : sigmoidf_(ps);
      act[i * 128 + j] = a;
    }
    __syncthreads();
    const int c = tid & 255, half = tid >> 8, h = c >> 6;
    {
      float* lora = act + 32 * 128;
      const int w8 = tid >> 6, ln = tid & 63, fr = ln & 15, fq = ln >> 4;
      const u16* w2t = (const u16*)(p.ws + OFF_WT + WT_W2T);
      const u16* a2t = (const u16*)(p.ws + OFF_WT + WT_A2T);
      const u16* g2t = (const u16*)(p.ws + OFF_WT + WT_G2T);
#pragma unroll
      for (int nbi = 0; nbi < 2; ++nbi) {
        const int col0 = (w8 * 2 + nbi) * 16;
        const bf16x8 bw = *reinterpret_cast<const bf16x8*>(w2t + (size_t)(col0 + fr) * 32 + fq * 8);
        const bf16x8 ba = *reinterpret_cast<const bf16x8*>(a2t + (size_t)(col0 + fr) * 32 + fq * 8);
        const bf16x8 bg0 = *reinterpret_cast<const bf16x8*>(g2t + (size_t)(col0 + fr) * 64 + fq * 8);
        const bf16x8 bg1 = *reinterpret_cast<const bf16x8*>(g2t + (size_t)(col0 + fr) * 64 + 32 + fq * 8);
#pragma unroll
        for (int mb = 0; mb < 2; ++mb) {
          const float* ap = act + (mb * 16 + fr) * 128 + fq * 8;
          bf16x8 af[4];
#pragma unroll
          for (int ks = 0; ks < 4; ++ks) {
            const float4 f0 = *reinterpret_cast<const float4*>(ap + ks * 32), f1 = *reinterpret_cast<const float4*>(ap + ks * 32 + 4);
            af[ks] = __builtin_bit_cast(bf16x8, (u32x4{pack2(f0.x, f0.y), pack2(f0.z, f0.w), pack2(f1.x, f1.y), pack2(f1.z, f1.w)}));
          }
          const f32x4 z4 = f32x4{0.f, 0.f, 0.f, 0.f};
          f32x4 dw = __builtin_amdgcn_mfma_f32_16x16x32_bf16(bw, af[0], z4, 0, 0, 0);
          f32x4 da = __builtin_amdgcn_mfma_f32_16x16x32_bf16(ba, af[1], z4, 0, 0, 0);
          f32x4 dg = __builtin_amdgcn_mfma_f32_16x16x32_bf16(bg0, af[2], z4, 0, 0, 0);
          dg = __builtin_amdgcn_mfma_f32_16x16x32_bf16(bg1, af[3], dg, 0, 0, 0);
          float* lp = lora + (mb * 16 + fr) * 256 + col0 + fq * 4;
          *reinterpret_cast<float4*>(lp) = make_float4(dw[0], dw[1], dw[2], dw[3]);
          *reinterpret_cast<float4*>(lp + 32 * 256) = make_float4(da[0], da[1], da[2], da[3]);
          *reinterpret_cast<float4*>(lp + 2 * 32 * 256) = make_float4(dg[0], dg[1], dg[2], dg[3]);
        }
      }
    }
    __syncthreads();
    float accw[16], acca[16], accg[16];
#pragma unroll
    for (int i = 0; i < 16; ++i) {
      const float* lp = act + 32 * 128 + (half * 16 + i) * 256 + c;
      accw[i] = lp[0]; acca[i] = lp[32 * 256]; accg[i] = lp[2 * 32 * 256];
    }
    const float mur = mu[c], muk = mu[256 + c], muv = mu[512 + c];
    const float w0c = w0[c], a0c = a0[c], kkc = k_k[c], kac = k_a[c], rkc = r_k[c];
#pragma unroll
    for (int i = 0; i < 16; ++i) {
      const int tok = tk0 + half * 16 + i;
      const bool has_prev = (tok & (SEQ - 1)) != 0;
      const u16* pr_ = rw + (size_t)tok * 896;
      float r0 = bf2f(pr_[c]), k0 = bf2f(pr_[256 + c]), v0 = bf2f(pr_[512 + c]);
      float r1 = 0.f, k1 = 0.f, v1 = 0.f;
      if (has_prev) { r1 = bf2f(pr_[c - 896]); k1 = bf2f(pr_[256 + c - 896]); v1 = bf2f(pr_[512 + c - 896]); }
      float r = r0 + (r1 - r0) * mur, k = k0 + (k1 - k0) * muk, v = v0 + (v1 - v0) * muv;
      float w = __expf(-0.6065306597126334f * sigmoidf_(w0c + accw[i]));
      float a = sigmoidf_(a0c + acca[i]);
      float kk = k * kkc;
      float ss = wave_sum(kk * kk);
      kk *= rsqrtf(fmaxf(ss, 1e-24f));
      float kp = k * (1.f + (a - 1.f) * kac);
      float bb = kk * a;
      float bo = wave_sum(r * kp * rkc);
      const int b = tok >> 12, t = tok & (SEQ - 1);
      char* rp = rec + ((size_t)((b * 4 + h) * SEQ + t)) * 1152;
      const int cc = c & 63;
      reinterpret_cast<float*>(rp)[cc] = w;
      reinterpret_cast<float*>(rp + 256)[cc] = kk;
      reinterpret_cast<float*>(rp + 512)[cc] = bb;
      reinterpret_cast<u16*>(rp + 768)[cc] = f2bf(kp);
      reinterpret_cast<u16*>(rp + 896)[cc] = f2bf(r);
      reinterpret_cast<u16*>(rp + 1024)[cc] = f2bf(v);
      gbuf[(size_t)tok * 256 + c] = f2bf(accg[i]);
      if (cc == 0) bonus[(size_t)tok * 4 + h] = bo;
    }
    __syncthreads();
  }
}

template <int DK, int DV, int NQB>
struct FlashWave {
  bf16x8 qf[NQB][DK / 32];
  f32x4 o[NQB][DV / 16];
  float m[NQB], l[NQB];
  DI void init() {
#pragma unroll
    for (int qb = 0; qb < NQB; ++qb) { m[qb] = -INFINITY; l[qb] = 0.f;
#pragma unroll
      for (int d = 0; d < DV / 16; ++d) o[qb][d] = f32x4{0.f, 0.f, 0.f, 0.f}; }
  }
  DI void tile(const u16* Ks, const u16* Vts) {
    constexpr int KSTR = DK + 8, VSTR = 72;
    const int lane = ltid() & 63, fr = lane & 15, fq = lane >> 4;
    float base[NQB];
#pragma unroll
    for (int qb = 0; qb < NQB; ++qb) base[qb] = (m[qb] == -INFINITY) ? 0.f : m[qb];
    f32x4 s[4][NQB];
    __builtin_amdgcn_s_setprio(1);
#pragma unroll
    for (int kb = 0; kb < 4; ++kb) {
#pragma unroll
      for (int qb = 0; qb < NQB; ++qb) s[kb][qb] = f32x4{-base[qb], -base[qb], -base[qb], -base[qb]};
#pragma unroll
      for (int ks = 0; ks < DK / 32; ++ks) {
        bf16x8 kf = *reinterpret_cast<const bf16x8*>(Ks + (kb * 16 + fr) * KSTR + ks * 32 + fq * 8);
#pragma unroll
        for (int qb = 0; qb < NQB; ++qb) s[kb][qb] = __builtin_amdgcn_mfma_f32_16x16x32_bf16(kf, qf[qb][ks], s[kb][qb], 0, 0, 0);
      }
    }
    __builtin_amdgcn_s_setprio(0);
    bf16x8 pf[NQB][2];
#pragma unroll
    for (int qb = 0; qb < NQB; ++qb) {
      float mx = -INFINITY;
#pragma unroll
      for (int kb = 0; kb < 4; ++kb) {
#pragma unroll
        for (int j = 0; j < 4; ++j) mx = fmaxf(mx, s[kb][qb][j]); }
      mx = fmaxf(mx, __shfl_xor(mx, 16));
      mx = fmaxf(mx, __shfl_xor(mx, 32));
      const float mn = fmaxf(m[qb], base[qb] + mx);
      const bool changed = __any(mn > m[qb]);
      float sum = 0.f;
      if (changed) {
        const float delta = mn - base[qb];
        const float alpha = __builtin_amdgcn_exp2f(m[qb] - mn);
#pragma unroll
        for (int kb = 0; kb < 4; ++kb) {
#pragma unroll
          for (int j = 0; j < 4; ++j) { float e = __builtin_amdgcn_exp2f(s[kb][qb][j] - delta); s[kb][qb][j] = e; sum += e; } }
        l[qb] = l[qb] * alpha + sum;
#pragma unroll
        for (int d = 0; d < DV / 16; ++d) { o[qb][d][0] *= alpha; o[qb][d][1] *= alpha; o[qb][d][2] *= alpha; o[qb][d][3] *= alpha; }
      } else {
#pragma unroll
        for (int kb = 0; kb < 4; ++kb) {
#pragma unroll
          for (int j = 0; j < 4; ++j) { float e = __builtin_amdgcn_exp2f(s[kb][qb][j]); s[kb][qb][j] = e; sum += e; } }
        l[qb] += sum;
      }
      m[qb] = mn;
#pragma unroll
      for (int k2 = 0; k2 < 2; ++k2) {
        u32x4 pk;
        pk[0] = pack2(s[2 * k2][qb][0], s[2 * k2][qb][1]); pk[1] = pack2(s[2 * k2][qb][2], s[2 * k2][qb][3]);
        pk[2] = pack2(s[2 * k2 + 1][qb][0], s[2 * k2 + 1][qb][1]); pk[3] = pack2(s[2 * k2 + 1][qb][2], s[2 * k2 + 1][qb][3]);
        pf[qb][k2] = __builtin_bit_cast(bf16x8, pk);
      }
    }
    __builtin_amdgcn_s_setprio(1);
    if constexpr (DV == 256) {
      constexpr int NPV = 2 * (DV / 16);
      const u16* vbase = Vts + fr * VSTR + fq * 4;
      uint2 ra0, ra1, rb0, rb1, rc0, rc1, rd0, rd1;
#define VLOAD(IDX, R0, R1) do { const u16* vp_ = vbase + (((IDX) % (DV / 16)) * 16) * VSTR + ((IDX) / (DV / 16)) * 32; \
        R0 = *reinterpret_cast<const uint2*>(vp_); R1 = *reinterpret_cast<const uint2*>(vp_ + 16); } while (0)
      VLOAD(0, ra0, ra1); VLOAD(1, rb0, rb1); VLOAD(2, rc0, rc1);
      rd0 = ra0; rd1 = ra1;
#pragma unroll
      for (int idx = 0; idx < NPV; ++idx) {
        const int k2 = idx / (DV / 16), d = idx % (DV / 16);
        if (idx + 3 < NPV) {
          if ((idx & 3) == 0) VLOAD(idx + 3, rd0, rd1);
          else if ((idx & 3) == 1) VLOAD(idx + 3, ra0, ra1);
          else if ((idx & 3) == 2) VLOAD(idx + 3, rb0, rb1);
          else VLOAD(idx + 3, rc0, rc1);
        }
        __builtin_amdgcn_sched_barrier(0);
        uint2 h0, h1;
        if ((idx & 3) == 0) { h0 = ra0; h1 = ra1; } else if ((idx & 3) == 1) { h0 = rb0; h1 = rb1; }
        else if ((idx & 3) == 2) { h0 = rc0; h1 = rc1; } else { h0 = rd0; h1 = rd1; }
        const bf16x8 vfv = __builtin_bit_cast(bf16x8, (u32x4{h0.x, h0.y, h1.x, h1.y}));
#pragma unroll
        for (int qb = 0; qb < NQB; ++qb) o[qb][d] = __builtin_amdgcn_mfma_f32_16x16x32_bf16(vfv, pf[qb][k2], o[qb][d], 0, 0, 0);
        __builtin_amdgcn_sched_barrier(0);
      }
#undef VLOAD
    } else {
#pragma unroll
    for (int k2 = 0; k2 < 2; ++k2) {
#pragma unroll
      for (int d = 0; d < DV / 16; ++d) {
        const u16* vp = Vts + (d * 16 + fr) * VSTR + k2 * 32 + fq * 4;
        const uint2 h0 = *reinterpret_cast<const uint2*>(vp);
        const uint2 h1 = *reinterpret_cast<const uint2*>(vp + 16);
        const bf16x8 vfv = __builtin_bit_cast(bf16x8, (u32x4{h0.x, h0.y, h1.x, h1.y}));
#pragma unroll
        for (int qb = 0; qb < NQB; ++qb) o[qb][d] = __builtin_amdgcn_mfma_f32_16x16x32_bf16(vfv, pf[qb][k2], o[qb][d], 0, 0, 0);
      }
    }
    }
    __builtin_amdgcn_s_setprio(0);
  }
  DI float lsum(int qb) { float t = l[qb]; t += __shfl_xor(t, 16); t += __shfl_xor(t, 32); return t; }
};

DI void diff_attn_item(const PRef& p, int l, int b, int h, int qt) {
  extern __shared__ __attribute__((aligned(16))) u16 shm[];
  u16* Ks = shm;
  u16* Vts = shm + 2 * 64 * 72;
  float* comb = reinterpret_cast<float*>(shm + 2 * 64 * 72 + 128 * 72);
  const u16* qk = (const u16*)(p.ws + OFF_QK);
  const u16* vt = (const u16*)(p.ws + OFF_VT);
  u16* hcat = (u16*)(p.ws + OFF_HCAT);
  const int tid = ltid(), w = tid >> 6, lane = tid & 63, fr = lane & 15, fq = lane >> 4;
  const int n = w >> 2, qsub = w & 3;
  const int tok0 = b * SEQ + qt * 128;
  float lam;
  {
    float a1 = ((const float*)p.in[I_LQ1])[l * 64 + lane] * ((const float*)p.in[I_LK1])[l * 64 + lane];
    float a2 = ((const float*)p.in[I_LQ2])[l * 64 + lane] * ((const float*)p.in[I_LK2])[l * 64 + lane];
    a1 = wave_sum(a1); a2 = wave_sum(a2);
    lam = __expf(a1) - __expf(a2) + p.lam_init[l];
  }
  FlashWave<64, 128, 2> fw;
  fw.init();
#pragma unroll
  for (int qb = 0; qb < 2; ++qb)
#pragma unroll
    for (int ks = 0; ks < 2; ++ks)
    fw.qf[qb][ks] = *reinterpret_cast<const bf16x8*>(qk + (size_t)(tok0 + qsub * 32 + qb * 16 + fr) * 1024 + h * 128 + n * 64 + ks * 32 + fq * 8);
  const int nkt = 2 * qt + 2;
  const int my_last = 2 * qt + (qsub >> 1);
  uint4 kreg0, kreg1, vreg0, vreg1;
  const int seg0 = tid, seg1 = tid + 512;
  const u16* kbase0 = qk + (size_t)(b * SEQ + ((seg0 >> 3) & 63)) * 1024 + 512 + h * 128 + (seg0 >> 9) * 64 + (seg0 & 7) * 8;
  const u16* kbase1 = qk + (size_t)(b * SEQ + ((seg1 >> 3) & 63)) * 1024 + 512 + h * 128 + (seg1 >> 9) * 64 + (seg1 & 7) * 8;
  const u16* vbase0 = vt + (size_t)(h * 128 + (seg0 >> 3)) * NTOK + b * SEQ + (seg0 & 7) * 8;
  const u16* vbase1 = vt + (size_t)(h * 128 + (seg1 >> 3)) * NTOK + b * SEQ + (seg1 & 7) * 8;
  u16* kdst0 = Ks + ((seg0 >> 9) * 64 + ((seg0 >> 3) & 63)) * 72 + (seg0 & 7) * 8;
  u16* kdst1 = Ks + ((seg1 >> 9) * 64 + ((seg1 >> 3) & 63)) * 72 + (seg1 & 7) * 8;
  u16* vdst0 = Vts + (seg0 >> 3) * 72 + (seg0 & 7) * 8;
  u16* vdst1 = Vts + (seg1 >> 3) * 72 + (seg1 & 7) * 8;
#define load_tile(kt) do { \
    kreg0 = *reinterpret_cast<const uint4*>(kbase0 + (size_t)(kt) * 64 * 1024); \
    kreg1 = *reinterpret_cast<const uint4*>(kbase1 + (size_t)(kt) * 64 * 1024); \
    vreg0 = *reinterpret_cast<const uint4*>(vbase0 + (kt) * 64); \
    vreg1 = *reinterpret_cast<const uint4*>(vbase1 + (kt) * 64); } while (0)
#define store_tile() do { \
    *reinterpret_cast<uint4*>(kdst0) = kreg0; *reinterpret_cast<uint4*>(kdst1) = kreg1; \
    *reinterpret_cast<uint4*>(vdst0) = vreg0; *reinterpret_cast<uint4*>(vdst1) = vreg1; } while (0)
  load_tile(0);
  for (int kt = 0; kt < nkt; ++kt) {
    __syncthreads();
    store_tile();
    __syncthreads();
    if (kt + 1 < nkt) load_tile(kt + 1);
    if (kt <= my_last) fw.tile(Ks + n * 64 * 72, Vts);
  }
  float inv[2];
#pragma unroll
  for (int qb = 0; qb < 2; ++qb) inv[qb] = 1.f / fw.lsum(qb);
  __syncthreads();
  if (n == 1) {
#pragma unroll
    for (int qb = 0; qb < 2; ++qb)
#pragma unroll
      for (int d = 0; d < 8; ++d) {
      float4 v; v.x = fw.o[qb][d][0] * inv[qb]; v.y = fw.o[qb][d][1] * inv[qb]; v.z = fw.o[qb][d][2] * inv[qb]; v.w = fw.o[qb][d][3] * inv[qb];
      *reinterpret_cast<float4*>(&comb[(qsub * 32 + qb * 16 + fr) * 132 + d * 16 + fq * 4]) = v;
    }
  }
  __syncthreads();
  if (n == 0) {
    const float* sg = (const float*)p.in[I_SUBLN] + l * 128;
    const float post = 1.f - p.lam_init[l];
#pragma unroll
    for (int qb = 0; qb < 2; ++qb) {
      float ss = 0.f;
#pragma unroll
      for (int d = 0; d < 8; ++d) {
        float4 c2 = *reinterpret_cast<const float4*>(&comb[(qsub * 32 + qb * 16 + fr) * 132 + d * 16 + fq * 4]);
        fw.o[qb][d][0] = fw.o[qb][d][0] * inv[qb] - lam * c2.x;
        fw.o[qb][d][1] = fw.o[qb][d][1] * inv[qb] - lam * c2.y;
        fw.o[qb][d][2] = fw.o[qb][d][2] * inv[qb] - lam * c2.z;
        fw.o[qb][d][3] = fw.o[qb][d][3] * inv[qb] - lam * c2.w;
        for (int j = 0; j < 4; ++j) ss += fw.o[qb][d][j] * fw.o[qb][d][j];
      }
      ss += __shfl_xor(ss, 16); ss += __shfl_xor(ss, 32);
      const float rms = rsqrtf(ss * (1.f / 128.f) + 1e-6f) * post;
      u16* op = hcat + (size_t)(tok0 + qsub * 32 + qb * 16 + fr) * 1024 + h * 128;
#pragma unroll
      for (int d = 0; d < 8; ++d) {
        const int dv = d * 16 + fq * 4;
        uint2 ov;
        ov.x = pack2(fw.o[qb][d][0] * rms * sg[dv], fw.o[qb][d][1] * rms * sg[dv + 1]);
        ov.y = pack2(fw.o[qb][d][2] * rms * sg[dv + 2], fw.o[qb][d][3] * rms * sg[dv + 3]);
        *reinterpret_cast<uint2*>(op + dv) = ov;
      }
    }
  }
  __syncthreads();
}

#undef load_tile
#undef store_tile
DI void cross_attn_item(const PRef& p, int tokblk, int h) {
  extern __shared__ __attribute__((aligned(16))) u16 shm[];
  u16* Ks = shm;
  u16* Vts = shm + 64 * 264;
  const u16* qc = (const u16*)(p.ws + OFF_QC);
  const u16* km = (const u16*)(p.ws + OFF_KMEM);
  const u16* vm = (const u16*)(p.ws + OFF_VMEMT);
  u16* oc = (u16*)(p.ws + OFF_OC);
  const int tid = ltid(), w = tid >> 6, lane = tid & 63, fr = lane & 15, fq = lane >> 4;
  const int tok0 = tokblk * 128, b = tok0 >> 12;
  FlashWave<256, 256, 1> fw;
  fw.init();
#pragma unroll
  for (int ks = 0; ks < 8; ++ks)
    fw.qf[0][ks] = *reinterpret_cast<const bf16x8*>(qc + (size_t)(tok0 + w * 16 + fr) * 1024 + h * 256 + ks * 32 + fq * 8);
  uint4 kreg0, kreg1, kreg2, kreg3, vreg0, vreg1, vreg2, vreg3;
  const u16* kbase = km + (size_t)(b * 256 + (tid >> 5)) * 1024 + h * 256 + (tid & 31) * 8;
  const u16* vbase = vm + (size_t)(h * 256 + (tid >> 3)) * 2048 + b * 256 + (tid & 7) * 8;
  u16* kdst = Ks + (tid >> 5) * 264 + (tid & 31) * 8;
  u16* vdst = Vts + (tid >> 3) * 72 + (tid & 7) * 8;
#define load_tile(kt) do { \
    kreg0 = *reinterpret_cast<const uint4*>(kbase + (size_t)((kt) * 64 + 0) * 1024); \
    kreg1 = *reinterpret_cast<const uint4*>(kbase + (size_t)((kt) * 64 + 16) * 1024); \
    kreg2 = *reinterpret_cast<const uint4*>(kbase + (size_t)((kt) * 64 + 32) * 1024); \
    kreg3 = *reinterpret_cast<const uint4*>(kbase + (size_t)((kt) * 64 + 48) * 1024); \
    vreg0 = *reinterpret_cast<const uint4*>(vbase + (size_t)0 * 2048 + (kt) * 64); \
    vreg1 = *reinterpret_cast<const uint4*>(vbase + (size_t)64 * 2048 + (kt) * 64); \
    vreg2 = *reinterpret_cast<const uint4*>(vbase + (size_t)128 * 2048 + (kt) * 64); \
    vreg3 = *reinterpret_cast<const uint4*>(vbase + (size_t)192 * 2048 + (kt) * 64); } while (0)
#define store_tile() do { \
    *reinterpret_cast<uint4*>(kdst) = kreg0; *reinterpret_cast<uint4*>(kdst + 16 * 264) = kreg1; \
    *reinterpret_cast<uint4*>(kdst + 32 * 264) = kreg2; *reinterpret_cast<uint4*>(kdst + 48 * 264) = kreg3; \
    *reinterpret_cast<uint4*>(vdst) = vreg0; *reinterpret_cast<uint4*>(vdst + 64 * 72) = vreg1; \
    *reinterpret_cast<uint4*>(vdst + 128 * 72) = vreg2; *reinterpret_cast<uint4*>(vdst + 192 * 72) = vreg3; } while (0)
  load_tile(0);
  for (int kt = 0; kt < 4; ++kt) {
    __syncthreads();
    store_tile();
    __syncthreads();
    if (kt + 1 < 4) load_tile(kt + 1);
    fw.tile(Ks, Vts);
  }
  const float inv = 1.f / fw.lsum(0);
  u16* op = oc + (size_t)(tok0 + w * 16 + fr) * 1024 + h * 256;
#pragma unroll
  for (int d = 0; d < 16; ++d) {
    uint2 ov;
    ov.x = pack2(fw.o[0][d][0] * inv, fw.o[0][d][1] * inv);
    ov.y = pack2(fw.o[0][d][2] * inv, fw.o[0][d][3] * inv);
    *reinterpret_cast<uint2*>(op + d * 16 + fq * 4) = ov;
  }
  __syncthreads();
}

#undef load_tile
#undef store_tile
DI float row8_sum(float x) {
  x += dpp_f<0xB1>(x);
  x += dpp_f<0x4E>(x);
  x += dpp_f<0x141>(x);
  return x;
}
DI f32v2 bfpair(unsigned q) { f32v2 r; r.x = __uint_as_float(q << 16); r.y = __uint_as_float(q & 0xffff0000u); return r; }

DI void rwkv_scan_item(const PRef& p, int b, int h, int half) {
  extern __shared__ __attribute__((aligned(16))) u16 shm[];
  char* buf = reinterpret_cast<char*>(shm);
  float* ybuf = reinterpret_cast<float*>(buf + 2 * 16 * 1152);
  float* dummy = ybuf + 1024;
  const char* rec = p.ws + OFF_REC + (size_t)((b * 4 + h) * SEQ) * 1152;
  float* Y = (float*)(p.ws + OFF_Y);
  const int tid = ltid(), w = tid >> 6, lane = tid & 63;
  const int rl = (w & 3) * 8 + (lane >> 3);
  const int row = half * 32 + rl;
  const int ks = (lane & 7) * 8;
  const bool compute = w < 4;
  const bool leader = (lane & 7) == 0;
  float* ydst0 = leader ? (ybuf + rl) : (dummy + (tid & 255));
  const int ystride = leader ? 32 : 0;
  f32v2 S01 = {0.f, 0.f}, S23 = {0.f, 0.f}, S45 = {0.f, 0.f}, S67 = {0.f, 0.f};
  uint4 rg0, rg1, rg2 = make_uint4(0, 0, 0, 0);
  auto load_chunk = [&](int ch) {
    const uint4* src = reinterpret_cast<const uint4*>(rec + (size_t)ch * 16 * 1152);
    rg0 = src[tid]; rg1 = src[tid + 512];
    if (tid < 128) rg2 = src[tid + 1024];
  };
  load_chunk(0);
  __syncthreads();
  for (int ch = 0; ch < SEQ / 16; ++ch) {
    char* cb = buf + (ch & 1) * 16 * 1152;
    {
      uint4* dst = reinterpret_cast<uint4*>(cb);
      dst[tid] = rg0; dst[tid + 512] = rg1;
      if (tid < 128) dst[tid + 1024] = rg2;
    }
    __syncthreads();
    if (ch + 1 < SEQ / 16) load_chunk(ch + 1);
    if (ch > 0) {
      const float* ybp = ybuf + ((ch - 1) & 1) * 512;
      const int st = tid >> 5, r = tid & 31;
      Y[(size_t)(b * SEQ + (ch - 1) * 16 + st) * 256 + h * 64 + half * 32 + r] = ybp[tid];
    }
    if (compute) {
      float* yd = ydst0 + (leader ? (ch & 1) * 512 : 0);
      const char* sp = cb;
      float4 wa = *reinterpret_cast<const float4*>(sp + ks * 4), wb = *reinterpret_cast<const float4*>(sp + ks * 4 + 16);
      float4 ka = *reinterpret_cast<const float4*>(sp + 256 + ks * 4), kb = *reinterpret_cast<const float4*>(sp + 256 + ks * 4 + 16);
      float4 ba = *reinterpret_cast<const float4*>(sp + 512 + ks * 4), bbv = *reinterpret_cast<const float4*>(sp + 512 + ks * 4 + 16);
      uint4 kq = *reinterpret_cast<const uint4*>(sp + 768 + ks * 2);
      uint4 rq = *reinterpret_cast<const uint4*>(sp + 896 + ks * 2);
      unsigned vq = *reinterpret_cast<const u16*>(sp + 1024 + row * 2);
#pragma unroll
      for (int st = 0; st < 16; ++st) {
        float4 wan, wbn, kan, kbn, ban, bbn; uint4 kqn, rqn; unsigned vqn;
        if (st < 15) {
          const char* sn = cb + (st + 1) * 1152;
          wan = *reinterpret_cast<const float4*>(sn + ks * 4); wbn = *reinterpret_cast<const float4*>(sn + ks * 4 + 16);
          kan = *reinterpret_cast<const float4*>(sn + 256 + ks * 4); kbn = *reinterpret_cast<const float4*>(sn + 256 + ks * 4 + 16);
          ban = *reinterpret_cast<const float4*>(sn + 512 + ks * 4); bbn = *reinterpret_cast<const float4*>(sn + 512 + ks * 4 + 16);
          kqn = *reinterpret_cast<const uint4*>(sn + 768 + ks * 2);
          rqn = *reinterpret_cast<const uint4*>(sn + 896 + ks * 2);
          vqn = *reinterpret_cast<const u16*>(sn + 1024 + row * 2);
        }
        const float v = __uint_as_float(vq << 16);
        const f32v2 vv = {v, v};
        const f32v2 kk01 = {ka.x, ka.y}, kk23 = {ka.z, ka.w}, kk45 = {kb.x, kb.y}, kk67 = {kb.z, kb.w};
        f32v2 sa2 = S01 * kk01 + S23 * kk23;
        f32v2 sb2 = S45 * kk45 + S67 * kk67;
        sa2 += sb2;
        float sa = row8_sum(sa2.x + sa2.y);
        const f32v2 sav = {sa, sa};
        S01 = S01 * f32v2{wa.x, wa.y} - sav * f32v2{ba.x, ba.y} + vv * bfpair(kq.x);
        S23 = S23 * f32v2{wa.z, wa.w} - sav * f32v2{ba.z, ba.w} + vv * bfpair(kq.y);
        S45 = S45 * f32v2{wb.x, wb.y} - sav * f32v2{bbv.x, bbv.y} + vv * bfpair(kq.z);
        S67 = S67 * f32v2{wb.z, wb.w} - sav * f32v2{bbv.z, bbv.w} + vv * bfpair(kq.w);
        f32v2 ya = S01 * bfpair(rq.x) + S23 * bfpair(rq.y);
        f32v2 yb2 = S45 * bfpair(rq.z) + S67 * bfpair(rq.w);
        ya += yb2;
        float y = row8_sum(ya.x + ya.y);
        yd[st * ystride] = y;
        if (st < 15) { wa = wan; wb = wbn; ka = kan; kb = kbn; ba = ban; bbv = bbn; kq = kqn; rq = rqn; vq = vqn; }
      }
    }
  }
  __syncthreads();
  {
    const int ch = SEQ / 16 - 1;
    const float* ybp = ybuf + (ch & 1) * 512;
    const int st = tid >> 5, r = tid & 31;
    Y[(size_t)(b * SEQ + ch * 16 + st) * 256 + h * 64 + half * 32 + r] = ybp[tid];
  }
  __syncthreads();
}

DI float gelu_tanh(float x) {
  float u = 0.7978845608028654f * (x + 0.044715f * x * x * x);
  return 0.5f * x * (1.f + tanhf(u));
}
DI void s5_item(const PRef& p, int l, int b, int g) {
  extern __shared__ __attribute__((aligned(16))) u16 shm[];
  float* uL = reinterpret_cast<float*>(shm);
  float* fin = uL + 8 * 256;
  float* xL = fin + 8 * 128;
  const u16* s5 = (const u16*)(p.ws + OFF_S5);
  u16* Z = (u16*)(p.ws + OFF_Z);
  const int tid = ltid(), w = tid >> 6, lane = tid & 63;
  const float Are = ((const float*)p.in[I_SARE])[(l * 16 + g) * 64 + lane];
  const float Aim = ((const float*)p.in[I_SAIM])[(l * 16 + g) * 64 + lane];
  const float delta = expf(((const float*)p.in[I_SLOG])[l * 16 + g]);
  float cr, ci;
  {
    float er = expf(delta * Are); float sn, cs; sincosf(delta * Aim, &sn, &cs);
    cr = er * cs; ci = er * sn;
  }
  float Bre[16], Bim[16];
  {
    const float x = cr - 1.f, y = ci, den = 1.f / (Are * Are + Aim * Aim);
    const float qre = (x * Are + y * Aim) * den, qim = (y * Are - x * Aim) * den;
    const float* bre = (const float*)p.in[I_SBRE] + ((size_t)(l * 16 + g) * 64 + lane) * 16;
    const float* bim = (const float*)p.in[I_SBIM] + ((size_t)(l * 16 + g) * 64 + lane) * 16;
#pragma unroll
    for (int hh = 0; hh < 16; ++hh) { float br = bre[hh], bi = bim[hh]; Bre[hh] = qre * br - qim * bi; Bim[hh] = qre * bi + qim * br; }
  }
  __syncthreads();
  bf16x8 cf[4];
  {
    const int hq = lane & 15, q4 = lane >> 4;
    const float* cre = (const float*)p.in[I_SCRE] + ((size_t)(l * 16 + g) * 16 + hq) * 64;
    const float* cim = (const float*)p.in[I_SCIM] + ((size_t)(l * 16 + g) * 16 + hq) * 64;
#pragma unroll
    for (int s4 = 0; s4 < 4; ++s4) {
      const float4 re = *reinterpret_cast<const float4*>(cre + 16 * s4 + 4 * q4);
      const float4 im = *reinterpret_cast<const float4*>(cim + 16 * s4 + 4 * q4);
      cf[s4] = __builtin_bit_cast(bf16x8, (u32x4{pack2(re.x, -im.x), pack2(re.y, -im.y), pack2(re.z, -im.z), pack2(re.w, -im.w)}));
    }
  }
  const int tbase = b * SEQ + w * 512;
  float* uw = uL + w * 256;
  auto load_u = [&](int ch) {
    const int tt = lane >> 2, c4 = (lane & 3) * 4;
    uint2 raw = *reinterpret_cast<const uint2*>(s5 + (size_t)(tbase + ch * 16 + tt) * 256 + g * 16 + c4);
    float4 f; f.x = __uint_as_float(raw.x << 16); f.y = __uint_as_float(raw.x & 0xffff0000u);
    f.z = __uint_as_float(raw.y << 16); f.w = __uint_as_float(raw.y & 0xffff0000u);
    *reinterpret_cast<float4*>(uw + tt * 16 + c4) = f;
  };
  float xr = 0.f, xi = 0.f;
  for (int ch = 0; ch < 32; ++ch) {
    __syncthreads();
    load_u(ch);
    __syncthreads();
#pragma unroll 4
    for (int tt = 0; tt < 16; ++tt) {
      float bur = 0.f, bui = 0.f;
#pragma unroll
      for (int h4 = 0; h4 < 4; ++h4) {
        float4 u = *reinterpret_cast<const float4*>(uw + tt * 16 + h4 * 4);
        bur += Bre[h4 * 4] * u.x + Bre[h4 * 4 + 1] * u.y + Bre[h4 * 4 + 2] * u.z + Bre[h4 * 4 + 3] * u.w;
        bui += Bim[h4 * 4] * u.x + Bim[h4 * 4 + 1] * u.y + Bim[h4 * 4 + 2] * u.z + Bim[h4 * 4 + 3] * u.w;
      }
      float nr = cr * xr - ci * xi + bur, ni = cr * xi + ci * xr + bui;
      xr = nr; xi = ni;
    }
  }
  fin[(w * 64 + lane) * 2] = xr; fin[(w * 64 + lane) * 2 + 1] = xi;
  __syncthreads();
  {
    float pr = cr, pi = ci;
    for (int i = 0; i < 9; ++i) { float nr = pr * pr - pi * pi, ni = 2.f * pr * pi; pr = nr; pi = ni; }
    float vr = 0.f, vi = 0.f;
    for (int ww = 0; ww < w; ++ww) {
      float fr_ = fin[(ww * 64 + lane) * 2], fi_ = fin[(ww * 64 + lane) * 2 + 1];
      float nr = pr * vr - pi * vi + fr_, ni = pr * vi + pi * vr + fi_;
      vr = nr; vi = ni;
    }
    xr = vr; xi = vi;
  }
  float* xw = xL + w * (16 * 66 * 2);
  const int ot = lane & 15, oh = (lane >> 4) * 4;
  const float* dsk = (const float*)p.in[I_SD] + l * 256 + g * 16 + oh;
  const float d0 = dsk[0], d1 = dsk[1], d2 = dsk[2], d3 = dsk[3];
  for (int ch = 0; ch < 32; ++ch) {
    __syncthreads();
    load_u(ch);
    __syncthreads();
#pragma unroll 4
    for (int tt = 0; tt < 16; ++tt) {
      float bur = 0.f, bui = 0.f;
#pragma unroll
      for (int h4 = 0; h4 < 4; ++h4) {
        float4 u = *reinterpret_cast<const float4*>(uw + tt * 16 + h4 * 4);
        bur += Bre[h4 * 4] * u.x + Bre[h4 * 4 + 1] * u.y + Bre[h4 * 4 + 2] * u.z + Bre[h4 * 4 + 3] * u.w;
        bui += Bim[h4 * 4] * u.x + Bim[h4 * 4 + 1] * u.y + Bim[h4 * 4 + 2] * u.z + Bim[h4 * 4 + 3] * u.w;
      }
      float nr = cr * xr - ci * xi + bur, ni = cr * xi + ci * xr + bui;
      xr = nr; xi = ni;
      *reinterpret_cast<float2*>(xw + (tt * 66 + lane) * 2) = make_float2(xr, xi);
    }
    __syncthreads();
    f32x4 yacc = f32x4{0.f, 0.f, 0.f, 0.f};
#pragma unroll
    for (int s4 = 0; s4 < 4; ++s4) {
      const float* xp = xw + (ot * 66 + 16 * s4 + oh) * 2;
      const float4 f0 = *reinterpret_cast<const float4*>(xp), f1 = *reinterpret_cast<const float4*>(xp + 4);
      const bf16x8 xf = __builtin_bit_cast(bf16x8, (u32x4{pack2(f0.x, f0.y), pack2(f0.z, f0.w), pack2(f1.x, f1.y), pack2(f1.z, f1.w)}));
      yacc = __builtin_amdgcn_mfma_f32_16x16x32_bf16(cf[s4], xf, yacc, 0, 0, 0);
    }
    float a0 = yacc[0], a1 = yacc[1], a2 = yacc[2], a3 = yacc[3];
    float4 u = *reinterpret_cast<const float4*>(uw + ot * 16 + oh);
    a0 = gelu_tanh(a0 + d0 * u.x); a1 = gelu_tanh(a1 + d1 * u.y); a2 = gelu_tanh(a2 + d2 * u.z); a3 = gelu_tanh(a3 + d3 * u.w);
    uint2 ov; ov.x = pack2(a0, a1); ov.y = pack2(a2, a3);
    *reinterpret_cast<uint2*>(Z + (size_t)(tbase + ch * 16 + ot) * 256 + g * 16 + oh) = ov;
  }
  __syncthreads();
}

DI void phase_mixers(const PRef& p, int lc) {
  __shared__ int s_item;
  unsigned* cnt = (unsigned*)(p.ws + OFF_CNT) + lc;
  const int l = lc & 7;
  const int total = 64 + 128 + 1024;
  while (true) {
    __syncthreads();
    if (ltid() == 0) s_item = (int)atomicAdd(cnt, 1u);
    __syncthreads();
    const int item = s_item;
    if (item >= total) break;
    kaptr_t ka2 = p.in.ka; asm volatile("" : "+s"(ka2)); const PRef q(ka2);
    const int cls = (lc >= 8) ? (PROBE_DUP >> 4) : 7;
    if (item < 64) { if (cls & 1) rwkv_scan_item(q, item >> 3, (item >> 1) & 3, item & 1); }
    else if (item < 192) { int i = item - 64; if (cls & 2) s5_item(q, l, i >> 4, i & 15); }
    else { int i = item - 192; int qt = 31 - (i >> 5); int bh = i & 31; if (cls & 4) diff_attn_item(q, l, bh >> 2, bh & 3, qt); }
  }
}

DI void phase_post(const PRef& p, int l) {
  const float* Y = (const float*)(p.ws + OFF_Y);
  const u16* gbuf = (const u16*)(p.ws + OFF_G);
  const u16* Z = (const u16*)(p.ws + OFF_Z);
  const float* bonus = (const float*)(p.ws + OFF_BONUS);
  const char* rec = p.ws + OFF_REC;
  u16* hcat = (u16*)(p.ws + OFF_HCAT);
  const u16* glut = (const u16*)(p.ws + OFF_WT + WT_GLU);
  const float* lng = (const float*)p.in[I_LNXG] + l * 256;
  const float* lnb = (const float*)p.in[I_LNXB] + l * 256;
  const float* glub = (const float*)p.in[I_GLUB] + l * 256;
  const float* outg = (const float*)p.in[I_SOUTG] + l * 256;
  const int tid = ltid(), w = tid >> 6, lane = tid & 63, fr = lane & 15, fq = lane >> 4;
  extern __shared__ __attribute__((aligned(16))) u16 shm[];
  {
    const uint4* g4 = reinterpret_cast<const uint4*>(glut);
    uint4* l4 = reinterpret_cast<uint4*>(shm);
#pragma unroll 4
    for (int i = 0; i < 16; ++i) {
      const int idx = tid + i * 512, row = idx >> 5, ch = idx & 31;
      l4[row * 32 + (ch ^ (row & 15))] = g4[idx];
    }
  }
  __syncthreads();
  for (int item = blockIdx.x; item < NTOK / 128; item += gridDim.x) {
    const int tk0 = item * 128;
    {
      const int c = tid & 255, half = tid >> 8, h = c >> 6, cc = c & 63;
      const float gw = lng[c], gb = lnb[c];
      for (int i0 = 0; i0 < 64; i0 += 8) {
        float yv[8], vv[8], gq[8], bo[8];
#pragma unroll
        for (int u = 0; u < 8; ++u) {
          const int tok = tk0 + half * 64 + i0 + u;
          const int b = tok >> 12, t = tok & (SEQ - 1);
          const char* rp = rec + ((size_t)((b * 4 + h) * SEQ + t)) * 1152;
          yv[u] = Y[(size_t)tok * 256 + c];
          vv[u] = bf2f(reinterpret_cast<const u16*>(rp + 1024)[cc]);
          gq[u] = bf2f(gbuf[(size_t)tok * 256 + c]);
          bo[u] = bonus[(size_t)tok * 4 + h];
        }
        float mean[8], var[8];
#pragma unroll
        for (int u = 0; u < 8; ++u) { mean[u] = wave_sum(yv[u]) * (1.f / 64.f); }
#pragma unroll
        for (int u = 0; u < 8; ++u) { float d = yv[u] - mean[u]; var[u] = wave_sum(d * d) * (1.f / 64.f); }
#pragma unroll
        for (int u = 0; u < 8; ++u) {
          const int tok = tk0 + half * 64 + i0 + u;
          float out = (yv[u] - mean[u]) * rsqrtf(var[u] + 64e-5f) * gw + gb + bo[u] * vv[u];
          out *= gq[u];
          hcat[(size_t)tok * 1024 + 512 + c] = f2bf(out);
        }
      }
    }
    {
      const int tokw = tk0 + w * 16;
      bf16x8 zf[8];
#pragma unroll
      for (int s = 0; s < 8; ++s) zf[s] = *reinterpret_cast<const bf16x8*>(Z + (size_t)(tokw + fr) * 256 + s * 32 + fq * 8);
      float ss = 0.f, rms = 0.f;
      for (int pass = 0; pass < 2; ++pass) {
#pragma unroll 2
        for (int nb = 0; nb < 16; ++nb) {
          f32x4 acc = f32x4{0.f, 0.f, 0.f, 0.f};
#pragma unroll
          for (int s = 0; s < 8; ++s) {
            bf16x8 wf = *reinterpret_cast<const bf16x8*>(shm + ((nb * 16 + fr) * 32 + ((s * 4 + fq) ^ fr)) * 8);
            acc = __builtin_amdgcn_mfma_f32_16x16x32_bf16(wf, zf[s], acc, 0, 0, 0);
          }
          const int col = nb * 16 + fq * 4;
          uint2 zr = *reinterpret_cast<const uint2*>(Z + (size_t)(tokw + fr) * 256 + col);
          float z0 = __uint_as_float(zr.x << 16), z1 = __uint_as_float(zr.x & 0xffff0000u);
          float z2 = __uint_as_float(zr.y << 16), z3 = __uint_as_float(zr.y & 0xffff0000u);
          float o0 = z0 * sigmoidf_(acc[0] + glub[col]), o1 = z1 * sigmoidf_(acc[1] + glub[col + 1]);
          float o2 = z2 * sigmoidf_(acc[2] + glub[col + 2]), o3 = z3 * sigmoidf_(acc[3] + glub[col + 3]);
          if (pass == 0) ss += o0 * o0 + o1 * o1 + o2 * o2 + o3 * o3;
          else {
            uint2 ov;
            ov.x = pack2(o0 * rms * outg[col], o1 * rms * outg[col + 1]);
            ov.y = pack2(o2 * rms * outg[col + 2], o3 * rms * outg[col + 3]);
            *reinterpret_cast<uint2*>(hcat + (size_t)(tokw + fr) * 1024 + 768 + col) = ov;
          }
        }
        if (pass == 0) { ss += __shfl_xor(ss, 16); ss += __shfl_xor(ss, 32); rms = rsqrtf(ss * (1.f / 256.f) + 1e-6f); }
      }
    }
  }
}

DI void phase_ln(const PRef& p, const float* g, const float* bta) {
  float* xs = p.xs; u16* xb = (u16*)(p.ws + OFF_XB);
  const int w = ltid() >> 6, lane = ltid() & 63;
  for (int tok = blockIdx.x * 8 + w; tok < NTOK; tok += gridDim.x * 8) {
    float4* row = reinterpret_cast<float4*>(xs + (size_t)tok * DM);
    float4 v[4]; float s = 0.f;
    for (int i = 0; i < 4; ++i) { v[i] = row[lane + i * 64]; s += v[i].x + v[i].y + v[i].z + v[i].w; }
    const float mean = wave_sum(s) * (1.f / 1024.f);
    float q = 0.f;
    for (int i = 0; i < 4; ++i) { float a = v[i].x - mean, b = v[i].y - mean, c = v[i].z - mean, d = v[i].w - mean; q += a * a + b * b + c * c + d * d; }
    const float rstd = rsqrtf(wave_sum(q) * (1.f / 1024.f) + 1e-5f);
    for (int i = 0; i < 4; ++i) {
      const int col = (lane + i * 64) * 4;
      float4 gg = *reinterpret_cast<const float4*>(g + col), bb = *reinterpret_cast<const float4*>(bta + col);
      float4 o;
      o.x = (v[i].x - mean) * rstd * gg.x + bb.x; o.y = (v[i].y - mean) * rstd * gg.y + bb.y;
      o.z = (v[i].z - mean) * rstd * gg.z + bb.z; o.w = (v[i].w - mean) * rstd * gg.w + bb.w;
      row[lane + i * 64] = o;
      uint2 ob; ob.x = pack2(o.x, o.y); ob.y = pack2(o.z, o.w);
      *reinterpret_cast<uint2*>(xb + (size_t)tok * DM + col) = ob;
    }
  }
}

DI void phase_conv(const PRef& p, int l) {
  char* ws = p.ws;
  u16* hmid = (u16*)(ws + OFF_AG);
  const float* af = (const float*)(ws + OFF_AF); const float* gf = (const float*)(ws + OFF_GF); const float* al = (const float*)(ws + OFF_AL);
  const float* cw = (const float*)p.in[I_CONVW] + (size_t)l * 3 * DFF;
  const float* cb = (const float*)p.in[I_CONVB] + (size_t)l * DFF;
  for (int it = blockIdx.x * 512 + ltid(); it < 128 * DFF; it += gridDim.x * 512) {
    const int pm = it / DFF, c = it % DFF;
    const float a0 = af[(size_t)(pm * 2) * DFF + c], a1 = af[(size_t)(pm * 2 + 1) * DFF + c];
    const float g0 = gf[(size_t)(pm * 2) * DFF + c], g1 = gf[(size_t)(pm * 2 + 1) * DFF + c];
    float l0 = 0.f, l1 = 0.f;
    if ((pm & 15) != 0) { l0 = al[(size_t)((pm - 1) * 2) * DFF + c]; l1 = al[(size_t)((pm - 1) * 2 + 1) * DFF + c]; }
    const float w0 = cw[c], w1 = cw[DFF + c], w2 = cw[2 * DFF + c], bs = cb[c];
    const float cv0 = bs + w0 * l0 + w1 * l1 + w2 * a0;
    const float cv1 = bs + w0 * l1 + w1 * a0 + w2 * a1;
    hmid[(size_t)(pm * 256) * DFF + c] = f2bf(cv0 * sigmoidf_(cv0) * g0);
    hmid[(size_t)(pm * 256 + 1) * DFF + c] = f2bf(cv1 * sigmoidf_(cv1) * g1);
  }
}

DI void phase_gemm(const PRef& p, int kind, int l) {
  int nN = 4, K = 1024, lda = 1024, ldb = 1024;
  if (kind == 0) nN = 9;
  if (kind == 10) nN = 22;
  if (kind == 12) { lda = 2816; ldb = 2816; K = 2816; }
  const int ntile = 128 * nN;
  const bool remap = (gridDim.x & 7) == 0;
  const int per = remap ? (ntile >> 3) : ntile, xcd = blockIdx.x & 7;
  const int slot = remap ? (int)(blockIdx.x >> 3) : (int)blockIdx.x, nslot = remap ? (int)(gridDim.x >> 3) : (int)gridDim.x;
  const int n_main = (slot < per) ? (per - slot + nslot - 1) / nslot : 0;
  const int t0x = remap ? (int)((((blockIdx.x >> 3) + 16) & 31) * 8 + (blockIdx.x & 7)) : (int)blockIdx.x;
  const int n_extra = (kind == 0 && t0x < 320) ? (320 - t0x + (int)gridDim.x - 1) / (int)gridDim.x : 0;
  const kaptr_t ka = p.in.ka;
  auto tile_fn = [&](int idx) -> TileDesc {
    const PRef q(ka);
    char* ws = q.ws; char* wt = ws + OFF_WT;
    const u16* xb = (const u16*)(ws + OFF_XB);
    TileDesc d; d.sub = 0; d.A = xb;
    if (idx < n_main) {
      const int jj = slot + idx * nslot;
      const int t = remap ? xcd * per + jj : jj;
      int pm = t / nN, pn = t % nN;
      if (kind == 0) { d.B = (const u16*)(wt + WT_IN); pn = (pn < 4) ? pn : pn + 2; }
      else if (kind == 4) { d.A = (const u16*)(ws + OFF_HCAT); d.B = (const u16*)(wt + WT_OUT); }
      else if (kind == 6) d.B = (const u16*)(wt + WT_Q);
      else if (kind == 8) { d.A = (const u16*)(ws + OFF_OC); d.B = (const u16*)(wt + WT_O); }
      else if (kind == 10) d.B = (const u16*)(wt + WT_UP);
      else { d.A = (const u16*)(ws + OFF_AG); d.B = (const u16*)(wt + WT_DOWN); }
      d.brow = pm * 256; d.bcol = pn * 256;
    } else {
      const int t = t0x + (idx - n_main) * (int)gridDim.x;
      const u16* wint = (const u16*)(wt + WT_IN); const u16* wkvt = (const u16*)(wt + WT_KV); const u16* memb = (const u16*)(ws + OFF_MEMB);
      int pm, pn;
      if (t < 256) { pn = t >> 1; pm = t & 1; d.A = wint + (size_t)1024 * 1024; d.B = xb; d.sub = 1; }
      else if (t < 288) { int i = t - 256; pm = i >> 2; pn = i & 3; d.A = memb; d.B = wkvt; d.sub = 2; }
      else { int i = t - 288; pm = i >> 3; pn = i & 7; d.A = wkvt + (size_t)1024 * 1024; d.B = memb; d.sub = 3; }
      d.brow = pm * 256; d.bcol = pn * 256;
    }
    return d;
  };
  EpiGen e; e.kind = kind; e.lay = l; e.ka = ka;
  gemm_stream(n_main + n_extra, lda, ldb, K, tile_fn, e);
}
DI void phase_cross(const PRef& p) {
  for (int it = blockIdx.x; it < 1024; it += gridDim.x) cross_attn_item(p, it >> 2, it & 3);
}

constexpr int PH_PER_LAYER = 14, N_PHASES = 1 + DEPTH * PH_PER_LAYER;

DI void run_phase(const PRef& p, int ph) {
  if (ph == 0) { phase_init(p); phase_transposes(p, 0); return; }
  const int l = (ph - 1) / PH_PER_LAYER, s = (ph - 1) % PH_PER_LAYER;
  if (s == 0 || s == 4 || s == 6 || s == 8 || s == 10 || s == 12) {
    phase_gemm(p, s, l);
    if ((PROBE_DUP & 1) && (s == 0 || s == 6 || s == 10)) phase_gemm(p, s, l);
    return;
  }
  switch (s) {
    case 1: phase_prep(p, l); break;
    case 2: phase_mixers(p, l); if (PROBE_DUP & 2) phase_mixers(p, l + 8); break;
    case 3: phase_post(p, l); if (PROBE_DUP & 8) phase_post(p, l); break;
    case 5: phase_ln(p, (const float*)p.in[I_LN1G] + l * DM, (const float*)p.in[I_LN1B] + l * DM); break;
    case 7: phase_cross(p); if (PROBE_DUP & 4) phase_cross(p); break;
    case 9: phase_ln(p, (const float*)p.in[I_LN2G] + l * DM, (const float*)p.in[I_LN2B] + l * DM); break;
    case 11: phase_conv(p, l); break;
    case 13:
      phase_ln(p, (const float*)p.in[I_LN3G] + l * DM, (const float*)p.in[I_LN3B] + l * DM);
      if (l + 1 < DEPTH) phase_transposes(p, l + 1);
      break;
  }
}

template <int S>
__global__ void __launch_bounds__(512) ph_kernel(Params p_unused, int l) {
  kaptr_t ka = (kaptr_t)__builtin_amdgcn_kernarg_segment_ptr();
  const PRef p(ka);
  if (S < 0) { phase_init(p); phase_transposes(p, 0); return; }
  if (S == 0 || S == 4 || S == 6 || S == 8 || S == 10 || S == 12) { phase_gemm(p, S, l); return; }
  if (S == 1) phase_prep(p, l);
  if (S == 2) phase_mixers(p, l);
  if (S == 3) phase_post(p, l);
  if (S == 5) phase_ln(p, (const float*)p.in[I_LN1G] + l * DM, (const float*)p.in[I_LN1B] + l * DM);
  if (S == 7) phase_cross(p);
  if (S == 9) phase_ln(p, (const float*)p.in[I_LN2G] + l * DM, (const float*)p.in[I_LN2B] + l * DM);
  if (S == 11) phase_conv(p, l);
  if (S == 13) {
    phase_ln(p, (const float*)p.in[I_LN3G] + l * DM, (const float*)p.in[I_LN3B] + l * DM);
    if (l + 1 < DEPTH) phase_transposes(p, l + 1);
  }
}

#if !MULTI_LAUNCH
__device__ unsigned g_bar = 0;
#ifndef USE_COOP
#define USE_COOP 1
#endif

__global__ void __launch_bounds__(512) fwd_kernel(Params p_unused, int ph_begin_arg, int ph_end_arg) {
  constexpr int ph_begin = 0, ph_end = N_PHASES;
#if USE_COOP
  cg::this_grid().sync();
#endif
  __shared__ unsigned s_base;
  for (int ph = ph_begin; ph < ph_end; ++ph) {
    kaptr_t ka = (kaptr_t)__builtin_amdgcn_kernarg_segment_ptr();
    asm volatile("" : "+s"(ka));
    const PRef p(ka);
    run_phase(p, ph);
    if (ph + 1 < ph_end) {
      asm volatile("s_waitcnt vmcnt(0) lgkmcnt(0)" ::: "memory");
      __syncthreads();
      if (threadIdx.x == 0) {
        __builtin_amdgcn_fence(__ATOMIC_RELEASE, "agent");
        asm volatile("s_waitcnt vmcnt(0)" ::: "memory");
        const unsigned nbar = (unsigned)(ph - ph_begin + 1);
        unsigned old = __hip_atomic_fetch_add(&g_bar, 1u, __ATOMIC_RELAXED, __HIP_MEMORY_SCOPE_AGENT);
        if (nbar == 1) { const unsigned per_launch = (unsigned)(ph_end - ph_begin - 1) * gridDim.x; s_base = old - (old % per_launch); }
        const unsigned target = s_base + nbar * gridDim.x;
        while ((int)(__hip_atomic_load(&g_bar, __ATOMIC_RELAXED, __HIP_MEMORY_SCOPE_AGENT) - target) < 0) __builtin_amdgcn_s_sleep(4);
        __builtin_amdgcn_fence(__ATOMIC_ACQUIRE, "agent");
        asm volatile("s_waitcnt vmcnt(0)" ::: "memory");
      }
      __syncthreads();
    }
  }
}
#endif

constexpr size_t kDynLds = 131072 + 4096;

template <int S> static void launch_ph(const Params& p, int l, int grid, hipStream_t stream) {
  static bool attr_done = false;
  if (!attr_done) { (void)hipFuncSetAttribute((const void*)ph_kernel<S>, hipFuncAttributeMaxDynamicSharedMemorySize, (int)kDynLds); attr_done = true; }
  hipLaunchKernelGGL(ph_kernel<S>, dim3(grid), dim3(512), kDynLds, stream, p, l);
}

extern "C" void kernel_launch(void* const* d_in, const int* in_sizes, int n_in, void* d_out, int out_size, void* d_ws, size_t ws_size,
                              hipStream_t stream) {
  Params p;
  memset(&p, 0, sizeof(p));
  for (int i = 0; i < N_IN && i < n_in; ++i) p.in[i] = d_in[i];
  p.xs = (float*)d_out;
  p.ws = (char*)d_ws;
  for (int l = 0; l < 4; ++l) p.lam_init[l] = (float)(0.8 - 0.6 * exp(-0.3 * (double)l));
#if MULTI_LAUNCH
  const int grid = 256;
  launch_ph<-1>(p, 0, grid, stream);
  for (int l = 0; l < DEPTH; ++l) {
    launch_ph<0>(p, l, grid, stream); launch_ph<1>(p, l, grid, stream); launch_ph<2>(p, l, grid, stream); launch_ph<3>(p, l, grid, stream);
    launch_ph<4>(p, l, grid, stream); launch_ph<5>(p, l, grid, stream); launch_ph<6>(p, l, grid, stream); launch_ph<7>(p, l, grid, stream);
    launch_ph<8>(p, l, grid, stream); launch_ph<9>(p, l, grid, stream); launch_ph<10>(p, l, grid, stream); launch_ph<11>(p, l, grid, stream);
    launch_ph<12>(p, l, grid, stream); launch_ph<13>(p, l, grid, stream);
  }
#else
  static int grid_blocks = 0;
  if (!grid_blocks) {
    (void)hipFuncSetAttribute((const void*)fwd_kernel, hipFuncAttributeMaxDynamicSharedMemorySize, (int)kDynLds);
    int dev = 0, cus = 0, per_cu = 0;
    (void)hipGetDevice(&dev);
    (void)hipDeviceGetAttribute(&cus, hipDeviceAttributeMultiprocessorCount, dev);
    (void)hipOccupancyMaxActiveBlocksPerMultiprocessor(&per_cu, fwd_kernel, 512, kDynLds);
    if (per_cu < 1) per_cu = 1;
    grid_blocks = cus * per_cu;
    if (grid_blocks <= 0) grid_blocks = 256;
    if (per_cu > 1) grid_blocks = cus;
  }
  int b = 0, e = N_PHASES;
#if USE_COOP
  void* args[] = {&p, &b, &e};
  hipError_t err = hipLaunchCooperativeKernel((void*)fwd_kernel, dim3(grid_blocks), dim3(512), args, kDynLds, stream);
  if (err != hipSuccess) fprintf(stderr, "cooperative launch failed: %s (grid %d)\n", hipGetErrorString(err), grid_blocks);
#else
#ifdef BISECT_PER_PHASE
  for (int ph = 0; ph < N_PHASES; ++ph) hipLaunchKernelGGL(fwd_kernel, dim3(grid_blocks), dim3(512), kDynLds, stream, p, ph, ph + 1);
#else
  hipLaunchKernelGGL(fwd_kernel, dim3(grid_blocks), dim3(512), kDynLds, stream, p, b, e);
#endif
#endif
#endif
}
```
